# Optimizing an MI355X kernel written in HIP

```python
import jax
import jax.numpy as jnp
from jax import lax
import numpy as np

D_MODEL = 1024
BATCH = 8
SEQ = 4096
DEPTH = 2

GRID_W = 64
CTX_LEN = 256
HEAD_DIM = 64
ROPE_THETA = 10000.0
EPS = 1e-6
Q_BLOCK = 128
NEG_BIG = -1e30

A_HEADS = 6
A_KV_HEADS = 2
B_HEADS = 4
B_Q_RANK = 256
B_KV_RANK = 128
B_NOPE = 64
B_ROPE = 32
B_V = 64
C_HEADS = 6
C_KV_HEADS = 2
C_WINDOW = 128

A_COLS = (A_HEADS + 2 * A_KV_HEADS) * HEAD_DIM
B_COLS = B_Q_RANK + B_KV_RANK + B_ROPE
C_COLS = (C_HEADS + 2 * C_KV_HEADS) * HEAD_DIM
IN_COLS = A_COLS + B_COLS + C_COLS
MIX_WIDTH = A_HEADS * HEAD_DIM + B_HEADS * B_V + C_HEADS * HEAD_DIM

D_FF_DENSE = 2816
N_EXPERTS = 8
TOP_K = 2
D_FF_EXPERT = 3584
N_DENSE = (DEPTH + 1) // 2
N_MOE = DEPTH // 2

kernel_name = "hybrid_parallel_heads_diffusion_block"


def rmsnorm(x, g):
    xf = x.astype(jnp.float32)
    y = xf * lax.rsqrt(jnp.mean(xf * xf, axis=-1, keepdims=True) + EPS)
    return (y * g.astype(jnp.float32)).astype(x.dtype)


def axial_rope_tables(n_tok, rot_dim, dtype):
    rows = n_tok // GRID_W
    row, col = jnp.meshgrid(jnp.arange(rows), jnp.arange(GRID_W), indexing="ij")
    row = row.reshape(-1).astype(jnp.float32)
    col = col.reshape(-1).astype(jnp.float32)
    n_freq = rot_dim // 4
    inv_freq = ROPE_THETA ** (-jnp.arange(n_freq, dtype=jnp.float32) / n_freq)
    ang_r = row[:, None] * inv_freq
    ang_c = col[:, None] * inv_freq
    ang = jnp.concatenate([ang_r, ang_r, ang_c, ang_c], axis=-1)
    return jnp.cos(ang).astype(dtype), jnp.sin(ang).astype(dtype)


def apply_axial_rope(t, cos, sin):
    n_freq = t.shape[-1] // 4
    t4 = t.reshape(t.shape[:-1] + (2, 2, n_freq))
    rot = jnp.concatenate([-t4[..., 1:, :], t4[..., :1, :]], axis=-2).reshape(t.shape)
    return t * cos[:, None, :] + rot * sin[:, None, :]


def rope_latent(t, n_ctx, cos, sin):
    return jnp.concatenate([t[:, :n_ctx], apply_axial_rope(t[:, n_ctx:], cos, sin)], axis=1)


def to_groups(q, n_kv):
    b, t, h, d = q.shape
    return q.reshape(b, t, n_kv, h // n_kv, d).transpose(0, 2, 3, 1, 4)


def to_heads(k):
    return k.transpose(0, 2, 1, 3)


def merge_heads(o):
    b, hk, g, t, d = o.shape
    return o.transpose(0, 3, 1, 2, 4).reshape(b, t, hk * g * d)


def sdpa(q, k, v, scale):
    s = jnp.einsum("bhgqd,bhkd->bhgqk", q, k, preferred_element_type=jnp.float32) * scale
    p = jax.nn.softmax(s, axis=-1)
    return jnp.einsum("bhgqk,bhkd->bhgqd", p.astype(v.dtype), v)


def block_sweep_attention(q, k, v, scale):
    b, hk, g, s, dk = q.shape
    nb = s // Q_BLOCK
    qb = jnp.moveaxis(q.reshape(b, hk, g, nb, Q_BLOCK, dk), 3, 0)
    ob = lax.map(lambda qi: sdpa(qi, k, v, scale), qb)
    return jnp.moveaxis(ob, 0, 3).reshape(b, hk, g, s, v.shape[-1])


def sink_softmax(scores, sink):
    m = sink
    for s in scores:
        m = jnp.maximum(m, jnp.max(s, axis=-1, keepdims=True))
    e = [jnp.exp(s - m) for s in scores]
    denom = jnp.exp(sink - m)
    for ei in e:
        denom = denom + jnp.sum(ei, axis=-1, keepdims=True)
    return [ei / denom for ei in e]


def global_gqa(qkv, n_ctx, q_gain, k_gain, cos, sin, with_ctx):
    b, t, _ = qkv.shape
    q, k, v = jnp.split(qkv, [A_HEADS * HEAD_DIM, (A_HEADS + A_KV_HEADS) * HEAD_DIM], axis=-1)
    q = rope_latent(rmsnorm(q.reshape(b, t, A_HEADS, HEAD_DIM), q_gain), n_ctx, cos, sin)
    k = rope_latent(rmsnorm(k.reshape(b, t, A_KV_HEADS, HEAD_DIM), k_gain), n_ctx, cos, sin)
    v = v.reshape(b, t, A_KV_HEADS, HEAD_DIM)
    qg, kh, vh = to_groups(q, A_KV_HEADS), to_heads(k), to_heads(v)
    scale = HEAD_DIM ** -0.5
    out_lat = merge_heads(block_sweep_attention(qg[:, :, :, n_ctx:], kh, vh, scale))
    out_ctx = None
    if with_ctx:
        out_ctx = merge_heads(sdpa(qg[:, :, :, :n_ctx], kh[:, :, :n_ctx], vh[:, :, :n_ctx], scale))
    return out_ctx, out_lat


def latent_attention(proj, n_ctx, q_gain, kv_gain, w_uq, w_ukv, cos, sin, with_ctx):
    b, t, _ = proj.shape
    cq, ckv, k_rope = jnp.split(proj, [B_Q_RANK, B_Q_RANK + B_KV_RANK], axis=-1)
    q = (rmsnorm(cq, q_gain) @ w_uq).reshape(b, t, B_HEADS, B_NOPE + B_ROPE)
    kv = (rmsnorm(ckv, kv_gain) @ w_ukv).reshape(b, t, B_HEADS, B_NOPE + B_V)
    q_nope, q_rope = jnp.split(q, [B_NOPE], axis=-1)
    k_nope, v = jnp.split(kv, [B_NOPE], axis=-1)
    q_rope = rope_latent(q_rope, n_ctx, cos, sin)
    k_rope = rope_latent(k_rope[:, :, None, :], n_ctx, cos, sin)
    q = jnp.concatenate([q_nope, q_rope], axis=-1)
    k = jnp.concatenate([k_nope, jnp.broadcast_to(k_rope, (b, t, B_HEADS, B_ROPE))], axis=-1)
    qg, kh, vh = to_groups(q, B_HEADS), to_heads(k), to_heads(v)
    scale = (B_NOPE + B_ROPE) ** -0.5
    out_lat = merge_heads(block_sweep_attention(qg[:, :, :, n_ctx:], kh, vh, scale))
    out_ctx = None
    if with_ctx:
        out_ctx = merge_heads(sdpa(qg[:, :, :, :n_ctx], kh[:, :, :n_ctx], vh[:, :, :n_ctx], scale))
    return out_ctx, out_lat


def window_sink_gqa(qkv, n_ctx, sinks, cos, sin, with_ctx):
    b, t, _ = qkv.shape
    q, k, v = jnp.split(qkv, [C_HEADS * HEAD_DIM, (C_HEADS + C_KV_HEADS) * HEAD_DIM], axis=-1)
    q = rope_latent(q.reshape(b, t, C_HEADS, HEAD_DIM), n_ctx, cos, sin)
    k = rope_latent(k.reshape(b, t, C_KV_HEADS, HEAD_DIM), n_ctx, cos, sin)
    v = v.reshape(b, t, C_KV_HEADS, HEAD_DIM)
    qg, kh, vh = to_groups(q, C_KV_HEADS), to_heads(k), to_heads(v)
    g = C_HEADS // C_KV_HEADS
    scale = HEAD_DIM ** -0.5
    sink = sinks.astype(jnp.float32).reshape(C_KV_HEADS, g)
    k_ctx, v_ctx = kh[:, :, :n_ctx], vh[:, :, :n_ctx]
    q_lat, k_lat, v_lat = qg[:, :, :, n_ctx:], kh[:, :, n_ctx:], vh[:, :, n_ctx:]
    s_len = t - n_ctx
    w = C_WINDOW
    nb = s_len // w
    qb = q_lat.reshape(b, C_KV_HEADS, g, nb, w, HEAD_DIM)

    def band(u):
        up = jnp.pad(u, ((0, 0), (0, 0), (w, w), (0, 0))).reshape(b, C_KV_HEADS, nb + 2, w, u.shape[-1])
        return jnp.concatenate([up[:, :, :-2], up[:, :, 1:-1], up[:, :, 2:]], axis=-2)

    kb, vb = band(k_lat), band(v_lat)
    blk = jnp.arange(nb)[:, None] * w
    q_pos = blk + jnp.arange(w)[None, :]
    k_pos = blk - w + jnp.arange(3 * w)[None, :]
    rel = k_pos[:, None, :] - q_pos[:, :, None]
    valid = (jnp.abs(rel) <= C_WINDOW) & (k_pos[:, None, :] >= 0) & (k_pos[:, None, :] < s_len)
    s_loc = jnp.einsum("bhgnqd,bhnkd->bhgnqk", qb, kb, preferred_element_type=jnp.float32) * scale
    s_loc = jnp.where(valid, s_loc, NEG_BIG)
    s_ctx = jnp.einsum("bhgnqd,bhkd->bhgnqk", qb, k_ctx, preferred_element_type=jnp.float32) * scale
    p_loc, p_ctx = sink_softmax([s_loc, s_ctx], sink[None, :, :, None, None, None])
    o = (jnp.einsum("bhgnqk,bhnkd->bhgnqd", p_loc.astype(vb.dtype), vb)
         + jnp.einsum("bhgnqk,bhkd->bhgnqd", p_ctx.astype(v_ctx.dtype), v_ctx))
    out_lat = merge_heads(o.reshape(b, C_KV_HEADS, g, s_len, HEAD_DIM))
    out_ctx = None
    if with_ctx:
        s_cc = jnp.einsum("bhgqd,bhkd->bhgqk", qg[:, :, :, :n_ctx], k_ctx,
                          preferred_element_type=jnp.float32) * scale
        (p_cc,) = sink_softmax([s_cc], sink[None, :, :, None, None])
        out_ctx = merge_heads(jnp.einsum("bhgqk,bhkd->bhgqd", p_cc.astype(v_ctx.dtype), v_ctx))
    return out_ctx, out_lat


def swiglu(t, w1, w3, w2):
    return (jax.nn.silu(t @ w1) * (t @ w3)) @ w2


def moe_swiglu(t, w_router, w1, w3, w2):
    shape = t.shape
    tok = t.reshape(-1, shape[-1])
    logits = jnp.dot(tok, w_router, preferred_element_type=jnp.float32)
    top_logit, top_idx = lax.top_k(logits, TOP_K)
    gates = jax.nn.softmax(top_logit, axis=-1)
    combine = jnp.sum(jax.nn.one_hot(top_idx, N_EXPERTS, dtype=jnp.float32) * gates[..., None],
                      axis=1).astype(tok.dtype)
    out = jnp.zeros_like(tok)
    for e in range(N_EXPERTS):
        out = out + combine[:, e:e + 1] * swiglu(tok, w1[e], w3[e], w2[e])
    return out.reshape(shape)


def channel_mixer(t, layer, w1_dense, w3_dense, w2_dense, w_router, w1_moe, w3_moe, w2_moe):
    j = layer // 2
    if layer % 2 == 0:
        return swiglu(t, w1_dense[j], w3_dense[j], w2_dense[j])
    return moe_swiglu(t, w_router[j], w1_moe[j], w3_moe[j], w2_moe[j])


def setup_inputs(seed: int = 0) -> dict:
    key = jax.random.key(seed)
    ks = jax.random.split(key, 25)
    f32 = jnp.float32

    def nrm(k, shape, scale=1.0):
        return jax.random.normal(k, shape, f32) * scale

    def gain(k, shape):
        return 1.0 + 0.1 * jax.random.normal(k, shape, f32)

    return {
        "x": nrm(ks[0], (BATCH, SEQ, D_MODEL)),
        "c": nrm(ks[1], (BATCH, D_MODEL)),
        "ctx": nrm(ks[2], (BATCH, CTX_LEN, D_MODEL)),
        "c_ctx": nrm(ks[3], (D_MODEL,)),
        "w_mod": nrm(ks[4], (DEPTH, D_MODEL, 6 * D_MODEL), 0.5 * D_MODEL ** -0.5),
        "b_mod": nrm(ks[5], (DEPTH, 6 * D_MODEL), 0.01),
        "norm_mix": gain(ks[6], (DEPTH, D_MODEL)),
        "norm_ffn": gain(ks[7], (DEPTH, D_MODEL)),
        "w_in": nrm(ks[8], (DEPTH, D_MODEL, IN_COLS), D_MODEL ** -0.5),
        "a_q_norm": gain(ks[9], (DEPTH, HEAD_DIM)),
        "a_k_norm": gain(ks[10], (DEPTH, HEAD_DIM)),
        "b_q_norm": gain(ks[11], (DEPTH, B_Q_RANK)),
        "b_kv_norm": gain(ks[12], (DEPTH, B_KV_RANK)),
        "w_uq": nrm(ks[13], (DEPTH, B_Q_RANK, B_HEADS * (B_NOPE + B_ROPE)), B_Q_RANK ** -0.5),
        "w_ukv": nrm(ks[14], (DEPTH, B_KV_RANK, B_HEADS * (B_NOPE + B_V)), B_KV_RANK ** -0.5),
        "c_sinks": nrm(ks[15], (DEPTH, C_HEADS)),
        "w_out": nrm(ks[16], (DEPTH, MIX_WIDTH, D_MODEL), MIX_WIDTH ** -0.5),
        "w1_dense": nrm(ks[17], (N_DENSE, D_MODEL, D_FF_DENSE), D_MODEL ** -0.5),
        "w3_dense": nrm(ks[18], (N_DENSE, D_MODEL, D_FF_DENSE), D_MODEL ** -0.5),
        "w2_dense": nrm(ks[19], (N_DENSE, D_FF_DENSE, D_MODEL), D_FF_DENSE ** -0.5),
        "w_router": nrm(ks[20], (N_MOE, D_MODEL, N_EXPERTS), D_MODEL ** -0.5),
        "w1_moe": nrm(ks[21], (N_MOE, N_EXPERTS, D_MODEL, D_FF_EXPERT), D_MODEL ** -0.5),
        "w3_moe": nrm(ks[22], (N_MOE, N_EXPERTS, D_MODEL, D_FF_EXPERT), D_MODEL ** -0.5),
        "w2_moe": nrm(ks[23], (N_MOE, N_EXPERTS, D_FF_EXPERT, D_MODEL), D_FF_EXPERT ** -0.5),
        "final_norm": gain(ks[24], (D_MODEL,)),
    }


def reference(x, c, ctx, c_ctx, w_mod, b_mod, norm_mix, norm_ffn, w_in, a_q_norm, a_k_norm,
              b_q_norm, b_kv_norm, w_uq, w_ukv, c_sinks, w_out, w1_dense, w3_dense, w2_dense,
              w_router, w1_moe, w3_moe, w2_moe, final_norm):
    n_ctx = ctx.shape[1]
    n_lat = x.shape[1]
    cos_h, sin_h = axial_rope_tables(n_lat, HEAD_DIM, x.dtype)
    cos_r, sin_r = axial_rope_tables(n_lat, B_ROPE, x.dtype)
    xc = ctx
    for i in range(DEPTH):
        last = i == DEPTH - 1
        mod_lat = jnp.split(jax.nn.silu(c) @ w_mod[i] + b_mod[i], 6, axis=-1)
        sh_a, sc_a, gt_a, sh_f, sc_f, gt_f = [m[:, None, :] for m in mod_lat]
        csh_a, csc_a, cgt_a, csh_f, csc_f, cgt_f = jnp.split(jax.nn.silu(c_ctx) @ w_mod[i] + b_mod[i], 6, axis=-1)

        h = jnp.concatenate([rmsnorm(xc, norm_mix[i]) * (1 + csc_a) + csh_a,
                             rmsnorm(x, norm_mix[i]) * (1 + sc_a) + sh_a], axis=1)
        proj = h @ w_in[i]
        p_a, p_b, p_c = jnp.split(proj, [A_COLS, A_COLS + B_COLS], axis=-1)
        a_ctx, a_lat = global_gqa(p_a, n_ctx, a_q_norm[i], a_k_norm[i], cos_h, sin_h, not last)
        b_ctx, b_lat = latent_attention(p_b, n_ctx, b_q_norm[i], b_kv_norm[i], w_uq[i], w_ukv[i],
                                        cos_r, sin_r, not last)
        c_ctx_out, c_lat = window_sink_gqa(p_c, n_ctx, c_sinks[i], cos_h, sin_h, not last)
        x = x + gt_a * (jnp.concatenate([a_lat, b_lat, c_lat], axis=-1) @ w_out[i])
        if not last:
            xc = xc + cgt_a * (jnp.concatenate([a_ctx, b_ctx, c_ctx_out], axis=-1) @ w_out[i])

        hf_lat = rmsnorm(x, norm_ffn[i]) * (1 + sc_f) + sh_f
        if last:
            x = x + gt_f * channel_mixer(hf_lat, i, w1_dense, w3_dense, w2_dense,
                                         w_router, w1_moe, w3_moe, w2_moe)
        else:
            hf = jnp.concatenate([rmsnorm(xc, norm_ffn[i]) * (1 + csc_f) + csh_f, hf_lat], axis=1)
            y = channel_mixer(hf, i, w1_dense, w3_dense, w2_dense, w_router, w1_moe, w3_moe, w2_moe)
            xc = xc + cgt_f * y[:, :n_ctx]
            x = x + gt_f * y[:, n_ctx:]
    return rmsnorm(x, final_norm)
```

```cpp
#include <hip/hip_runtime.h>
#include <cstdio>
#include <cstdint>
namespace pg8 {
#define PG8_LAS __attribute__((address_space(3)))
typedef unsigned short bf16_t;
typedef short bf16x8 __attribute__((ext_vector_type(8)));
typedef float f32x4 __attribute__((ext_vector_type(4)));
typedef unsigned u32x4 __attribute__((ext_vector_type(4)));
constexpr int BM = 256, BK = 64, HALF = 128, HTB = HALF * BK * 2  , STAGE_BYTES = 8 * HTB, NXCD = 8, WGM = 8;

__host__ __device__ __forceinline__ int lds_byte(int r, int c) { const int st = (r >> 4) * 2 + (c >> 5), rr = r & 15, cc = c & 31, ob = rr * 64 + cc * 2; return st * 1024 + (ob ^ (((ob >> 9) & 1) << 5)); }
__host__ __device__ __forceinline__ void stage_rc(int b, int& R, int& C) { const int st = b / 1024, sb = b % 1024, swz = sb ^ (((sb >> 9) & 1) << 5); R = (st >> 1) * 16 + swz / 64; C = (st & 1) * 32 + (swz % 64) / 2; }
__host__ __device__ __forceinline__ int perm32(int rho) { const int n = rho >> 4, i = rho & 15; return 8 * (i >> 2) + 4 * n + (i & 3); }

struct Unit { int pm, pn; };
struct Gemm { const bf16_t* A; const bf16_t* Bt; int M, N, K; };

struct StaticOrder {
    int nM, nN, nwg, G, c;
    __host__ __device__ void init(int M, int N, int G_, int c_) { nM = M / BM; nN = N / BM; nwg = nM * nN; G = G_; c = c_; }
    __host__ __device__ bool next(int i, Unit& u) const {
        const long L = (long)i * G + c; if (L >= nwg) return false;
        int wgid = (int)L; { const int q = nwg / NXCD, r = nwg % NXCD, xcd = wgid % NXCD, off = wgid / NXCD; wgid = (xcd < r ? xcd * (q + 1) : r * (q + 1) + (xcd - r) * q) + off; }
        const int nig = WGM * nN, gid = wgid / nig, fm = gid * WGM, gsz = (nM - fm) < WGM ? (nM - fm) : WGM;
        u.pm = fm + ((wgid % nig) % gsz); u.pn = (wgid % nig) / gsz; return true;
    }
    __device__ __forceinline__ void a_ready(const Unit&) const {}
    __device__ __forceinline__ void done(const Unit&) const {}
};

__device__ __forceinline__ unsigned cvt_pk_bf16(float lo, float hi) { unsigned r; asm volatile("v_cvt_pk_bf16_f32 %0, %1, %2" : "=v"(r) : "v"(lo), "v"(hi)); return r; }
typedef float f32x2 __attribute__((ext_vector_type(2)));
template <class Epi, class Sched, bool ALIGN_EPI = false, bool SP2 = false>
__device__ __forceinline__ void gemm_phase(PG8_LAS unsigned char* lds, const Gemm g, const Sched& S, const Epi& E) {
    const int tid = threadIdx.x, wid = __builtin_amdgcn_readfirstlane(tid >> 6), lane = tid & 63, wr = wid >> 2, wc = wid & 3, fr = lane & 15, fq = lane >> 4;
    const int K = g.K, nt = K / BK;
    unsigned voffA[2], voffB[2];
#pragma unroll
    for (int i = 0; i < 2; ++i) { int R, C; stage_rc(tid * 16 + i * 8192, R, C); const int Rb = Epi::PERM ? ((R & ~31) + perm32(R & 31)) : R;
        voffA[i] = (unsigned)(R * K + C) * 2u; voffB[i] = (unsigned)(Rb * K + C) * 2u; }
    const size_t kstep = (size_t)(BK * 2);
    const size_t hstep = (size_t)HALF * K * 2;
    const size_t tstep = 2 * hstep;
    const unsigned ldsw = (unsigned)wid * 1024u;
    const int aoff = lds_byte(wr * 64 + fr, fq * 8), boff = lds_byte(wc * 32 + fr, fq * 8);
#define PG8_SA(b, h) (((b) * 2 + (h)) * HTB)
#define PG8_SB(b, h) ((4 + (b) * 2 + (h)) * HTB)
#define PG8_STAGE(bufoff, gbase, voff) do { _Pragma("unroll") for (int _i = 0; _i < 2; ++_i) \
        __builtin_amdgcn_global_load_lds((const unsigned*)((const char*)(gbase) + (voff)[_i]), (PG8_LAS unsigned*)(lds + (bufoff) + ldsw + _i * 8192), 16, 0, 0); } while (0)
#define PG8_LDA(dst, b, h) do { _Pragma("unroll") for (int m = 0; m < 4; ++m) _Pragma("unroll") for (int k = 0; k < 2; ++k) dst[m][k] = *(const PG8_LAS bf16x8*)(lds + PG8_SA(b, h) + aoff + m * 2048 + k * 1024); } while (0)
#define PG8_LDB(dst, b, h) do { _Pragma("unroll") for (int n = 0; n < 2; ++n) _Pragma("unroll") for (int k = 0; k < 2; ++k) dst[n][k] = *(const PG8_LAS bf16x8*)(lds + PG8_SB(b, h) + boff + n * 2048 + k * 1024); } while (0)
#define PG8_MMA(ai, bj, At, Bt) do { __builtin_amdgcn_s_setprio(1); _Pragma("unroll") for (int m = 0; m < 4; ++m) _Pragma("unroll") for (int n = 0; n < 2; ++n) _Pragma("unroll") for (int k = 0; k < 2; ++k) \
        acc[ai][bj][m][n] = __builtin_amdgcn_mfma_f32_16x16x32_bf16(Bt[n][k], At[m][k], acc[ai][bj][m][n], 0, 0, 0); __builtin_amdgcn_s_setprio(0); } while (0)
#define PG8_WAIT_V(n) asm volatile("s_waitcnt vmcnt(" #n ")" ::: "memory")
#define PG8_WAIT_L(n) asm volatile("s_waitcnt lgkmcnt(" #n ")" ::: "memory")
#define PG8_BAR __builtin_amdgcn_s_barrier()
#define PG8_SCHED __builtin_amdgcn_sched_barrier(0)
    Unit cur, nxt; int ui = 0;
    if (!S.next(0, cur)) return;
    f32x4 acc[2][2][4][2];
#pragma unroll
    for (int a = 0; a < 2; ++a)
#pragma unroll
        for (int b = 0; b < 2; ++b)
#pragma unroll
            for (int m = 0; m < 4; ++m)
#pragma unroll
                for (int n = 0; n < 2; ++n) acc[a][b][m][n] = (f32x4){0.f, 0.f, 0.f, 0.f};
    bf16x8 At[4][2], B0[2][2], B1[2][2];
    const char* cA = (const char*)g.A + (size_t)cur.pm * tstep; const char* cB = (const char*)g.Bt + (size_t)cur.pn * tstep;
    S.a_ready(cur);
    if constexpr (SP2) {
        PG8_STAGE(PG8_SB(0, 0), cB, voffB); PG8_STAGE(PG8_SB(0, 1), cB + hstep, voffB); PG8_STAGE(PG8_SA(0, 0), cA, voffA); PG8_STAGE(PG8_SA(0, 1), cA + hstep, voffA);
        if (wr == 1) PG8_BAR;
        PG8_WAIT_V(2); PG8_BAR;
        PG8_STAGE(PG8_SB(1, 0), cB + kstep, voffB); PG8_STAGE(PG8_SA(1, 0), cA + kstep, voffA); PG8_STAGE(PG8_SB(1, 1), cB + hstep + kstep, voffB);
        PG8_WAIT_V(6); PG8_BAR;
    } else {
        PG8_STAGE(PG8_SB(0, 0), cB, voffB); PG8_STAGE(PG8_SA(0, 0), cA, voffA); PG8_STAGE(PG8_SB(0, 1), cB + hstep, voffB); PG8_STAGE(PG8_SA(0, 1), cA + hstep, voffA);
        if (wr == 1) PG8_BAR;
        PG8_WAIT_V(4); PG8_BAR;
        PG8_STAGE(PG8_SB(1, 0), cB + kstep, voffB); PG8_STAGE(PG8_SA(1, 0), cA + kstep, voffA); PG8_STAGE(PG8_SB(1, 1), cB + hstep + kstep, voffB);
        PG8_WAIT_V(6); PG8_BAR;
    }
    for (;;) {
        const bool has_next = S.next(ui + 1, nxt);
        const char* nA = has_next ? (const char*)g.A + (size_t)nxt.pm * tstep : cA; const char* nB = has_next ? (const char*)g.Bt + (size_t)nxt.pn * tstep : cB;
        for (int t = 0; t < nt; t += 2) {
            const bool last = (t == nt - 2);
            const char* a1 = cA + (size_t)(t + 1) * kstep;
            const char* a2 = last ? nA : cA + (size_t)(t + 2) * kstep; const char* b2 = last ? nB : cB + (size_t)(t + 2) * kstep;
            const char* a3 = a2 + kstep; const char* b3 = b2 + kstep;
            if (last && has_next) S.a_ready(nxt);
            if constexpr (SP2) {
            PG8_LDB(B0, 0, 0); PG8_LDB(B1, 0, 1); PG8_SCHED; PG8_LDA(At, 0, 0); PG8_STAGE(PG8_SA(1, 1), a1 + hstep, voffA);
            PG8_WAIT_V(8); PG8_WAIT_L(0); PG8_BAR; PG8_MMA(0, 0, At, B0); PG8_MMA(0, 1, At, B1); PG8_BAR; PG8_SCHED;
            PG8_LDA(At, 0, 1); PG8_STAGE(PG8_SB(0, 0), b2, voffB); PG8_STAGE(PG8_SB(0, 1), b2 + hstep, voffB); PG8_STAGE(PG8_SA(0, 0), a2, voffA);
            PG8_WAIT_V(8); PG8_WAIT_L(0); PG8_BAR; PG8_MMA(1, 0, At, B0); PG8_MMA(1, 1, At, B1); PG8_BAR; PG8_SCHED;
            PG8_LDB(B0, 1, 0); PG8_LDB(B1, 1, 1); PG8_SCHED; PG8_LDA(At, 1, 0); PG8_STAGE(PG8_SA(0, 1), a2 + hstep, voffA);
            PG8_WAIT_V(8); PG8_WAIT_L(0); PG8_BAR; PG8_MMA(0, 0, At, B0); PG8_MMA(0, 1, At, B1); PG8_BAR; PG8_SCHED;
            PG8_LDA(At, 1, 1); PG8_STAGE(PG8_SB(1, 0), b3, voffB); PG8_STAGE(PG8_SB(1, 1), b3 + hstep, voffB); PG8_STAGE(PG8_SA(1, 0), a3, voffA);
            PG8_WAIT_V(8); PG8_WAIT_L(0); PG8_BAR; PG8_MMA(1, 0, At, B0); PG8_MMA(1, 1, At, B1); PG8_BAR; PG8_SCHED;
            } else {
            PG8_LDB(B0, 0, 0); PG8_SCHED; PG8_LDA(At, 0, 0); PG8_STAGE(PG8_SA(1, 1), a1 + hstep, voffA);
            PG8_WAIT_L(8); PG8_BAR; PG8_WAIT_L(0); PG8_MMA(0, 0, At, B0); PG8_BAR; PG8_SCHED;
            PG8_LDB(B1, 0, 1); PG8_STAGE(PG8_SB(0, 0), b2, voffB);
            PG8_BAR; PG8_WAIT_L(0); PG8_MMA(0, 1, At, B1); PG8_BAR;
            PG8_LDA(At, 0, 1); PG8_STAGE(PG8_SA(0, 0), a2, voffA);
            PG8_BAR; PG8_WAIT_L(0); PG8_MMA(1, 0, At, B0); PG8_BAR; PG8_SCHED;
            PG8_STAGE(PG8_SB(0, 1), b2 + hstep, voffB);
            PG8_WAIT_V(6); PG8_BAR; PG8_MMA(1, 1, At, B1); PG8_BAR;
            PG8_LDB(B0, 1, 0); PG8_SCHED; PG8_LDA(At, 1, 0); PG8_STAGE(PG8_SA(0, 1), a2 + hstep, voffA);
            PG8_WAIT_L(8); PG8_BAR; PG8_WAIT_L(0); PG8_MMA(0, 0, At, B0); PG8_BAR; PG8_SCHED;
            PG8_LDB(B1, 1, 1); PG8_STAGE(PG8_SB(1, 0), b3, voffB);
            PG8_BAR; PG8_WAIT_L(0); PG8_MMA(0, 1, At, B1); PG8_BAR;
            PG8_LDA(At, 1, 1); PG8_STAGE(PG8_SA(1, 0), a3, voffA);
            PG8_BAR; PG8_WAIT_L(0); PG8_MMA(1, 0, At, B0); PG8_BAR; PG8_SCHED;
            PG8_STAGE(PG8_SB(1, 1), b3 + hstep, voffB);
            PG8_WAIT_V(6); PG8_BAR; PG8_MMA(1, 1, At, B1); PG8_BAR;
            }
        }
        if constexpr (ALIGN_EPI) { if (wr == 0) PG8_BAR; }
        if constexpr (!Epi::AFTER_DRAIN) { E(acc, cur, wr, wc, fr, fq); S.done(cur); }
        if (!has_next) break;
#pragma unroll
        for (int a = 0; a < 2; ++a)
#pragma unroll
            for (int b = 0; b < 2; ++b)
#pragma unroll
                for (int m = 0; m < 4; ++m)
#pragma unroll
                    for (int n = 0; n < 2; ++n) acc[a][b][m][n] = (f32x4){0.f, 0.f, 0.f, 0.f};
        cur = nxt; cA = nA; cB = nB; ++ui;
        if constexpr (ALIGN_EPI) { if (wr == 1) PG8_BAR; }
    }
    PG8_WAIT_V(0);
    if constexpr (!ALIGN_EPI) { if (wr == 0) PG8_BAR; }
    PG8_BAR;
    if constexpr (Epi::AFTER_DRAIN) { E.fused(acc, cur, wr, wc, fr, fq, lds, wid, lane); S.done(cur); }
#undef PG8_SA
#undef PG8_SB
#undef PG8_STAGE
#undef PG8_LDA
#undef PG8_LDB
#undef PG8_MMA
#undef PG8_WAIT_V
#undef PG8_WAIT_L
#undef PG8_BAR
#undef PG8_SCHED
}
}
#define GAS __attribute__((address_space(1)))
#define LAS __attribute__((address_space(3)))
typedef unsigned short bf16;
typedef unsigned v4u __attribute__((ext_vector_type(4)));
typedef float f32x4 __attribute__((ext_vector_type(4)));
typedef short bf16x8 __attribute__((ext_vector_type(8)));
typedef GAS unsigned gu32;
typedef GAS unsigned long long gu64;
#define RLX_AGENT __ATOMIC_RELAXED, __HIP_MEMORY_SCOPE_AGENT
#define LDS_WAIT() asm volatile("s_waitcnt lgkmcnt(0)" ::: "memory")
#define VM_WAIT() asm volatile("s_waitcnt vmcnt(0)" ::: "memory")
__device__ __forceinline__ unsigned long long rt() { return __builtin_amdgcn_s_memrealtime(); }
__device__ __forceinline__ unsigned f2bf(float f) { unsigned u = __builtin_bit_cast(unsigned, f); return (u + 0x7fffu + ((u >> 16) & 1u)) >> 16; }
__device__ __forceinline__ unsigned pk2(float lo, float hi) { return f2bf(lo) | (f2bf(hi) << 16); }

#define XB_TMO      128
#define XB_XCNT(j)  (256  + 64 * (j))
#define XB_XSUB(j)  (1280 + 64 * (j))
#define XB_XGEN(j)  (2304 + 64 * (j))
#define XB_TOP      3328
#define XB_TOPGEN   3392
#define XCD_BAR_WORDS 3456
#define XB_SPIN_CAP (1u << 18)

__device__ __forceinline__ unsigned xb_ld(unsigned* p)              { return __hip_atomic_load(p, __ATOMIC_RELAXED, __HIP_MEMORY_SCOPE_AGENT); }
__device__ __forceinline__ unsigned xb_add(unsigned* p, unsigned v) { return __hip_atomic_fetch_add(p, v, __ATOMIC_RELAXED, __HIP_MEMORY_SCOPE_AGENT); }
__device__ __forceinline__ unsigned xb_xcc_id() { return (unsigned)__builtin_amdgcn_s_getreg((3 << 11) | 20) & 0xFu; }
#define XB_SPIN(cond, bar) do { unsigned _sp = 0; while (cond) { __builtin_amdgcn_s_sleep(1); \
    if ((++_sp & 255u) == 0u) { if (xb_ld(&(bar)[XB_TMO])) break; if (_sp > XB_SPIN_CAP) { atomicAdd(&(bar)[XB_TMO], 1u); break; } } } } while (0)

struct XcdBarrier {
    unsigned* bar; unsigned x;
    volatile LAS unsigned* st;
};

__device__ __forceinline__ XcdBarrier xcd_barrier_post(unsigned* bar, volatile LAS unsigned* st) {
    XcdBarrier b; b.bar = bar; b.x = xb_xcc_id(); b.st = st;
    if (threadIdx.x == 0) (void)xb_add(&bar[XB_XCNT(b.x)], 1u);
    return b;
}
__device__ __forceinline__ void xcd_barrier_complete(unsigned* bar, unsigned x, unsigned& nloc, unsigned& nx) {
    const unsigned G = gridDim.x * gridDim.y * gridDim.z;
    unsigned sum, cnt, mine, sp = 0u;
    for (;;) {
        sum = 0u; cnt = 0u; mine = 0u;
#pragma unroll
        for (unsigned j = 0; j < 16; ++j) { const unsigned c = xb_ld(&bar[XB_XCNT(j)]); sum += c; cnt += (c > 0u) ? 1u : 0u; mine = (j == x) ? c : mine; }
        if (sum == G) break;
        __builtin_amdgcn_s_sleep(1);
        if ((++sp & 255u) == 0u) { if (xb_ld(&bar[XB_TMO])) break; if (sp > XB_SPIN_CAP) { atomicAdd(&bar[XB_TMO], 1u); break; } }
    }
    nloc = mine > 0u ? mine : 1u; nx = cnt > 0u ? cnt : 1u;
}

__device__ __forceinline__ void xcd_barrier(const XcdBarrier& b) {
    asm volatile("s_waitcnt vmcnt(0)" ::: "memory");
    __syncthreads();
    if (threadIdx.x == 0) {
        unsigned* bar = b.bar;
        __builtin_amdgcn_s_waitcnt(0);
        unsigned nloc = b.st[0], nx = b.st[1];
        if (nloc == 0u) { xcd_barrier_complete(bar, b.x, nloc, nx); b.st[0] = nloc; b.st[1] = nx; }
        const unsigned old = xb_add(&bar[XB_XSUB(b.x)], 1u);
        const unsigned gen = old / nloc;
        if (old + 1u == (gen + 1u) * nloc) {
            __builtin_amdgcn_fence(__ATOMIC_RELEASE, "agent");
            asm volatile("s_waitcnt vmcnt(0)" ::: "memory");
            const unsigned og = xb_add(&bar[XB_TOP], 1u);
            const unsigned tg = og / nx;
            if (og + 1u == (tg + 1u) * nx) xb_add(&bar[XB_TOPGEN], 1u);
            else XB_SPIN(xb_ld(&bar[XB_TOPGEN]) == tg, bar);
            __builtin_amdgcn_fence(__ATOMIC_ACQUIRE, "agent");
            xb_add(&bar[XB_XGEN(b.x)], 1u);
            asm volatile("s_waitcnt vmcnt(0)" ::: "memory");
        } else {
            XB_SPIN(xb_ld(&bar[XB_XGEN(b.x)]) == gen, bar);
            __builtin_amdgcn_fence(__ATOMIC_ACQUIRE, "agent");
            asm volatile("s_waitcnt vmcnt(0)" ::: "memory");
        }
    }
    __syncthreads();
}

constexpr int NWAVES = 8;
constexpr int NB = 8, SEQ = 4096, CTXL = 256, TT = SEQ + CTXL, DM = 1024, MROWS = NB * TT;
constexpr int NLAT = NB * SEQ;
constexpr int NPROJ = 1792, INCOLS = 1696, FFD = 2816, FFE = 3584, NEXP = 8;
constexpr int KTILES = TT / 64;
constexpr float EPS = 1e-6f, LOG2E = 1.4426950408889634f;
constexpr int MOE_CH = 64, MOE_NCH = 5, MOE_MAXT = 264;

constexpr size_t MiB = 1u << 20;
constexpr size_t WS_CTL = 0, WS_WUB = 1 * MiB, ZERO_BYTES = 3 * MiB;
constexpr size_t WS_MOD = 3 * MiB;
constexpr size_t WS_WIN = 4 * MiB, WS_WOUT = 11 * MiB, WS_WUP = 15 * MiB, WS_WDN = 26 * MiB;
constexpr size_t WS_XC = 32 * MiB;
constexpr size_t WS_RT = 40 * MiB;
constexpr size_t RT_TOPE = 0, RT_GATE = 256 * 1024, RT_POS = 512 * 1024, RT_HIST = 768 * 1024, RT_TILEE = 776 * 1024;
constexpr size_t WS_H = 42 * MiB;
constexpr size_t WS_P = 110 * MiB;
constexpr size_t WS_Q = 229 * MiB;
constexpr size_t SZ_Q64 = (size_t)NB * 6 * TT * 64 * 2, SZ_KV2 = (size_t)NB * 2 * KTILES * 8192;
constexpr size_t WS_QA = WS_Q, WS_KA = WS_QA + SZ_Q64, WS_VA = WS_KA + SZ_KV2, WS_QC = WS_VA + SZ_KV2, WS_KC = WS_QC + SZ_Q64, WS_VC = WS_KC + SZ_KV2;
constexpr size_t WS_CQKV = WS_VC + SZ_KV2;
constexpr size_t WS_KR = WS_CQKV + (size_t)MROWS * 384 * 2;
constexpr size_t WS_QB = WS_KR + (size_t)MROWS * 32 * 2;
constexpr size_t WS_KB = WS_QB + (size_t)NB * 4 * TT * 96 * 2;
constexpr size_t WS_VB = WS_KB + (size_t)NB * 4 * KTILES * 12288;
constexpr size_t WS_QEND = WS_VB + (size_t)NB * 4 * KTILES * 8192;
constexpr size_t WS_U = WS_P;
constexpr size_t WS_WMUP = 110 * MiB, WS_WMDN = 222 * MiB, WS_HFS = 278 * MiB, WS_UM = 410 * MiB, WS_END = 522 * MiB;
static_assert(WS_QEND <= 411 * MiB && WS_U + (size_t)MROWS * FFD * 2 <= WS_QEND, "ws map");
static_assert(WS_WMUP + (size_t)NEXP * 2 * FFE * DM * 2 <= WS_WMDN && WS_WMDN + (size_t)NEXP * DM * FFE * 2 <= WS_HFS && WS_HFS + (size_t)MOE_MAXT * 256 * DM * 2 <= WS_UM && WS_UM + (size_t)MOE_CH * 256 * FFE * 2 <= WS_END, "moe ws map");
constexpr int CW_BAR = 4096;

constexpr int RING_BYTES = 131072, LDSCTL_OFF = RING_BYTES, MISC_OFF = LDSCTL_OFF + 320, LDS_BYTES = 147456;

__device__ __forceinline__ float bflo(unsigned u) { return __builtin_bit_cast(float, u << 16); }
__device__ __forceinline__ float bfhi(unsigned u) { return __builtin_bit_cast(float, u & 0xffff0000u); }
__device__ __forceinline__ void unpack8(const v4u r, float (&v)[8]) { v[0] = bflo(r.x); v[1] = bfhi(r.x); v[2] = bflo(r.y); v[3] = bfhi(r.y); v[4] = bflo(r.z); v[5] = bfhi(r.z); v[6] = bflo(r.w); v[7] = bfhi(r.w); }
__device__ __forceinline__ v4u pack8(const float (&v)[8]) { v4u o; o.x = pk2(v[0], v[1]); o.y = pk2(v[2], v[3]); o.z = pk2(v[4], v[5]); o.w = pk2(v[6], v[7]); return o; }
__device__ __forceinline__ float wave_sum(float v) {
#pragma unroll
    for (int o = 1; o < 64; o <<= 1) v += __shfl_xor(v, o);
    return v;
}
__device__ __forceinline__ float fast_rsqrt(float x) { return __builtin_amdgcn_rsqf(x); }
__device__ __forceinline__ float silu_f(float a) { return a * __builtin_amdgcn_rcpf(1.0f + __builtin_amdgcn_exp2f(-a * LOG2E)); }

struct Args { const float* in[25]; float* out; unsigned char* ws; int ph_lo, ph_hi; };
struct Ctx {
    LAS unsigned char* lds; int tid, lane, wave, vcu, G, wg;
    const float* const* in; float* out; unsigned char* ws;
};

struct TileSched {
    int nM, nN, nwg, G, c, skip;
    __device__ __forceinline__ void init(int nM_, int nN_, int G_, int c_, int skip_) { nM = nM_; nN = nN_; nwg = nM * nN; G = G_; c = c_; skip = skip_; }
    __device__ __forceinline__ bool next(int i, pg8::Unit& u) const {
        const long L = (long)i * G + c; if (L >= nwg) return false;
        int wgid = (int)L; { const int q = nwg / pg8::NXCD, r = nwg % pg8::NXCD, xcd = wgid % pg8::NXCD, off = wgid / pg8::NXCD; wgid = (xcd < r ? xcd * (q + 1) : r * (q + 1) + (xcd - r) * q) + off; }
        const int nig = pg8::WGM * nN, gid = wgid / nig, fm = gid * pg8::WGM, gsz = (nM - fm) < pg8::WGM ? (nM - fm) : pg8::WGM;
        int pm = fm + ((wgid % nig) % gsz); u.pn = (wgid % nig) / gsz;
        if (skip) pm = (pm >> 4) * 17 + 1 + (pm & 15);
        u.pm = pm; return true;
    }
    __device__ __forceinline__ void a_ready(const pg8::Unit&) const {}
    __device__ __forceinline__ void done(const pg8::Unit&) const {}
};
struct MoeSched {
    const int* tile_e; int tile0, ntc, NT, G, c, up;
    __device__ __forceinline__ bool next(int i, pg8::Unit& u) const {
        const int L = i * G + c; if (L >= ntc * NT) return false;
        const int tl = L % ntc, pnl = L / ntc;
        const int e = __builtin_amdgcn_readfirstlane(__hip_atomic_load(tile_e + tile0 + tl, __ATOMIC_RELAXED, __HIP_MEMORY_SCOPE_AGENT)) & 7;
        u.pm = up ? tile0 + tl : tl; u.pn = e * NT + pnl; return true;
    }
    __device__ __forceinline__ void a_ready(const pg8::Unit&) const {}
    __device__ __forceinline__ void done(const pg8::Unit&) const {}
};

struct EpiStoreBf16 {
    static constexpr bool PERM = true, AFTER_DRAIN = false;
    pg8::bf16_t* O; int ldc, pn_mod, pm_off;
    __device__ __forceinline__ void operator()(const pg8::f32x4 (&acc)[2][2][4][2], const pg8::Unit& u, int wr, int wc, int fr, int fq) const {
        const int row0 = (u.pm + pm_off) * 256 + wr * 64 + fr, col0 = (u.pn % pn_mod) * 256 + wc * 32 + 8 * fq;
#pragma unroll
        for (int ai = 0; ai < 2; ++ai)
#pragma unroll
            for (int m = 0; m < 4; ++m) { pg8::bf16_t* rowp = O + (size_t)(row0 + ai * 128 + m * 16) * ldc + col0;
#pragma unroll
                for (int bj = 0; bj < 2; ++bj) { const pg8::f32x4 v0 = acc[ai][bj][m][0], v1 = acc[ai][bj][m][1];
                    pg8::u32x4 w; w.x = pg8::cvt_pk_bf16(v0[0], v0[1]); w.y = pg8::cvt_pk_bf16(v0[2], v0[3]); w.z = pg8::cvt_pk_bf16(v1[0], v1[1]); w.w = pg8::cvt_pk_bf16(v1[2], v1[3]);
                    *(pg8::u32x4*)(rowp + bj * 128) = w; } }
    }
};
struct EpiSwiglu {
    static constexpr bool PERM = true, AFTER_DRAIN = false;
    pg8::bf16_t* O; int ldc, pn_mod, pm_off;
    __device__ __forceinline__ void operator()(const pg8::f32x4 (&acc)[2][2][4][2], const pg8::Unit& u, int wr, int wc, int fr, int fq) const {
        typedef unsigned u32x2v __attribute__((ext_vector_type(2)));
        const int row0 = (u.pm + pm_off) * 256 + wr * 64 + fr, col0 = (u.pn % pn_mod) * 128 + wc * 16 + 4 * fq;
#pragma unroll
        for (int ai = 0; ai < 2; ++ai)
#pragma unroll
            for (int m = 0; m < 4; ++m) { pg8::bf16_t* rowp = O + (size_t)(row0 + ai * 128 + m * 16) * ldc + col0;
#pragma unroll
                for (int bj = 0; bj < 2; ++bj) { const pg8::f32x4 a = acc[ai][bj][m][0], b = acc[ai][bj][m][1];
                    u32x2v w; w.x = pg8::cvt_pk_bf16(silu_f(a[0]) * b[0], silu_f(a[1]) * b[1]); w.y = pg8::cvt_pk_bf16(silu_f(a[2]) * b[2], silu_f(a[3]) * b[3]);
                    *(u32x2v*)(rowp + bj * 64) = w; } }
    }
};
struct EpiResid {
    static constexpr bool PERM = false, AFTER_DRAIN = false;
    const float* base_lat; const float* base_ctx; float* out_lat; float* out_ctx; const float* gate;
    __device__ __forceinline__ void operator()(const pg8::f32x4 (&acc)[2][2][4][2], const pg8::Unit& u, int wr, int wc, int fr, int fq) const {
        const int b = u.pm / 17, j = u.pm % 17;
        const float* bs; float* os; const float* g;
        if (j == 0) { bs = base_ctx + (size_t)b * CTXL * DM; os = out_ctx + (size_t)b * CTXL * DM; g = gate + 8 * 6144; }
        else { const size_t ro = ((size_t)b * SEQ + (size_t)(j - 1) * 256) * DM; bs = base_lat + ro; os = out_lat + ro; g = gate + b * 6144; }
        const int col0 = u.pn * 256 + wc * 32 + 4 * fq;
#pragma unroll
        for (int bj = 0; bj < 2; ++bj)
#pragma unroll
            for (int n = 0; n < 2; ++n) { const pg8::f32x4 gv = *(const pg8::f32x4*)(g + col0 + bj * 128 + n * 16);
#pragma unroll
                for (int ai = 0; ai < 2; ++ai)
#pragma unroll
                    for (int m = 0; m < 4; ++m) { const size_t off = (size_t)(ai * 128 + wr * 64 + m * 16 + fr) * DM + col0 + bj * 128 + n * 16;
                        const pg8::f32x4 x0 = *(const pg8::f32x4*)(bs + off);
                        *(pg8::f32x4*)(os + off) = x0 + gv * acc[ai][bj][m][n];
                        if (m & 1) asm volatile("" ::: "memory"); } }
    }
};

namespace att {
using f32x16 = __attribute__((ext_vector_type(16))) float;
using s16x4 = __attribute__((ext_vector_type(4))) short;
typedef short v4i16_t __attribute__((ext_vector_type(4)));
constexpr int KSLOT = 12288, VSLOT = 8192;
constexpr int L_K = 0, L_V = 2 * KSLOT, L_O = L_V + 2 * VSLOT, OSTR = 144, L_END = L_O + NWAVES * 32 * OSTR;
static_assert(L_END <= RING_BYTES, "attention LDS");
constexpr float THR = 8.0f, NEGBIG = -1e30f;
__device__ __forceinline__ int crow(int r, int hi) { return (r & 3) + 8 * (r >> 2) + 4 * hi; }
__device__ __forceinline__ float swapmax(float m) { auto rr = __builtin_amdgcn_permlane32_swap(__float_as_uint(m), __float_as_uint(m), false, false); return fmaxf(__uint_as_float(rr[0]), __uint_as_float(rr[1])); }
__device__ __forceinline__ float swapsum(float m) { auto rr = __builtin_amdgcn_permlane32_swap(__float_as_uint(m), __float_as_uint(m), false, false); return __uint_as_float(rr[0]) + __uint_as_float(rr[1]); }
__device__ __forceinline__ s16x4 vtr(const LAS unsigned char* p) { return __builtin_bit_cast(s16x4, __builtin_amdgcn_ds_read_tr16_b64_v4i16((LAS v4i16_t*)p)); }
__device__ __forceinline__ unsigned cvtpk(float lo, float hi) { return pg8::cvt_pk_bf16(lo, hi); }

struct UnitDesc {
    const bf16* Q;
    const unsigned char* Kimg; const unsigned char* Vimg;
    bf16* O;
    int n0, s1t0, n1;
    int qpos0;
    float minit, linit;
};

template <int DK, bool WIN>
__device__ __forceinline__ void unit(LAS unsigned char* lds, const UnitDesc& u) {
    const int tid = threadIdx.x, lane = tid & 63, r32 = lane & 31, hi = lane >> 5; const int wid = __builtin_amdgcn_readfirstlane(tid >> 6);
    constexpr int KT_BYTES = DK * 128, NDS = DK / 16;
    const int NT = u.n0 + u.n1;
#define ATT_ISSUE(i_, slot_) do { const int tl_ = ((i_) < u.n0) ? (i_) : u.s1t0 + ((i_) - u.n0); \
        const unsigned char* kg_ = u.Kimg + (size_t)tl_ * KT_BYTES + wid * 1024 + lane * 16; \
        __builtin_amdgcn_global_load_lds((const unsigned*)kg_, (LAS unsigned*)(lds + L_K + (slot_) * KSLOT + wid * 1024), 16, 0, 0); \
        if (DK == 96) { if (wid < 4) __builtin_amdgcn_global_load_lds((const unsigned*)(kg_ + 8192), (LAS unsigned*)(lds + L_K + (slot_) * KSLOT + 8192 + wid * 1024), 16, 0, 0); } \
        const unsigned char* vg_ = u.Vimg + (size_t)tl_ * 8192 + wid * 1024 + lane * 16; \
        __builtin_amdgcn_global_load_lds((const unsigned*)vg_, (LAS unsigned*)(lds + L_V + (slot_) * VSLOT + wid * 1024), 16, 0, 0); } while (0)
    ATT_ISSUE(0, 0);
    bf16x8 qf[NDS];
#pragma unroll
    for (int ds = 0; ds < NDS; ++ds) qf[ds] = *(const bf16x8*)(u.Q + (size_t)(wid * 32 + r32) * DK + ds * 16 + hi * 8);
    f32x16 o0 = {}, o1 = {};
    float mref = u.minit, lsum = (hi == 0) ? u.linit : 0.f;
    const int qlo = u.qpos0 + wid * 32, qp = qlo + r32;
    asm volatile("s_waitcnt vmcnt(0)" ::: "memory"); __builtin_amdgcn_s_barrier(); asm volatile("" ::: "memory");
    for (int i = 0; i < NT; ++i) {
        const int slot = i & 1;
        if (i + 1 < NT) ATT_ISSUE(i + 1, slot ^ 1);
        bool active = true; int kpos0 = 0;
        if (WIN) { if (i >= u.n0) { kpos0 = (u.s1t0 + (i - u.n0) - 4) * 64; active = (kpos0 + 63 >= qlo - 128) && (kpos0 <= qlo + 31 + 128); } }
        if (active) {
            f32x16 p0 = {}, p1 = {};
            const LAS unsigned char* kb = lds + L_K + slot * KSLOT + hi * 1024 + r32 * 16;
#pragma unroll
            for (int ds = 0; ds < NDS; ++ds) {
                const bf16x8 k0 = *(const LAS bf16x8*)(kb + ds * 2048), k1 = *(const LAS bf16x8*)(kb + ds * 2048 + 512);
                p0 = __builtin_amdgcn_mfma_f32_32x32x16_bf16(k0, qf[ds], p0, 0, 0, 0);
                p1 = __builtin_amdgcn_mfma_f32_32x32x16_bf16(k1, qf[ds], p1, 0, 0, 0);
            }
            if (WIN) { if (i >= u.n0) {
#pragma unroll
                for (int r = 0; r < 16; ++r) { const int dk = kpos0 + crow(r, hi) - qp; if (dk > 128 || dk < -128) p0[r] = NEGBIG; if (dk + 32 > 128 || dk + 32 < -128) p1[r] = NEGBIG; }
            } }
            float rm = fmaxf(p0[0], p1[0]);
#pragma unroll
            for (int r = 1; r < 16; ++r) rm = fmaxf(rm, fmaxf(p0[r], p1[r]));
            rm = swapmax(rm);
            if (__any(rm > mref + THR)) {
                const float mn = fmaxf(mref, rm), al = __builtin_amdgcn_exp2f(mref - mn);
#pragma unroll
                for (int r = 0; r < 16; ++r) { o0[r] *= al; o1[r] *= al; }
                lsum *= al; mref = mn;
            }
            float sacc = 0.f;
#pragma unroll
            for (int r = 0; r < 16; ++r) { p0[r] = __builtin_amdgcn_exp2f(p0[r] - mref); p1[r] = __builtin_amdgcn_exp2f(p1[r] - mref); sacc += p0[r] + p1[r]; }
            lsum += sacc;
            v4u pw[4];
#pragma unroll
            for (int k = 0; k < 2; ++k) {
                pw[k].x = cvtpk(p0[8 * k + 0], p0[8 * k + 1]); pw[k].y = cvtpk(p0[8 * k + 2], p0[8 * k + 3]); pw[k].z = cvtpk(p0[8 * k + 4], p0[8 * k + 5]); pw[k].w = cvtpk(p0[8 * k + 6], p0[8 * k + 7]);
                pw[2 + k].x = cvtpk(p1[8 * k + 0], p1[8 * k + 1]); pw[2 + k].y = cvtpk(p1[8 * k + 2], p1[8 * k + 3]); pw[2 + k].z = cvtpk(p1[8 * k + 4], p1[8 * k + 5]); pw[2 + k].w = cvtpk(p1[8 * k + 6], p1[8 * k + 7]);
            }
            const LAS unsigned char* vb = lds + L_V + slot * VSLOT + ((lane >> 4) & 1) * 32 + (lane & 3) * 8 + (4 * hi + ((lane & 15) >> 2)) * 64;
#pragma unroll
            for (int ks = 0; ks < 4; ++ks) {
                const s16x4 a0 = vtr(vb + ks * 1024), a1 = vtr(vb + ks * 1024 + 512), b0 = vtr(vb + 4096 + ks * 1024), b1 = vtr(vb + 4096 + ks * 1024 + 512);
                const bf16x8 vf0 = (bf16x8){a0[0], a0[1], a0[2], a0[3], a1[0], a1[1], a1[2], a1[3]}, vf1 = (bf16x8){b0[0], b0[1], b0[2], b0[3], b1[0], b1[1], b1[2], b1[3]};
                const bf16x8 pf = __builtin_bit_cast(bf16x8, pw[ks]);
                o0 = __builtin_amdgcn_mfma_f32_32x32x16_bf16(vf0, pf, o0, 0, 0, 0);
                o1 = __builtin_amdgcn_mfma_f32_32x32x16_bf16(vf1, pf, o1, 0, 0, 0);
            }
        }
        asm volatile("s_waitcnt vmcnt(0) lgkmcnt(0)" ::: "memory"); __builtin_amdgcn_s_barrier(); asm volatile("" ::: "memory");
    }
#undef ATT_ISSUE
    const float inv = __builtin_amdgcn_rcpf(swapsum(lsum));
    LAS unsigned char* stg = lds + L_O + wid * (32 * OSTR);
    typedef unsigned u32x2v __attribute__((ext_vector_type(2)));
#pragma unroll
    for (int rg = 0; rg < 4; ++rg) {
        u32x2v w0, w1;
        w0.x = cvtpk(o0[4 * rg + 0] * inv, o0[4 * rg + 1] * inv); w0.y = cvtpk(o0[4 * rg + 2] * inv, o0[4 * rg + 3] * inv);
        w1.x = cvtpk(o1[4 * rg + 0] * inv, o1[4 * rg + 1] * inv); w1.y = cvtpk(o1[4 * rg + 2] * inv, o1[4 * rg + 3] * inv);
        *(LAS u32x2v*)(stg + r32 * OSTR + (8 * rg + 4 * hi) * 2) = w0;
        *(LAS u32x2v*)(stg + r32 * OSTR + (32 + 8 * rg + 4 * hi) * 2) = w1;
    }
    asm volatile("s_waitcnt lgkmcnt(0)" ::: "memory");
#pragma unroll
    for (int i = 0; i < 4; ++i) { const int row = i * 8 + (lane >> 3), ch = lane & 7; const v4u v = *(const LAS v4u*)(stg + row * OSTR + ch * 16);
        *(v4u*)(u.O + (size_t)(wid * 32 + row) * DM + ch * 8) = v; }
    asm volatile("s_waitcnt lgkmcnt(0)" ::: "memory");
}
}

__device__ __forceinline__ void transpose_item(const float* W, int ldw, int k0, int n0, bf16* WT, int dpitch, int dk0, int rmode, int roff, LAS float* scr, int lane) {
#pragma unroll 8
    for (int i = 0; i < 32; ++i) { const int kk = 2 * i + (lane >> 5); scr[kk * 33 + (lane & 31)] = W[(size_t)(k0 + kk) * ldw + n0 + (lane & 31)]; }
    LDS_WAIT(); asm volatile("" ::: "memory");
    const int c = lane & 7;
#pragma unroll
    for (int j = 0; j < 4; ++j) { const int n = (lane >> 3) + 8 * j; const LAS float* s = scr + (8 * c) * 33 + n;
        v4u o; o.x = pk2(s[0 * 33], s[1 * 33]); o.y = pk2(s[2 * 33], s[3 * 33]); o.z = pk2(s[4 * 33], s[5 * 33]); o.w = pk2(s[6 * 33], s[7 * 33]);
        const int nn = n0 + n; const int drow = rmode ? (8 * (nn >> 2) + 4 * roff + (nn & 3)) : (roff + nn);
        *(v4u*)(WT + (size_t)drow * dpitch + dk0 + k0 + 8 * c) = o; }
    LDS_WAIT(); asm volatile("" ::: "memory");
}
__device__ __forceinline__ void transpose_mat(const Ctx& C, int item, const float* W, int K, int N, bf16* WT, int dpitch, int dk0, int rmode, int roff) {
    const int nblk = N / 32, kb = item / nblk, nb = item % nblk;
    transpose_item(W, N, 64 * kb, 32 * nb, WT, dpitch, dk0, rmode, roff, (LAS float*)(C.lds + C.wave * 16384), C.lane);
}

__device__ __forceinline__ void phase_prologue(const Ctx& C) {
    float* mod = (float*)(C.ws + WS_MOD);
    if (C.vcu < 192) {
        const int L = C.vcu / 96, j0 = (C.vcu % 96) * 64;
        LAS float* sil = (LAS float*)C.lds; LAS float* part = (LAS float*)(C.lds + 40960);
        const float* cc = C.in[1]; const float* cx = C.in[3];
        for (int i = C.tid; i < 9 * 1024; i += 512) { const int r = i >> 10, k = i & 1023; const float v = (r < 8) ? cc[r * 1024 + k] : cx[k]; sil[i] = v / (1.0f + __expf(-v)); }
        __syncthreads();
        float acc[9];
#pragma unroll
        for (int r = 0; r < 9; ++r) acc[r] = 0.f;
        const float* wm = C.in[4] + (size_t)L * 1024 * 6144 + j0 + C.lane;
#pragma unroll 8
        for (int kk = 0; kk < 128; ++kk) { const int k = C.wave * 128 + kk; const float wv = wm[(size_t)k * 6144];
#pragma unroll
            for (int r = 0; r < 9; ++r) acc[r] += sil[r * 1024 + k] * wv; }
#pragma unroll
        for (int r = 0; r < 9; ++r) part[(C.wave * 9 + r) * 64 + C.lane] = acc[r];
        __syncthreads();
        for (int i = C.tid; i < 576; i += 512) { const int r = i >> 6, l = i & 63; float s = 0.f;
#pragma unroll
            for (int w = 0; w < 8; ++w) s += part[(w * 9 + r) * 64 + l];
            mod[(size_t)(L * 9 + r) * 6144 + j0 + l] = s + C.in[5][L * 6144 + j0 + l]; }
        __syncthreads();
    }
    const int gw = C.vcu * NWAVES + C.wave, NGW = C.G * NWAVES;
    bf16* win = (bf16*)(C.ws + WS_WIN); bf16* wout = (bf16*)(C.ws + WS_WOUT); bf16* wup = (bf16*)(C.ws + WS_WUP); bf16* wdn = (bf16*)(C.ws + WS_WDN); bf16* wub = (bf16*)(C.ws + WS_WUB);
    constexpr int I_IN = 16 * 53, I_OUT = 16 * 32, I_UP = 16 * 88, I_DN = 44 * 32, I_UQ = 4 * 12, I_UKV = 2 * 16, I_Z = 192;
    constexpr int NITEMS = 2 * I_IN + 2 * I_OUT + 2 * I_UP + I_DN + 2 * I_UQ + 2 * I_UKV + 2 * I_Z;
    for (int it = gw; it < NITEMS; it += NGW) {
        int r = it;
        if (r < 2 * I_IN) { const int L = r / I_IN; transpose_mat(C, r % I_IN, C.in[8] + (size_t)L * DM * INCOLS, DM, INCOLS, win + (size_t)L * NPROJ * DM, DM, 0, 0, 0); continue; } r -= 2 * I_IN;
        if (r < 2 * I_OUT) { const int L = r / I_OUT; transpose_mat(C, r % I_OUT, C.in[16] + (size_t)L * DM * DM, DM, DM, wout + (size_t)L * DM * DM, DM, 0, 0, 0); continue; } r -= 2 * I_OUT;
        if (r < I_UP) { transpose_mat(C, r, C.in[17], DM, FFD, wup, DM, 0, 1, 0); continue; } r -= I_UP;
        if (r < I_UP) { transpose_mat(C, r, C.in[18], DM, FFD, wup, DM, 0, 1, 1); continue; } r -= I_UP;
        if (r < I_DN) { transpose_mat(C, r, C.in[19], FFD, DM, wdn, FFD, 0, 0, 0); continue; } r -= I_DN;
        if (r < 2 * I_UQ) { const int L = r / I_UQ; transpose_mat(C, r % I_UQ, C.in[13] + (size_t)L * 256 * 384, 256, 384, wub + (size_t)L * 1024 * 384, 384, 0, 0, 0); continue; } r -= 2 * I_UQ;
        if (r < 2 * I_UKV) { const int L = r / I_UKV; transpose_mat(C, r % I_UKV, C.in[14] + (size_t)L * 128 * 512, 128, 512, wub + (size_t)L * 1024 * 384, 384, 256, 0, 384); continue; } r -= 2 * I_UKV;
        { const int L = r / I_Z, z = r % I_Z; *(v4u*)(win + (size_t)L * NPROJ * DM + (size_t)INCOLS * DM + (size_t)z * 512 + C.lane * 8) = (v4u){0u, 0u, 0u, 0u}; }
    }
}

__device__ __forceinline__ void norm_row(const float* xrow, const float* g, const float* sc, const float* sh, bf16* orow, int lane) {
    const f32x4* xr = (const f32x4*)xrow + lane; f32x4 v[4]; float s = 0.f;
#pragma unroll
    for (int j = 0; j < 4; ++j) { v[j] = xr[64 * j]; s += (v[j].x * v[j].x + v[j].y * v[j].y) + (v[j].z * v[j].z + v[j].w * v[j].w); }
    const float rinv = fast_rsqrt(wave_sum(s) * (1.f / DM) + EPS);
    unsigned long long* o8 = (unsigned long long*)orow + lane;
#pragma unroll
    for (int j = 0; j < 4; ++j) { const f32x4 gg = ((const f32x4*)g)[lane + 64 * j], s1 = ((const f32x4*)sc)[lane + 64 * j], s0 = ((const f32x4*)sh)[lane + 64 * j];
        const f32x4 y = v[j] * rinv * gg * (s1 + 1.0f) + s0;
        o8[64 * j] = (unsigned long long)pk2(y.x, y.y) | ((unsigned long long)pk2(y.z, y.w) << 32); }
}
__device__ __forceinline__ void phase_norm(const Ctx& C, int L, int which, const float* xlat, const float* xctx, bf16* H) {
    const int gw = C.vcu * NWAVES + C.wave, NGW = C.G * NWAVES;
    const float* g = (which ? C.in[7] : C.in[6]) + L * DM;
    const float* mod = (const float*)(C.ws + WS_MOD) + (size_t)L * 9 * 6144 + (which ? 3072 : 0);
    for (int m = gw; m < MROWS; m += NGW) {
        const int b = m / TT, t = m % TT; const bool isl = t >= CTXL;
        const float* xrow = isl ? xlat + ((size_t)b * SEQ + (t - CTXL)) * DM : xctx + ((size_t)b * CTXL + t) * DM;
        const float* md = mod + (size_t)(isl ? b : 8) * 6144;
        norm_row(xrow, g, md + 1024, md, H + (size_t)m * DM, C.lane);
    }
}

__device__ __forceinline__ void build_rope_tables(const Ctx& C, LAS float* tab64, LAS float* tab32) {
    for (int i = C.tid; i < 1024; i += 512) { const int pos = i >> 4, f = i & 15; const float invf = exp2f(-(float)f * (13.287712379549449f / 16.0f)); const float rev = ((float)pos * invf) * 0.15915494309189535f;
        tab64[2 * i] = __builtin_amdgcn_cosf(rev); tab64[2 * i + 1] = __builtin_amdgcn_sinf(rev); }
    for (int i = C.tid; i < 512; i += 512) { const int pos = i >> 3, f = i & 7; const float invf = exp2f(-(float)f * (13.287712379549449f / 8.0f)); const float rev = ((float)pos * invf) * 0.15915494309189535f;
        tab32[2 * i] = __builtin_amdgcn_cosf(rev); tab32[2 * i + 1] = __builtin_amdgcn_sinf(rev); }
    __syncthreads();
}
__device__ __forceinline__ size_t kimg_off(int t, int c, int tile_bytes) { return (size_t)(t >> 6) * tile_bytes + c * 1024 + (t & 63) * 16; }
__device__ __forceinline__ size_t vimg_off(int t, int c) { return (size_t)(t >> 6) * 8192 + (c >> 2) * 4096 + ((t & 63) >> 4) * 1024 + (t & 15) * 64 + (c & 3) * 16; }

__device__ __forceinline__ void phase_prep1(const Ctx& C, int L) {
    LAS float* tab64 = (LAS float*)C.lds; LAS float* tab32 = (LAS float*)(C.lds + 8192);
    build_rope_tables(C, tab64, tab32);
    const int gw = C.vcu * NWAVES + C.wave, NGW = C.G * NWAVES, lane = C.lane;
    const bf16* proj = (const bf16*)(C.ws + WS_P);
    bf16* QA = (bf16*)(C.ws + WS_QA); unsigned char* KA = C.ws + WS_KA; unsigned char* VA = C.ws + WS_VA;
    bf16* QC = (bf16*)(C.ws + WS_QC); unsigned char* KC = C.ws + WS_KC; unsigned char* VC = C.ws + WS_VC;
    bf16* CQ = (bf16*)(C.ws + WS_CQKV); bf16* KR = (bf16*)(C.ws + WS_KR);
    const float* aq = C.in[9] + L * 64; const float* ak = C.in[10] + L * 64; const float* bq = C.in[11] + L * 256; const float* bkv = C.in[12] + L * 128;
    const int hh = lane >> 3, c = lane & 7;
    const float QS = 0.125f * LOG2E;
    for (int m = gw; m < MROWS; m += NGW) {
        const int b = m / TT, t = m % TT; const bool isl = t >= CTXL; const int lp = t - CTXL, prow = (lp >> 6) & 63, pcol = lp & 63;
        const bf16* pr = proj + (size_t)m * NPROJ;
        const v4u rA = *(const v4u*)(pr + 8 * lane);
        const v4u rC = *(const v4u*)(pr + 1056 + 8 * lane);
        const v4u rB = (lane < 52) ? *(const v4u*)(pr + 640 + 8 * lane) : (v4u){0u, 0u, 0u, 0u};
        const v4u rV = (lane < 32) ? *(const v4u*)(pr + (lane < 16 ? 512 + 8 * lane : 1568 + 8 * (lane - 16))) : (v4u){0u, 0u, 0u, 0u};
        const int pos = (c >> 2) ? pcol : prow; const bool second = (c >> 1) & 1;
        const LAS float* tb = tab64 + (pos * 16 + 8 * (c & 1)) * 2;
        {
            float v[8]; unpack8(rA, v); float ss = 0.f;
#pragma unroll
            for (int e = 0; e < 8; ++e) ss += v[e] * v[e];
            ss += __shfl_xor(ss, 1); ss += __shfl_xor(ss, 2); ss += __shfl_xor(ss, 4);
            const float rinv = fast_rsqrt(ss * (1.f / 64.f) + EPS); const float* gn = (hh < 6 ? aq : ak) + 8 * c;
#pragma unroll
            for (int e = 0; e < 8; ++e) v[e] = v[e] * rinv * gn[e];
            float o[8];
#pragma unroll
            for (int e = 0; e < 8; ++e) { const float yp = __shfl_xor(v[e], 2); const float cs = tb[2 * e], sn = tb[2 * e + 1]; o[e] = isl ? (second ? v[e] * cs + yp * sn : v[e] * cs - yp * sn) : v[e]; }
            if (hh < 6) {
#pragma unroll
                for (int e = 0; e < 8; ++e) o[e] *= QS;
                *(v4u*)(QA + ((size_t)(b * 6 + hh) * TT + t) * 64 + 8 * c) = pack8(o);
            } else *(v4u*)(KA + (size_t)(b * 2 + hh - 6) * KTILES * 8192 + kimg_off(t, c, 8192)) = pack8(o);
        }
        {
            float v[8]; unpack8(rC, v); float o[8];
#pragma unroll
            for (int e = 0; e < 8; ++e) { const float yp = __shfl_xor(v[e], 2); const float cs = tb[2 * e], sn = tb[2 * e + 1]; o[e] = isl ? (second ? v[e] * cs + yp * sn : v[e] * cs - yp * sn) : v[e]; }
            if (hh < 6) {
#pragma unroll
                for (int e = 0; e < 8; ++e) o[e] *= QS;
                *(v4u*)(QC + ((size_t)(b * 6 + hh) * TT + t) * 64 + 8 * c) = pack8(o);
            } else *(v4u*)(KC + (size_t)(b * 2 + hh - 6) * KTILES * 8192 + kimg_off(t, c, 8192)) = pack8(o);
        }
        if (lane < 32) { const int l2 = lane & 15, hk = l2 >> 3, cv = l2 & 7; unsigned char* vb = (lane < 16 ? VA : VC) + (size_t)(b * 2 + hk) * KTILES * 8192 + vimg_off(t, cv); *(v4u*)vb = rV; }
        {
            float v[8]; unpack8(rB, v); float ss = 0.f;
#pragma unroll
            for (int e = 0; e < 8; ++e) ss += v[e] * v[e];
            ss += __shfl_xor(ss, 1); ss += __shfl_xor(ss, 2); ss += __shfl_xor(ss, 4); ss += __shfl_xor(ss, 8);
            const float ss32 = ss + __shfl_xor(ss, 16);
            const int c4 = lane & 3; const int pos4 = (c4 >> 1) ? pcol : prow; const LAS float* t4 = tab32 + (pos4 * 8) * 2;
            float o[8];
#pragma unroll
            for (int e = 0; e < 8; ++e) { const float yp = __shfl_xor(v[e], 1); const float cs = t4[2 * e], sn = t4[2 * e + 1]; o[e] = isl ? ((c4 & 1) ? v[e] * cs + yp * sn : v[e] * cs - yp * sn) : v[e]; }
            if (lane < 32) { const float rinv = fast_rsqrt(ss32 * (1.f / 256.f) + EPS);
#pragma unroll
                for (int e = 0; e < 8; ++e) o[e] = v[e] * rinv * bq[8 * lane + e];
                *(v4u*)(CQ + (size_t)m * 384 + 8 * lane) = pack8(o);
            } else if (lane < 48) { const float rinv = fast_rsqrt(ss * (1.f / 128.f) + EPS);
#pragma unroll
                for (int e = 0; e < 8; ++e) o[e] = v[e] * rinv * bkv[8 * (lane - 32) + e];
                *(v4u*)(CQ + (size_t)m * 384 + 256 + 8 * (lane - 32)) = pack8(o);
            } else if (lane < 52) *(v4u*)(KR + (size_t)m * 32 + 8 * (lane - 48)) = pack8(o);
        }
    }
}

__device__ __forceinline__ void phase_prep2(const Ctx& C) {
    LAS float* tab64 = (LAS float*)C.lds; LAS float* tab32 = (LAS float*)(C.lds + 8192);
    build_rope_tables(C, tab64, tab32);
    const int gw = C.vcu * NWAVES + C.wave, NGW = C.G * NWAVES, lane = C.lane;
    const bf16* raw = (const bf16*)(C.ws + WS_P); const bf16* KR = (const bf16*)(C.ws + WS_KR);
    bf16* QB = (bf16*)(C.ws + WS_QB); unsigned char* KB = C.ws + WS_KB; unsigned char* VB = C.ws + WS_VB;
    const float QS = 0.10206207261596575f * LOG2E;
    for (int m = gw; m < MROWS; m += NGW) {
        const int b = m / TT, t = m % TT; const bool isl = t >= CTXL; const int lp = t - CTXL, prow = (lp >> 6) & 63, pcol = lp & 63;
        const bf16* rr = raw + (size_t)m * 1024;
        const v4u rq = (lane < 48) ? *(const v4u*)(rr + 8 * lane) : (v4u){0u, 0u, 0u, 0u};
        const v4u rkv = *(const v4u*)(rr + 384 + 8 * lane);
        const v4u rk = (lane < 16) ? *(const v4u*)(KR + (size_t)m * 32 + 8 * (lane & 3)) : (v4u){0u, 0u, 0u, 0u};
        {
            const int h = lane / 12, cc = lane % 12, c4 = cc & 3; const int pos4 = (c4 >> 1) ? pcol : prow; const LAS float* t4 = tab32 + (pos4 * 8) * 2;
            float v[8]; unpack8(rq, v); float o[8];
#pragma unroll
            for (int e = 0; e < 8; ++e) { const float yp = __shfl_xor(v[e], 1); const float cs = t4[2 * e], sn = t4[2 * e + 1]; const float rot = (c4 & 1) ? v[e] * cs + yp * sn : v[e] * cs - yp * sn; o[e] = ((isl && cc >= 8) ? rot : v[e]) * QS; }
            if (lane < 48) *(v4u*)(QB + ((size_t)(b * 4 + h) * TT + t) * 96 + 8 * cc) = pack8(o);
        }
        {
            const int h = lane >> 4, part = (lane >> 3) & 1, c = lane & 7;
            if (part == 0) *(v4u*)(KB + (size_t)(b * 4 + h) * KTILES * 12288 + kimg_off(t, c, 12288)) = rkv;
            else *(v4u*)(VB + (size_t)(b * 4 + h) * KTILES * 8192 + vimg_off(t, c)) = rkv;
        }
        if (lane < 16) { const int h = lane >> 2, c = lane & 3; *(v4u*)(KB + (size_t)(b * 4 + h) * KTILES * 12288 + kimg_off(t, 8 + c, 12288)) = rk; }
    }
}

__device__ __forceinline__ void phase_attn(const Ctx& C, int L) {
    const bf16* QA = (const bf16*)(C.ws + WS_QA); const bf16* QB = (const bf16*)(C.ws + WS_QB); const bf16* QC = (const bf16*)(C.ws + WS_QC);
    const unsigned char* KA = C.ws + WS_KA; const unsigned char* VA = C.ws + WS_VA; const unsigned char* KB = C.ws + WS_KB; const unsigned char* VB = C.ws + WS_VB;
    const unsigned char* KC = C.ws + WS_KC; const unsigned char* VC = C.ws + WS_VC;
    bf16* mix = (bf16*)(C.ws + WS_H);
    const float* sinks = C.in[15] + L * 6;
    const int with_ctx = (L == 0);
    for (int idx = C.vcu; idx < 512 + (with_ctx ? 32 : 0); idx += C.G) {
        att::UnitDesc u; int b, h, row0;
        if (idx < 512) { b = idx >> 6; h = (idx >> 4) & 3; row0 = CTXL + (idx & 15) * 256; u.n0 = KTILES; }
        else { const int j = idx - 512; b = j >> 2; h = j & 3; row0 = 0; u.n0 = 4; }
        u.Q = QB + ((size_t)(b * 4 + h) * TT + row0) * 96; u.Kimg = KB + (size_t)(b * 4 + h) * KTILES * 12288; u.Vimg = VB + (size_t)(b * 4 + h) * KTILES * 8192;
        u.O = mix + ((size_t)b * TT + row0) * DM + 384 + h * 64; u.s1t0 = 0; u.n1 = 0; u.qpos0 = 0; u.minit = att::NEGBIG; u.linit = 0.f;
        att::unit<96, false>(C.lds, u);
    }
    for (int idx = C.vcu; idx < 768 + (with_ctx ? 96 : 0); idx += C.G) {
        att::UnitDesc u; int b, h, row0, isC = 0;
        if (idx < 768) { b = idx / 96; h = (idx >> 4) % 6; row0 = CTXL + (idx & 15) * 256; u.n0 = KTILES; }
        else { int j = idx - 768; if (j >= 48) { j -= 48; isC = 1; } b = j / 6; h = j % 6; row0 = 0; u.n0 = 4; }
        const int hk = h / 3;
        u.Q = (isC ? QC : QA) + ((size_t)(b * 6 + h) * TT + row0) * 64; u.Kimg = (isC ? KC : KA) + (size_t)(b * 2 + hk) * KTILES * 8192; u.Vimg = (isC ? VC : VA) + (size_t)(b * 2 + hk) * KTILES * 8192;
        u.O = mix + ((size_t)b * TT + row0) * DM + (isC ? 640 : 0) + h * 64; u.s1t0 = 0; u.n1 = 0; u.qpos0 = 0;
        u.minit = isC ? sinks[h] * LOG2E : att::NEGBIG; u.linit = isC ? 1.f : 0.f;
        att::unit<64, false>(C.lds, u);
    }
    for (int idx = C.vcu; idx < 768; idx += C.G) {
        att::UnitDesc u; const int b = idx / 96, h = (idx >> 4) % 6, qb = idx & 15, hk = h / 3, row0 = CTXL + qb * 256;
        const int lt0 = 4 * qb - 2, ls = lt0 < 0 ? 0 : lt0, le = (lt0 + 10 > 64) ? 64 : lt0 + 10;
        u.Q = QC + ((size_t)(b * 6 + h) * TT + row0) * 64; u.Kimg = KC + (size_t)(b * 2 + hk) * KTILES * 8192; u.Vimg = VC + (size_t)(b * 2 + hk) * KTILES * 8192;
        u.O = mix + ((size_t)b * TT + row0) * DM + 640 + h * 64; u.n0 = 4; u.s1t0 = 4 + ls; u.n1 = le - ls; u.qpos0 = qb * 256;
        u.minit = sinks[h] * LOG2E; u.linit = 1.f;
        att::unit<64, true>(C.lds, u);
    }
}

__device__ __forceinline__ void phase_route1(const Ctx& C) {
    LAS float* wr = (LAS float*)C.lds;
    LAS int* hist = (LAS int*)(C.lds + 32768);
    const float* wrg = C.in[20];
    for (int i = C.tid; i < 8192; i += 512) wr[i] = wrg[i];
    if (C.tid < 8) hist[C.tid] = 0;
    __syncthreads();
    const float* g = C.in[7] + DM; const float* mod = (const float*)(C.ws + WS_MOD) + (size_t)9 * 6144 + 3072;
    bf16* H = (bf16*)(C.ws + WS_H);
    int* tope = (int*)(C.ws + WS_RT + RT_TOPE); float* gate = (float*)(C.ws + WS_RT + RT_GATE);
    const int TPW = NLAT / C.G;
    for (int i = C.wave; i < TPW; i += NWAVES) {
        const int n = C.wg * TPW + i, b = n / SEQ;
        const f32x4* xr = (const f32x4*)(C.out + (size_t)n * DM) + C.lane; f32x4 v[4]; float s = 0.f;
#pragma unroll
        for (int j = 0; j < 4; ++j) { v[j] = xr[64 * j]; s += (v[j].x * v[j].x + v[j].y * v[j].y) + (v[j].z * v[j].z + v[j].w * v[j].w); }
        const float rinv = fast_rsqrt(wave_sum(s) * (1.f / DM) + EPS);
        const float* md = mod + (size_t)b * 6144;
        unsigned long long* o8 = (unsigned long long*)(H + (size_t)n * DM) + C.lane;
        float lg[8];
#pragma unroll
        for (int e = 0; e < 8; ++e) lg[e] = 0.f;
#pragma unroll
        for (int j = 0; j < 4; ++j) { const f32x4 gg = ((const f32x4*)g)[C.lane + 64 * j], s1 = ((const f32x4*)(md + 1024))[C.lane + 64 * j], s0 = ((const f32x4*)md)[C.lane + 64 * j];
            const f32x4 y = v[j] * rinv * gg * (s1 + 1.0f) + s0;
            o8[64 * j] = (unsigned long long)pk2(y.x, y.y) | ((unsigned long long)pk2(y.z, y.w) << 32);
#pragma unroll
            for (int q = 0; q < 4; ++q) { const int k = 4 * C.lane + 256 * j + q; const f32x4 w0 = *(const LAS f32x4*)(wr + k * 8), w1 = *(const LAS f32x4*)(wr + k * 8 + 4); const float yy = y[q];
                lg[0] += yy * w0.x; lg[1] += yy * w0.y; lg[2] += yy * w0.z; lg[3] += yy * w0.w; lg[4] += yy * w1.x; lg[5] += yy * w1.y; lg[6] += yy * w1.z; lg[7] += yy * w1.w; } }
#pragma unroll
        for (int e = 0; e < 8; ++e) lg[e] = wave_sum(lg[e]);
        int e1 = 0; float l1 = lg[0];
#pragma unroll
        for (int e = 1; e < 8; ++e) if (lg[e] > l1) { l1 = lg[e]; e1 = e; }
        int e2 = -1; float l2 = -3.0e38f;
#pragma unroll
        for (int e = 0; e < 8; ++e) if (e != e1 && lg[e] > l2) { l2 = lg[e]; e2 = e; }
        const float g2 = 1.0f / (1.0f + __expf(l1 - l2)), g1 = 1.0f - g2;
        if (C.lane == 0) { tope[2 * n] = e1; tope[2 * n + 1] = e2; gate[2 * n] = g1; gate[2 * n + 1] = g2; __hip_atomic_fetch_add(hist + e1, 1, __ATOMIC_RELAXED, __HIP_MEMORY_SCOPE_WORKGROUP); __hip_atomic_fetch_add(hist + e2, 1, __ATOMIC_RELAXED, __HIP_MEMORY_SCOPE_WORKGROUP); }
    }
    __syncthreads();
    if (C.tid < 8) ((int*)(C.ws + WS_RT + RT_HIST))[C.wg * 8 + C.tid] = hist[C.tid];
    __syncthreads();
    const int gw = C.vcu * NWAVES + C.wave, NGW = C.G * NWAVES;
    bf16* wmup = (bf16*)(C.ws + WS_WMUP); bf16* wmdn = (bf16*)(C.ws + WS_WMDN);
    constexpr int I_UP = 16 * 112, I_DN = 56 * 32;
    for (int it = gw; it < NEXP * (2 * I_UP + I_DN); it += NGW) {
        const int e = it / (2 * I_UP + I_DN); int r = it % (2 * I_UP + I_DN);
        if (r < I_UP) { transpose_mat(C, r, C.in[21] + (size_t)e * DM * FFE, DM, FFE, wmup + (size_t)e * 2 * FFE * DM, DM, 0, 1, 0); continue; } r -= I_UP;
        if (r < I_UP) { transpose_mat(C, r, C.in[22] + (size_t)e * DM * FFE, DM, FFE, wmup + (size_t)e * 2 * FFE * DM, DM, 0, 1, 1); continue; } r -= I_UP;
        transpose_mat(C, r, C.in[23] + (size_t)e * FFE * DM, FFE, DM, wmdn + (size_t)e * DM * FFE, FFE, 0, 0, 0);
    }
}

__device__ __forceinline__ void phase_route2(const Ctx& C) {
    LAS int* hl = (LAS int*)C.lds;
    LAS int* cnt = (LAS int*)(C.lds + 16384); LAS int* pre = cnt + 8; LAS int* off = cnt + 16;
    LAS int* ep = (LAS int*)(C.lds + 20480); LAS int* posl = ep + 512;
    const int* hist = (const int*)(C.ws + WS_RT + RT_HIST);
    for (int i = C.tid; i < C.G * 8; i += 512) hl[i] = hist[i];
    __syncthreads();
    if (C.tid < 8) { int s = 0, p = 0; for (int w = 0; w < C.G; ++w) { const int hv = hl[w * 8 + C.tid]; if (w < C.wg) p += hv; s += hv; } cnt[C.tid] = s; pre[C.tid] = p; }
    __syncthreads();
    if (C.tid == 0) { int o = 0; for (int e = 0; e < 8; ++e) { off[e] = o; o += (cnt[e] + 255) & ~255; } off[8] = o; }
    __syncthreads();
    const int TPW = NLAT / C.G, NP = 2 * TPW;
    const int* tope = (const int*)(C.ws + WS_RT + RT_TOPE); int* posg = (int*)(C.ws + WS_RT + RT_POS);
    for (int p = C.tid; p < NP; p += 512) ep[p] = tope[2 * (C.wg * TPW) + p];
    __syncthreads();
    for (int p = C.tid; p < NP; p += 512) { const int e = ep[p]; int rank = 0; for (int q = 0; q < p; ++q) rank += (ep[q] == e) ? 1 : 0; const int pos = off[e] + pre[e] + rank; posl[p] = pos; posg[2 * (C.wg * TPW) + p] = pos; }
    __syncthreads();
    const bf16* H = (const bf16*)(C.ws + WS_H); bf16* HFS = (bf16*)(C.ws + WS_HFS);
    for (int i = C.wave; i < TPW; i += NWAVES) {
        const int n = C.wg * TPW + i; const v4u* src = (const v4u*)(H + (size_t)n * DM) + C.lane; const v4u a = src[0], b2 = src[64];
        v4u* d0 = (v4u*)(HFS + (size_t)posl[2 * i] * DM) + C.lane; v4u* d1 = (v4u*)(HFS + (size_t)posl[2 * i + 1] * DM) + C.lane;
        d0[0] = a; d0[64] = b2; d1[0] = a; d1[64] = b2;
    }
    int* tile_e = (int*)(C.ws + WS_RT + RT_TILEE);
    if (C.wg == 0) { for (int tl = C.tid; tl < 272; tl += 512) { int e = 7; for (int q = 7; q >= 0; --q) if (tl * 256 < off[q + 1]) e = q; tile_e[tl] = e; } if (C.tid == 0) tile_e[272] = off[8] >> 8; }
    if (C.wg < 8) { const int e = C.wg; for (int r = off[e] + cnt[e] + C.wave; r < off[e + 1]; r += NWAVES) { v4u* d = (v4u*)(HFS + (size_t)r * DM) + C.lane; d[0] = (v4u){0u, 0u, 0u, 0u}; d[64] = (v4u){0u, 0u, 0u, 0u}; } }
}

__device__ __forceinline__ void phase_final(const Ctx& C) {
    const int gw = C.vcu * NWAVES + C.wave, NGW = C.G * NWAVES;
    const bf16* Y = (const bf16*)(C.ws + WS_HFS); const int* posg = (const int*)(C.ws + WS_RT + RT_POS); const float* gate = (const float*)(C.ws + WS_RT + RT_GATE);
    const float* mod = (const float*)(C.ws + WS_MOD) + (size_t)9 * 6144 + 5120; const float* fn = C.in[24];
    for (int n = gw; n < NLAT; n += NGW) {
        const int b = n / SEQ; const int p0 = posg[2 * n], p1 = posg[2 * n + 1]; const float g0 = gate[2 * n], g1 = gate[2 * n + 1];
        f32x4* xr = (f32x4*)(C.out + (size_t)n * DM) + C.lane; const float* gt = mod + (size_t)b * 6144;
        const unsigned long long* y0 = (const unsigned long long*)(Y + (size_t)p0 * DM) + C.lane; const unsigned long long* y1 = (const unsigned long long*)(Y + (size_t)p1 * DM) + C.lane;
        f32x4 v[4]; float s = 0.f;
#pragma unroll
        for (int j = 0; j < 4; ++j) { const f32x4 x = xr[64 * j]; const unsigned long long a = y0[64 * j], c = y1[64 * j]; const f32x4 gg = ((const f32x4*)gt)[C.lane + 64 * j];
            f32x4 ya, yc; ya.x = bflo((unsigned)a); ya.y = bfhi((unsigned)a); ya.z = bflo((unsigned)(a >> 32)); ya.w = bfhi((unsigned)(a >> 32));
            yc.x = bflo((unsigned)c); yc.y = bfhi((unsigned)c); yc.z = bflo((unsigned)(c >> 32)); yc.w = bfhi((unsigned)(c >> 32));
            v[j] = x + gg * (ya * g0 + yc * g1); s += (v[j].x * v[j].x + v[j].y * v[j].y) + (v[j].z * v[j].z + v[j].w * v[j].w); }
        const float rinv = fast_rsqrt(wave_sum(s) * (1.f / DM) + EPS);
#pragma unroll
        for (int j = 0; j < 4; ++j) xr[64 * j] = v[j] * rinv * ((const f32x4*)fn)[C.lane + 64 * j];
    }
}

#ifndef MK_SPLIT
#define MK_SPLIT 0
#endif
constexpr int N_PHASES = 31;
#define GP_ALIGN true
#define GP_SP2 true


#ifndef PH_MASK
#define PH_MASK 0x7fffffffu
#endif
#define IN(k) (((PH_MASK >> (k)) & 1u) && lo <= (k) && (k) < hi)
#define SEAM(k) do { if (IN(k) && IN((k) + 1)) xcd_barrier(bar); } while (0)
template <int L>
__device__ __forceinline__ void layer_phases(const Ctx& C, const Args& args, const XcdBarrier& bar, const int lo, const int hi) {
    unsigned char* ws = C.ws;
    float* xc = (float*)(ws + WS_XC);
    bf16* Hb = (bf16*)(ws + WS_H);
    const float* modall = (const float*)(ws + WS_MOD);
        const int pb = 1 + 10 * L;
        const float* xlat = (L == 0) ? args.in[0] : (const float*)args.out;
        const float* xctx = (L == 0) ? args.in[2] : (const float*)xc;
        const float* modL = modall + (size_t)L * 9 * 6144;
        if (IN(pb + 0)) { phase_norm(C, L, 0, xlat, xctx, Hb); SEAM(pb + 0); }
        if (IN(pb + 1)) {
            pg8::Gemm g{(const pg8::bf16_t*)Hb, (const pg8::bf16_t*)(ws + WS_WIN) + (size_t)L * NPROJ * DM, MROWS, NPROJ, DM};
            TileSched S; S.init(MROWS / 256, NPROJ / 256, C.G, C.wg, 0);
            EpiStoreBf16 E{(pg8::bf16_t*)(ws + WS_P), NPROJ, NPROJ / 256, 0};
            pg8::gemm_phase<EpiStoreBf16, TileSched, GP_ALIGN, GP_SP2>(C.lds, g, S, E);
            SEAM(pb + 1);
        }
        if (IN(pb + 2)) { phase_prep1(C, L); SEAM(pb + 2); }
        if (IN(pb + 3)) {
            pg8::Gemm g{(const pg8::bf16_t*)(ws + WS_CQKV), (const pg8::bf16_t*)(ws + WS_WUB) + (size_t)L * 1024 * 384, MROWS, 1024, 384};
            TileSched S; S.init(MROWS / 256, 4, C.G, C.wg, 0);
            EpiStoreBf16 E{(pg8::bf16_t*)(ws + WS_P), 1024, 4, 0};
            pg8::gemm_phase<EpiStoreBf16, TileSched, GP_ALIGN, GP_SP2>(C.lds, g, S, E);
            SEAM(pb + 3);
        }
        if (IN(pb + 4)) { phase_prep2(C); SEAM(pb + 4); }
        if (IN(pb + 5)) { phase_attn(C, L); SEAM(pb + 5); }
        if (IN(pb + 6)) {
            pg8::Gemm g{(const pg8::bf16_t*)Hb, (const pg8::bf16_t*)(ws + WS_WOUT) + (size_t)L * DM * DM, MROWS, DM, DM};
            TileSched S; S.init(L == 0 ? MROWS / 256 : NLAT / 256, 4, C.G, C.wg, L == 0 ? 0 : 1);
            EpiResid E{xlat, xctx, args.out, xc, modL + 2048};
            pg8::gemm_phase<EpiResid, TileSched, GP_ALIGN, GP_SP2>(C.lds, g, S, E);
            SEAM(pb + 6);
        }
        if (L == 0) {
            if (IN(8)) { phase_norm(C, 0, 1, args.out, xc, Hb); SEAM(8); }
            if (IN(9)) {
                pg8::Gemm g{(const pg8::bf16_t*)Hb, (const pg8::bf16_t*)(ws + WS_WUP), MROWS, 2 * FFD, DM};
                TileSched S; S.init(MROWS / 256, 2 * FFD / 256, C.G, C.wg, 0);
                EpiSwiglu E{(pg8::bf16_t*)(ws + WS_U), FFD, 2 * FFD / 256, 0};
                pg8::gemm_phase<EpiSwiglu, TileSched, GP_ALIGN, GP_SP2>(C.lds, g, S, E);
                SEAM(9);
            }
            if (IN(10)) {
                pg8::Gemm g{(const pg8::bf16_t*)(ws + WS_U), (const pg8::bf16_t*)(ws + WS_WDN), MROWS, DM, FFD};
                TileSched S; S.init(MROWS / 256, 4, C.G, C.wg, 0);
                EpiResid E{args.out, xc, args.out, xc, modL + 5120};
                pg8::gemm_phase<EpiResid, TileSched, GP_ALIGN, GP_SP2>(C.lds, g, S, E);
                SEAM(10);
            }
        }
    }

__global__ void __launch_bounds__(NWAVES * 64, 2) mk_fwd(Args args) {
    extern __shared__ __attribute__((aligned(16))) unsigned char lds_raw[];
    Ctx C;
    C.lds = (LAS unsigned char*)lds_raw;
    C.tid = threadIdx.x; C.lane = C.tid & 63; C.wave = __builtin_amdgcn_readfirstlane(C.tid >> 6);
    C.G = gridDim.x; C.wg = blockIdx.x; { const int bx = blockIdx.x; C.vcu = (C.G % 8 == 0) ? (bx % 8) * (C.G / 8) + bx / 8 : bx; }
    C.in = args.in; C.out = args.out; C.ws = args.ws;
    volatile LAS unsigned* MISC = (volatile LAS unsigned*)(C.lds + MISC_OFF);
    for (int u = C.tid; u < (LDS_BYTES - LDSCTL_OFF) / 4; u += NWAVES * 64) ((LAS unsigned*)(C.lds + LDSCTL_OFF))[u] = 0u;
    __syncthreads();
    unsigned* ctl = (unsigned*)(C.ws + WS_CTL);
    XcdBarrier bar = xcd_barrier_post(ctl + CW_BAR, MISC + 8);
    const int lo = args.ph_lo, hi = args.ph_hi;
    unsigned char* ws = C.ws;
    float* xc = (float*)(ws + WS_XC);
    bf16* Hb = (bf16*)(ws + WS_H);
    const float* modall = (const float*)(ws + WS_MOD);

    if (IN(0)) { phase_prologue(C); SEAM(0); }

    layer_phases<0>(C, args, bar, lo, hi);
    layer_phases<1>(C, args, bar, lo, hi);
    if (IN(18)) { phase_route1(C); SEAM(18); }
    if (IN(19)) { phase_route2(C); SEAM(19); }
    {
        const int* tile_e = (const int*)(ws + WS_RT + RT_TILEE);
        for (int ch = 0; ch < MOE_NCH; ++ch) {
            const int pu = 20 + 2 * ch;
            int ntiles = 0;
            if (IN(pu) || IN(pu + 1)) ntiles = __builtin_amdgcn_readfirstlane(__hip_atomic_load(tile_e + 272, __ATOMIC_RELAXED, __HIP_MEMORY_SCOPE_AGENT));
            int ntc = ntiles - MOE_CH * ch; ntc = ntc < 0 ? 0 : (ntc > MOE_CH ? MOE_CH : ntc);
            if (IN(pu)) {
                pg8::Gemm g{(const pg8::bf16_t*)(ws + WS_HFS), (const pg8::bf16_t*)(ws + WS_WMUP), MOE_MAXT * 256, NEXP * 2 * FFE, DM};
                MoeSched S{tile_e, MOE_CH * ch, ntc, 2 * FFE / 256, C.G, C.wg, 1};
                EpiSwiglu E{(pg8::bf16_t*)(ws + WS_UM), FFE, 2 * FFE / 256, -MOE_CH * ch};
                pg8::gemm_phase<EpiSwiglu, MoeSched, GP_ALIGN, GP_SP2>(C.lds, g, S, E);
                SEAM(pu);
            }
            if (IN(pu + 1)) {
                pg8::Gemm g{(const pg8::bf16_t*)(ws + WS_UM), (const pg8::bf16_t*)(ws + WS_WMDN), MOE_CH * 256, NEXP * DM, FFE};
                MoeSched S{tile_e, MOE_CH * ch, ntc, 4, C.G, C.wg, 0};
                EpiStoreBf16 E{(pg8::bf16_t*)(ws + WS_HFS), DM, 4, MOE_CH * ch};
                pg8::gemm_phase<EpiStoreBf16, MoeSched, GP_ALIGN, GP_SP2>(C.lds, g, S, E);
                SEAM(pu + 1);
            }
        }
    }
    if (IN(30)) { phase_final(C); }
#undef IN
#undef SEAM
}

extern "C" void kernel_launch(void* const* d_in, const int* in_sizes, int n_in, void* d_out, int out_size, void* d_ws, size_t ws_size, hipStream_t stream) {
    static int grid = 0;
    if (grid == 0) {
        if (n_in != 25 || in_sizes[0] != NLAT * DM || out_size != NLAT * DM || ws_size < WS_END) { fprintf(stderr, "kernel_launch: unexpected shapes (n_in %d, in0 %d, out %d, ws %zu < %zu)\n", n_in, n_in > 0 ? in_sizes[0] : -1, out_size, ws_size, (size_t)WS_END); grid = -1; return; }
        int dev = 0, cus = 0, per_cu = 0;
        if (hipGetDevice(&dev) != hipSuccess || hipDeviceGetAttribute(&cus, hipDeviceAttributeMultiprocessorCount, dev) != hipSuccess) { grid = -1; return; }
        if (hipFuncSetAttribute((const void*)mk_fwd, hipFuncAttributeMaxDynamicSharedMemorySize, LDS_BYTES) != hipSuccess) { fprintf(stderr, "kernel_launch: hipFuncSetAttribute failed\n"); grid = -1; return; }
        if (hipOccupancyMaxActiveBlocksPerMultiprocessor(&per_cu, (const void*)mk_fwd, NWAVES * 64, LDS_BYTES) != hipSuccess || per_cu < 1) fprintf(stderr, "kernel_launch: occupancy query reports %d\n", per_cu);
        (void)hipGetLastError();
        grid = 256;
        if (cus < 256) { fprintf(stderr, "kernel_launch: %d CUs < 256\n", cus); grid = -1; return; }
    }
    if (grid < 0) return;
    if (hipMemsetAsync((char*)d_ws, 0, ZERO_BYTES, stream) != hipSuccess) return;
    Args a{};
    for (int i = 0; i < 25; ++i) a.in[i] = (const float*)d_in[i];
    a.out = (float*)d_out; a.ws = (unsigned char*)d_ws;
#if MK_SPLIT
    for (int p = 0; p < N_PHASES; ++p) { a.ph_lo = p; a.ph_hi = p + 1; hipLaunchKernelGGL(mk_fwd, dim3(grid), dim3(NWAVES * 64), LDS_BYTES, stream, a); }
#else
    a.ph_lo = 0; a.ph_hi = N_PHASES;
    hipLaunchKernelGGL(mk_fwd, dim3(grid), dim3(NWAVES * 64), LDS_BYTES, stream, a);
#endif
}
```

```cpp
#include <hip/hip_runtime.h>
#include <cstdio>
#include <cstdint>
namespace pg8 {
#define PG8_LAS __attribute__((address_space(3)))
typedef unsigned short bf16_t;
typedef short bf16x8 __attribute__((ext_vector_type(8)));
typedef float f32x4 __attribute__((ext_vector_type(4)));
typedef unsigned u32x4 __attribute__((ext_vector_type(4)));
constexpr int BM = 256, BK = 64, HALF = 128, HTB = HALF * BK * 2  , STAGE_BYTES = 8 * HTB, NXCD = 8, WGM = 8;

__host__ __device__ __forceinline__ int lds_byte(int r, int c) { const int st = (r >> 4) * 2 + (c >> 5), rr = r & 15, cc = c & 31, ob = rr * 64 + cc * 2; return st * 1024 + (ob ^ (((ob >> 9) & 1) << 5)); }
__host__ __device__ __forceinline__ void stage_rc(int b, int& R, int& C) { const int st = b / 1024, sb = b % 1024, swz = sb ^ (((sb >> 9) & 1) << 5); R = (st >> 1) * 16 + swz / 64; C = (st & 1) * 32 + (swz % 64) / 2; }
__host__ __device__ __forceinline__ int perm32(int rho) { const int n = rho >> 4, i = rho & 15; return 8 * (i >> 2) + 4 * n + (i & 3); }

struct Unit { int pm, pn, ks; };
struct Gemm { const bf16_t* A; const bf16_t* Bt; int M, N, K; int KL = 0, KLL = 0, NKS = 0, KO1 = -1; };

struct StaticOrder {
    int nM, nN, nwg, G, c;
    __host__ __device__ void init(int M, int N, int G_, int c_) { nM = M / BM; nN = N / BM; nwg = nM * nN; G = G_; c = c_; }
    __host__ __device__ bool next(int i, Unit& u) const {
        const long L = (long)i * G + c; if (L >= nwg) return false;
        int wgid = (int)L; { const int q = nwg / NXCD, r = nwg % NXCD, xcd = wgid % NXCD, off = wgid / NXCD; wgid = (xcd < r ? xcd * (q + 1) : r * (q + 1) + (xcd - r) * q) + off; }
        const int nig = WGM * nN, gid = wgid / nig, fm = gid * WGM, gsz = (nM - fm) < WGM ? (nM - fm) : WGM;
        u.pm = fm + ((wgid % nig) % gsz); u.pn = (wgid % nig) / gsz; return true;
    }
    __device__ __forceinline__ void a_ready(const Unit&) const {}
    __device__ __forceinline__ void done(const Unit&) const {}
};

__device__ __forceinline__ unsigned cvt_pk_bf16(float lo, float hi) { unsigned r; asm volatile("v_cvt_pk_bf16_f32 %0, %1, %2" : "=v"(r) : "v"(lo), "v"(hi)); return r; }
typedef float f32x2 __attribute__((ext_vector_type(2)));
typedef int i32x4_t __attribute__((ext_vector_type(4))); typedef int i32x8_t __attribute__((ext_vector_type(8)));
__device__ __forceinline__ i32x8_t cat8(bf16x8 a, bf16x8 b) { return __builtin_shufflevector(__builtin_bit_cast(i32x4_t, a), __builtin_bit_cast(i32x4_t, b), 0, 1, 2, 3, 4, 5, 6, 7); }
template <class Epi, class Sched, bool ALIGN_EPI = false, bool SP2 = false, bool F8 = false, bool KSPLIT = false>
__device__ __forceinline__ void gemm_phase(PG8_LAS unsigned char* lds, const Gemm g, const Sched& S, const Epi& E) {
    const int tid = threadIdx.x, wid = __builtin_amdgcn_readfirstlane(tid >> 6), lane = tid & 63, wr = wid >> 2, wc = wid & 3, fr = lane & 15, fq = lane >> 4;
    const int K = g.K; int nt = (KSPLIT ? g.KL : K) / BK;
    const size_t ksb = KSPLIT ? (size_t)g.KL * 2 : 0;
    unsigned voffA[2], voffB[2];
#pragma unroll
    for (int i = 0; i < 2; ++i) { int R, C; stage_rc(tid * 16 + i * 8192, R, C); const int Rb = Epi::PERM ? ((R & ~31) + perm32(R & 31)) : R;
        voffA[i] = (unsigned)(R * K + C) * 2u; voffB[i] = (unsigned)(Rb * K + C) * 2u; }
    const size_t kstep = (size_t)(BK * 2);
    const size_t hstep = (size_t)HALF * K * 2;
    const size_t tstep = 2 * hstep;
    const unsigned ldsw = (unsigned)wid * 1024u;
    const int aoff = lds_byte(wr * 64 + fr, fq * 8), boff = lds_byte(wc * 32 + fr, fq * 8);
#define PG8_SA(b, h) (((b) * 2 + (h)) * HTB)
#define PG8_SB(b, h) ((4 + (b) * 2 + (h)) * HTB)
#define PG8_STAGE(bufoff, gbase, voff) do { _Pragma("unroll") for (int _i = 0; _i < 2; ++_i) \
        __builtin_amdgcn_global_load_lds((const unsigned*)((const char*)(gbase) + (voff)[_i]), (PG8_LAS unsigned*)(lds + (bufoff) + ldsw + _i * 8192), 16, 0, 0); } while (0)
#define PG8_LDA(dst, b, h) do { if constexpr (F8) { _Pragma("unroll") for (int m = 0; m < 4; ++m) dst##8[m] = cat8(*(const PG8_LAS bf16x8*)(lds + PG8_SA(b, h) + aoff + m * 2048), *(const PG8_LAS bf16x8*)(lds + PG8_SA(b, h) + aoff + m * 2048 + 1024)); } else { \
        _Pragma("unroll") for (int m = 0; m < 4; ++m) _Pragma("unroll") for (int k = 0; k < 2; ++k) dst[m][k] = *(const PG8_LAS bf16x8*)(lds + PG8_SA(b, h) + aoff + m * 2048 + k * 1024); } } while (0)
#define PG8_LDB(dst, b, h) do { if constexpr (F8) { _Pragma("unroll") for (int n = 0; n < 2; ++n) dst##8[n] = cat8(*(const PG8_LAS bf16x8*)(lds + PG8_SB(b, h) + boff + n * 2048), *(const PG8_LAS bf16x8*)(lds + PG8_SB(b, h) + boff + n * 2048 + 1024)); } else { \
        _Pragma("unroll") for (int n = 0; n < 2; ++n) _Pragma("unroll") for (int k = 0; k < 2; ++k) dst[n][k] = *(const PG8_LAS bf16x8*)(lds + PG8_SB(b, h) + boff + n * 2048 + k * 1024); } } while (0)
#define PG8_MMA(ai, bj, At, Bt) do { __builtin_amdgcn_s_setprio(1); if constexpr (F8) { _Pragma("unroll") for (int m = 0; m < 4; ++m) _Pragma("unroll") for (int n = 0; n < 2; ++n) \
        asm volatile("v_mfma_f32_16x16x128_f8f6f4 %0, %1, %2, %0" : "+v"(acc[ai][bj][m][n]) : "v"(Bt##8[n]), "v"(At##8[m])); } else { \
        _Pragma("unroll") for (int m = 0; m < 4; ++m) _Pragma("unroll") for (int n = 0; n < 2; ++n) _Pragma("unroll") for (int k = 0; k < 2; ++k) \
        acc[ai][bj][m][n] = __builtin_amdgcn_mfma_f32_16x16x32_bf16(Bt[n][k], At[m][k], acc[ai][bj][m][n], 0, 0, 0); } __builtin_amdgcn_s_setprio(0); } while (0)
#define PG8_WAIT_V(n) asm volatile("s_waitcnt vmcnt(" #n ")" ::: "memory")
#define PG8_WAIT_L(n) asm volatile("s_waitcnt lgkmcnt(" #n ")" ::: "memory")
#define PG8_BAR __builtin_amdgcn_s_barrier()
#define PG8_SCHED __builtin_amdgcn_sched_barrier(0)
    Unit cur, nxt; int ui = 0;
    if (!S.next(0, cur)) return;
    f32x4 acc[2][2][4][2];
#pragma unroll
    for (int a = 0; a < 2; ++a)
#pragma unroll
        for (int b = 0; b < 2; ++b)
#pragma unroll
            for (int m = 0; m < 4; ++m)
#pragma unroll
                for (int n = 0; n < 2; ++n) acc[a][b][m][n] = (f32x4){0.f, 0.f, 0.f, 0.f};
    bf16x8 At[4][2], B0[2][2], B1[2][2]; i32x8_t At8[4], B08[2], B18[2];
    const char* cA = (const char*)g.A + (size_t)cur.pm * tstep; const char* cB = (const char*)g.Bt + (size_t)cur.pn * tstep;
    if constexpr (KSPLIT) { const size_t ko = (g.KO1 >= 0) ? (cur.ks ? (size_t)g.KO1 : 0) : (size_t)cur.ks * ksb; cA += ko; cB += ko; if (g.KLL && cur.ks == g.NKS - 1) nt = g.KLL / BK; }
    S.a_ready(cur);
    if constexpr (SP2) {
        PG8_STAGE(PG8_SB(0, 0), cB, voffB); PG8_STAGE(PG8_SB(0, 1), cB + hstep, voffB); PG8_STAGE(PG8_SA(0, 0), cA, voffA); PG8_STAGE(PG8_SA(0, 1), cA + hstep, voffA);
        if (wr == 1) PG8_BAR;
        PG8_WAIT_V(2); PG8_BAR;
        PG8_STAGE(PG8_SB(1, 0), cB + kstep, voffB); PG8_STAGE(PG8_SA(1, 0), cA + kstep, voffA); PG8_STAGE(PG8_SB(1, 1), cB + hstep + kstep, voffB);
        PG8_WAIT_V(6); PG8_BAR;
    } else {
        PG8_STAGE(PG8_SB(0, 0), cB, voffB); PG8_STAGE(PG8_SA(0, 0), cA, voffA); PG8_STAGE(PG8_SB(0, 1), cB + hstep, voffB); PG8_STAGE(PG8_SA(0, 1), cA + hstep, voffA);
        if (wr == 1) PG8_BAR;
        PG8_WAIT_V(4); PG8_BAR;
        PG8_STAGE(PG8_SB(1, 0), cB + kstep, voffB); PG8_STAGE(PG8_SA(1, 0), cA + kstep, voffA); PG8_STAGE(PG8_SB(1, 1), cB + hstep + kstep, voffB);
        PG8_WAIT_V(6); PG8_BAR;
    }
    for (;;) {
        const bool has_next = S.next(ui + 1, nxt);
        const size_t nko = KSPLIT ? ((g.KO1 >= 0) ? (nxt.ks ? (size_t)g.KO1 : 0) : (size_t)nxt.ks * ksb) : 0;
        const char* nA = has_next ? (const char*)g.A + (size_t)nxt.pm * tstep + nko : cA; const char* nB = has_next ? (const char*)g.Bt + (size_t)nxt.pn * tstep + nko : cB;
        for (int t = 0; t < nt; t += 2) {
            const bool last = (t == nt - 2);
            const char* a1 = cA + (size_t)(t + 1) * kstep;
            const char* a2 = last ? nA : cA + (size_t)(t + 2) * kstep; const char* b2 = last ? nB : cB + (size_t)(t + 2) * kstep;
            const char* a3 = a2 + kstep; const char* b3 = b2 + kstep;
            if (last && has_next) S.a_ready(nxt);
            if constexpr (SP2) {
            PG8_LDB(B0, 0, 0); PG8_LDB(B1, 0, 1); PG8_SCHED; PG8_LDA(At, 0, 0); PG8_STAGE(PG8_SA(1, 1), a1 + hstep, voffA);
            PG8_WAIT_V(8); PG8_WAIT_L(0); PG8_BAR; PG8_MMA(0, 0, At, B0); PG8_MMA(0, 1, At, B1); PG8_BAR; PG8_SCHED;
            PG8_LDA(At, 0, 1); PG8_STAGE(PG8_SB(0, 0), b2, voffB); PG8_STAGE(PG8_SB(0, 1), b2 + hstep, voffB); PG8_STAGE(PG8_SA(0, 0), a2, voffA);
            PG8_WAIT_V(8); PG8_WAIT_L(0); PG8_BAR; PG8_MMA(1, 0, At, B0); PG8_MMA(1, 1, At, B1); PG8_BAR; PG8_SCHED;
            PG8_LDB(B0, 1, 0); PG8_LDB(B1, 1, 1); PG8_SCHED; PG8_LDA(At, 1, 0); PG8_STAGE(PG8_SA(0, 1), a2 + hstep, voffA);
            PG8_WAIT_V(8); PG8_WAIT_L(0); PG8_BAR; PG8_MMA(0, 0, At, B0); PG8_MMA(0, 1, At, B1); PG8_BAR; PG8_SCHED;
            PG8_LDA(At, 1, 1); PG8_STAGE(PG8_SB(1, 0), b3, voffB); PG8_STAGE(PG8_SB(1, 1), b3 + hstep, voffB); PG8_STAGE(PG8_SA(1, 0), a3, voffA);
            PG8_WAIT_V(8); PG8_WAIT_L(0); PG8_BAR; PG8_MMA(1, 0, At, B0); PG8_MMA(1, 1, At, B1); PG8_BAR; PG8_SCHED;
            } else {
            PG8_LDB(B0, 0, 0); PG8_SCHED; PG8_LDA(At, 0, 0); PG8_STAGE(PG8_SA(1, 1), a1 + hstep, voffA);
            PG8_WAIT_L(8); PG8_BAR; PG8_WAIT_L(0); PG8_MMA(0, 0, At, B0); PG8_BAR; PG8_SCHED;
            PG8_LDB(B1, 0, 1); PG8_STAGE(PG8_SB(0, 0), b2, voffB);
            PG8_BAR; PG8_WAIT_L(0); PG8_MMA(0, 1, At, B1); PG8_BAR;
            PG8_LDA(At, 0, 1); PG8_STAGE(PG8_SA(0, 0), a2, voffA);
            PG8_BAR; PG8_WAIT_L(0); PG8_MMA(1, 0, At, B0); PG8_BAR; PG8_SCHED;
            PG8_STAGE(PG8_SB(0, 1), b2 + hstep, voffB);
            PG8_WAIT_V(6); PG8_BAR; PG8_MMA(1, 1, At, B1); PG8_BAR;
            PG8_LDB(B0, 1, 0); PG8_SCHED; PG8_LDA(At, 1, 0); PG8_STAGE(PG8_SA(0, 1), a2 + hstep, voffA);
            PG8_WAIT_L(8); PG8_BAR; PG8_WAIT_L(0); PG8_MMA(0, 0, At, B0); PG8_BAR; PG8_SCHED;
            PG8_LDB(B1, 1, 1); PG8_STAGE(PG8_SB(1, 0), b3, voffB);
            PG8_BAR; PG8_WAIT_L(0); PG8_MMA(0, 1, At, B1); PG8_BAR;
            PG8_LDA(At, 1, 1); PG8_STAGE(PG8_SA(1, 0), a3, voffA);
            PG8_BAR; PG8_WAIT_L(0); PG8_MMA(1, 0, At, B0); PG8_BAR; PG8_SCHED;
            PG8_STAGE(PG8_SB(1, 1), b3 + hstep, voffB);
            PG8_WAIT_V(6); PG8_BAR; PG8_MMA(1, 1, At, B1); PG8_BAR;
            }
        }
        if constexpr (F8) { asm volatile("s_nop 15\n\ts_nop 15" ::: "memory"); __builtin_amdgcn_sched_barrier(0); }
        if constexpr (ALIGN_EPI) { if (wr == 0) PG8_BAR; }
        if constexpr (!Epi::AFTER_DRAIN) { E(acc, cur, wr, wc, fr, fq); S.done(cur); }
        if (!has_next) break;
#pragma unroll
        for (int a = 0; a < 2; ++a)
#pragma unroll
            for (int b = 0; b < 2; ++b)
#pragma unroll
                for (int m = 0; m < 4; ++m)
#pragma unroll
                    for (int n = 0; n < 2; ++n) acc[a][b][m][n] = (f32x4){0.f, 0.f, 0.f, 0.f};
        cur = nxt; cA = nA; cB = nB; ++ui;
        if constexpr (KSPLIT) nt = ((g.KLL && cur.ks == g.NKS - 1) ? g.KLL : g.KL) / BK;
        if constexpr (ALIGN_EPI) { if (wr == 1) PG8_BAR; }
    }
    PG8_WAIT_V(0);
    if constexpr (!ALIGN_EPI) { if (wr == 0) PG8_BAR; }
    PG8_BAR;
    if constexpr (Epi::AFTER_DRAIN) { E.fused(acc, cur, wr, wc, fr, fq, lds, wid, lane); S.done(cur); }
#undef PG8_SA
#undef PG8_SB
#undef PG8_STAGE
#undef PG8_LDA
#undef PG8_LDB
#undef PG8_MMA
#undef PG8_WAIT_V
#undef PG8_WAIT_L
#undef PG8_BAR
#undef PG8_SCHED
}
}
#define GAS __attribute__((address_space(1)))
#define LAS __attribute__((address_space(3)))
typedef unsigned short bf16;
typedef unsigned v4u __attribute__((ext_vector_type(4)));
typedef float f32x4 __attribute__((ext_vector_type(4)));
typedef short bf16x8 __attribute__((ext_vector_type(8)));
typedef GAS unsigned gu32;
typedef GAS unsigned long long gu64;
#define RLX_AGENT __ATOMIC_RELAXED, __HIP_MEMORY_SCOPE_AGENT
#define LDS_WAIT() asm volatile("s_waitcnt lgkmcnt(0)" ::: "memory")
#define VM_WAIT() asm volatile("s_waitcnt vmcnt(0)" ::: "memory")
__device__ __forceinline__ unsigned long long rt() { return __builtin_amdgcn_s_memrealtime(); }
__device__ __forceinline__ unsigned f2bf(float f) { unsigned u = __builtin_bit_cast(unsigned, f); return (u + 0x7fffu + ((u >> 16) & 1u)) >> 16; }
typedef float pk_f32x2 __attribute__((ext_vector_type(2))); typedef __bf16 pk_bf16x2 __attribute__((ext_vector_type(2)));
__device__ __forceinline__ unsigned pk2(float lo, float hi) { pk_f32x2 v = {lo, hi}; pk_bf16x2 b = __builtin_convertvector(v, pk_bf16x2); return __builtin_bit_cast(unsigned, b); }

#define XB_TMO      128
#define XB_XCNT(j)  (256  + 64 * (j))
#define XB_XSUB(j)  (1280 + 64 * (j))
#define XB_XGEN(j)  (2304 + 64 * (j))
#define XB_TOP      3328
#define XB_TOPGEN   3392
#define XCD_BAR_WORDS 3456
#define XB_SPIN_CAP (1u << 18)

__device__ __forceinline__ unsigned xb_ld(unsigned* p)              { return __hip_atomic_load(p, __ATOMIC_RELAXED, __HIP_MEMORY_SCOPE_AGENT); }
__device__ __forceinline__ unsigned xb_add(unsigned* p, unsigned v) { return __hip_atomic_fetch_add(p, v, __ATOMIC_RELAXED, __HIP_MEMORY_SCOPE_AGENT); }
__device__ __forceinline__ unsigned xb_xcc_id() { return (unsigned)__builtin_amdgcn_s_getreg((3 << 11) | 20) & 0xFu; }
#define XB_SPIN(cond, bar) do { unsigned _sp = 0; while (cond) { __builtin_amdgcn_s_sleep(1); \
    if ((++_sp & 255u) == 0u) { if (xb_ld(&(bar)[XB_TMO])) break; if (_sp > XB_SPIN_CAP) { atomicAdd(&(bar)[XB_TMO], 1u); break; } } } } while (0)

struct XcdBarrier {
    unsigned* bar; unsigned x;
    volatile LAS unsigned* st;
};

__device__ __forceinline__ XcdBarrier xcd_barrier_post(unsigned* bar, volatile LAS unsigned* st) {
    XcdBarrier b; b.bar = bar; b.x = xb_xcc_id(); b.st = st;
    if (threadIdx.x == 0) (void)xb_add(&bar[XB_XCNT(b.x)], 1u);
    return b;
}
__device__ __forceinline__ void xcd_barrier_complete(unsigned* bar, unsigned x, unsigned& nloc, unsigned& nx) {
    const unsigned G = gridDim.x * gridDim.y * gridDim.z;
    unsigned sum, cnt, mine, sp = 0u;
    for (;;) {
        sum = 0u; cnt = 0u; mine = 0u;
#pragma unroll
        for (unsigned j = 0; j < 16; ++j) { const unsigned c = xb_ld(&bar[XB_XCNT(j)]); sum += c; cnt += (c > 0u) ? 1u : 0u; mine = (j == x) ? c : mine; }
        if (sum == G) break;
        __builtin_amdgcn_s_sleep(1);
        if ((++sp & 255u) == 0u) { if (xb_ld(&bar[XB_TMO])) break; if (sp > XB_SPIN_CAP) { atomicAdd(&bar[XB_TMO], 1u); break; } }
    }
    nloc = mine > 0u ? mine : 1u; nx = cnt > 0u ? cnt : 1u;
}

__device__ __forceinline__ void xcd_barrier(const XcdBarrier& b) {
    asm volatile("s_waitcnt vmcnt(0)" ::: "memory");
    __syncthreads();
    if (threadIdx.x == 0) {
        unsigned* bar = b.bar;
        __builtin_amdgcn_s_waitcnt(0);
        unsigned nloc = b.st[0], nx = b.st[1];
        if (nloc == 0u) { xcd_barrier_complete(bar, b.x, nloc, nx); b.st[0] = nloc; b.st[1] = nx; }
        const unsigned old = xb_add(&bar[XB_XSUB(b.x)], 1u);
        const unsigned gen = old / nloc;
        if (old + 1u == (gen + 1u) * nloc) {
            __builtin_amdgcn_fence(__ATOMIC_RELEASE, "agent");
            asm volatile("s_waitcnt vmcnt(0)" ::: "memory");
            const unsigned og = xb_add(&bar[XB_TOP], 1u);
            const unsigned tg = og / nx;
            if (og + 1u == (tg + 1u) * nx) xb_add(&bar[XB_TOPGEN], 1u);
            else XB_SPIN(xb_ld(&bar[XB_TOPGEN]) == tg, bar);
            __builtin_amdgcn_fence(__ATOMIC_ACQUIRE, "agent");
            xb_add(&bar[XB_XGEN(b.x)], 1u);
            asm volatile("s_waitcnt vmcnt(0)" ::: "memory");
        } else {
            XB_SPIN(xb_ld(&bar[XB_XGEN(b.x)]) == gen, bar);
            __builtin_amdgcn_fence(__ATOMIC_ACQUIRE, "agent");
            asm volatile("s_waitcnt vmcnt(0)" ::: "memory");
        }
    }
    __syncthreads();
}

__device__ __forceinline__ void split_arrive(const XcdBarrier& b, unsigned* w) {
    asm volatile("s_waitcnt vmcnt(0)" ::: "memory");
    __syncthreads();
    if (threadIdx.x == 0) {
        __builtin_amdgcn_s_waitcnt(0);
        unsigned nloc = b.st[0], nx = b.st[1];
        if (nloc == 0u) { xcd_barrier_complete(b.bar, b.x, nloc, nx); b.st[0] = nloc; b.st[1] = nx; }
        const unsigned old = xb_add(&w[64 * b.x], 1u);
        if (old + 1u == nloc) {
            __builtin_amdgcn_fence(__ATOMIC_RELEASE, "agent");
            asm volatile("s_waitcnt vmcnt(0)" ::: "memory");
            const unsigned og = xb_add(&w[64 * 16], 1u);
            if (og + 1u == nx) xb_add(&w[64 * 17], 1u);
        }
    }
}
__device__ __forceinline__ void split_wait(const XcdBarrier& b, unsigned* w) {
    if (threadIdx.x == 0) {
        XB_SPIN(xb_ld(&w[64 * 17]) == 0u, b.bar);
        __builtin_amdgcn_fence(__ATOMIC_ACQUIRE, "agent");
        asm volatile("s_waitcnt vmcnt(0)" ::: "memory");
    }
    __syncthreads();
}

constexpr int NWAVES = 8;
constexpr int NB = 8, SEQ = 4096, CTXL = 256, TT = SEQ + CTXL, DM = 1024, MROWS = NB * TT;
constexpr int NLAT = NB * SEQ;
constexpr int NPROJ = 1792, INCOLS = 1696, FFD = 2816, FFE = 3584, NEXP = 8;
constexpr int KTILES = TT / 64;
constexpr float EPS = 1e-6f, LOG2E = 1.4426950408889634f;
constexpr int MOE_CH = 64, MOE_NCH = 5, MOE_MAXT = 264, MOE_TAILK = 7;

constexpr size_t MiB = 1u << 20;
constexpr size_t WS_CTL = 0, WS_WUB = 1 * MiB, ZERO_BYTES = 3 * MiB;
constexpr size_t WS_MOD = 3 * MiB;
constexpr size_t WS_WIN = 4 * MiB, WS_WOUT = 11 * MiB, WS_WUP = 15 * MiB, WS_WDN = 26 * MiB;
constexpr size_t WS_XC = 32 * MiB;
constexpr size_t WS_RT = 40 * MiB;
constexpr size_t RT_TOPE = 0, RT_GATE = 256 * 1024, RT_POS = 512 * 1024, RT_HIST = 768 * 1024, RT_TILEE = 776 * 1024;
constexpr size_t WS_H = 42 * MiB;
constexpr size_t WS_P = 110 * MiB;
constexpr size_t WS_Q = 229 * MiB;
constexpr size_t SZ_Q64 = (size_t)NB * 6 * TT * 64 * 2, SZ_KV2 = (size_t)NB * 2 * KTILES * 8192;
constexpr size_t WS_QA = WS_Q, WS_KA = WS_QA + SZ_Q64, WS_VA = WS_KA + SZ_KV2, WS_QC = WS_VA + SZ_KV2, WS_KC = WS_QC + SZ_Q64, WS_VC = WS_KC + SZ_KV2;
constexpr size_t WS_CQKV = WS_VC + SZ_KV2;
constexpr size_t WS_KR = WS_CQKV + (size_t)MROWS * 384 * 2;
constexpr size_t WS_SSQ = WS_KR, WS_SSK = WS_KR + (size_t)MROWS * 16;
constexpr size_t WS_QB = WS_KR + (size_t)MROWS * 32 * 2;
constexpr size_t WS_KB = WS_QB + (size_t)NB * 4 * TT * 96 * 2;
constexpr size_t WS_VB = WS_KB + (size_t)NB * 4 * KTILES * 12288;
constexpr size_t WS_QEND = WS_VB + (size_t)NB * 4 * KTILES * 8192;
constexpr size_t WS_PART2 = 392 * MiB;
constexpr size_t WS_UM2 = WS_H;
constexpr size_t WS_PART = 400 * MiB;
constexpr size_t WS_D1 = WS_P;
constexpr size_t WS_D0 = WS_P;
constexpr size_t WS_D2 = 300 * MiB;
constexpr size_t WS_YT = 534 * MiB;
constexpr size_t WS_U = WS_P;
constexpr size_t WS_HFS = 194 * MiB, WS_Y = 260 * MiB, WS_UM = 392 * MiB, WS_WMUP = 450 * MiB, WS_WMDN = 506 * MiB, WS_END = 562 * MiB;
static_assert(WS_QEND <= 411 * MiB && WS_U + (size_t)MROWS * FFD * 2 <= WS_QEND, "ws map");
static_assert(WS_HFS + (size_t)MOE_MAXT * 256 * DM <= WS_Y && WS_Y + (size_t)MOE_MAXT * 256 * DM * 2 <= WS_UM && WS_UM + (size_t)MOE_CH * 256 * FFE <= WS_WMUP && WS_QEND <= WS_WMUP && WS_WMUP + (size_t)NEXP * 2 * FFE * DM <= WS_WMDN && WS_WMDN + (size_t)NEXP * DM * FFE <= WS_END, "moe ws map");
constexpr int CW_BAR = 4096;
constexpr int CW_STEAL = 16384, CW_DONE = 16448, CW_FINAL = 20480, CW_SPLIT = 24576;

constexpr int RING_BYTES = 131072, LDSCTL_OFF = RING_BYTES, MISC_OFF = LDSCTL_OFF + 320, LDS_BYTES = 147456;

__device__ __forceinline__ float bflo(unsigned u) { return __builtin_bit_cast(float, u << 16); }
__device__ __forceinline__ float bfhi(unsigned u) { return __builtin_bit_cast(float, u & 0xffff0000u); }
__device__ __forceinline__ void unpack8(const v4u r, float (&v)[8]) { v[0] = bflo(r.x); v[1] = bfhi(r.x); v[2] = bflo(r.y); v[3] = bfhi(r.y); v[4] = bflo(r.z); v[5] = bfhi(r.z); v[6] = bflo(r.w); v[7] = bfhi(r.w); }
__device__ __forceinline__ v4u pack8(const float (&v)[8]) { v4u o; o.x = pk2(v[0], v[1]); o.y = pk2(v[2], v[3]); o.z = pk2(v[4], v[5]); o.w = pk2(v[6], v[7]); return o; }
__device__ __forceinline__ float wave_sum(float v) {
#define WS_DPP(ctrl_, rmask_) v += __builtin_bit_cast(float, __builtin_amdgcn_update_dpp(0, __builtin_bit_cast(int, v), ctrl_, rmask_, 0xf, false))
    WS_DPP(0xB1, 0xf);
    WS_DPP(0x4E, 0xf);
    WS_DPP(0x141, 0xf);
    WS_DPP(0x140, 0xf);
    WS_DPP(0x142, 0xa);
    WS_DPP(0x143, 0xc);
#undef WS_DPP
    return __builtin_bit_cast(float, __builtin_amdgcn_readlane(__builtin_bit_cast(int, v), 63));
}
__device__ __forceinline__ float fast_rsqrt(float x) { return __builtin_amdgcn_rsqf(x); }
__device__ __forceinline__ float silu_f(float a) { return a * __builtin_amdgcn_rcpf(1.0f + __builtin_amdgcn_exp2f(-a * LOG2E)); }

__device__ __forceinline__ float clamp8(float v) { return __builtin_amdgcn_fmed3f(v, -448.f, 448.f); }
__device__ __forceinline__ unsigned pk4_fp8(float a, float b, float c, float d) { int w = __builtin_amdgcn_cvt_pk_fp8_f32(clamp8(a), clamp8(b), 0, false); w = __builtin_amdgcn_cvt_pk_fp8_f32(clamp8(c), clamp8(d), w, true); return (unsigned)w; }
#ifndef DENSE_F8
#define DENSE_F8 0
#endif
#ifndef DENSE_F8_UP
#define DENSE_F8_UP 0
#endif
#ifndef DENSE_F8_DN
#define DENSE_F8_DN 1
#endif
constexpr float F8_SA = 8.f, F8_SW = 64.f, F8_SU = 2.f;
struct Args { const float* in[25]; float* out; unsigned char* ws; int ph_lo, ph_hi; };
struct Ctx {
    LAS unsigned char* lds; int tid, lane, wave, vcu, G, wg;
    const float* const* in; float* out; unsigned char* ws;
};

struct TileSched {
    int nM, nN, nwg, G, c, skip, reps;
    __device__ __forceinline__ void init(int nM_, int nN_, int G_, int c_, int skip_, int reps_ = 1) { nM = nM_; nN = nN_; nwg = nM * nN; G = G_; c = c_; skip = skip_; reps = reps_; }
    __device__ __forceinline__ bool next(int i, pg8::Unit& u) const {
        const long L = (long)i * G + c; if (L >= (long)nwg * reps) return false;
        int wgid = (int)(L % nwg); { const int q = nwg / pg8::NXCD, r = nwg % pg8::NXCD, xcd = wgid % pg8::NXCD, off = wgid / pg8::NXCD; wgid = (xcd < r ? xcd * (q + 1) : r * (q + 1) + (xcd - r) * q) + off; }
        const int nig = pg8::WGM * nN, gid = wgid / nig, fm = gid * pg8::WGM, gsz = (nM - fm) < pg8::WGM ? (nM - fm) : pg8::WGM;
        int pm = fm + ((wgid % nig) % gsz); u.pn = (wgid % nig) / gsz;
        if (skip) pm = (pm >> 4) * 17 + 1 + (pm & 15);
        u.pm = pm; return true;
    }
    __device__ __forceinline__ void a_ready(const pg8::Unit&) const {}
    __device__ __forceinline__ void done(const pg8::Unit&) const {}
};
struct CtxSched {
    int c;
    __device__ __forceinline__ bool next(int i, pg8::Unit& u) const { if (i > 0 || c >= 32) return false; u.pm = 17 * (c >> 2); u.pn = c & 3; return true; }
    __device__ __forceinline__ void a_ready(const pg8::Unit&) const {}
    __device__ __forceinline__ void done(const pg8::Unit&) const {}
};
struct UpBSched {
    TileSched T;
    __device__ __forceinline__ bool next(int i, pg8::Unit& u) const { if (!T.next(i, u)) return false; u.ks = (u.pn >= 2) ? 1 : 0; return true; }
    __device__ __forceinline__ void a_ready(const pg8::Unit&) const {}
    __device__ __forceinline__ void done(const pg8::Unit&) const {}
};
struct CtxSplitSched {
    int c;
    __device__ __forceinline__ bool next(int i, pg8::Unit& u) const { if (i > 0 || c >= 64) return false; u.pm = 17 * (c >> 3); u.pn = (c >> 1) & 3; u.ks = c & 1; return true; }
    __device__ __forceinline__ void a_ready(const pg8::Unit&) const {}
    __device__ __forceinline__ void done(const pg8::Unit&) const {}
};
struct MoeTailSched {
    const int* tile_e; int tile0, ntc, G, c;
    __device__ __forceinline__ bool next(int i, pg8::Unit& u) const {
        const int L = i * G + c; if (L >= ntc * 4 * MOE_TAILK) return false;
        const int tl = L % ntc, r = L / ntc;
        const int e = __builtin_amdgcn_readfirstlane(__hip_atomic_load(tile_e + tile0 + tl, __ATOMIC_RELAXED, __HIP_MEMORY_SCOPE_AGENT)) & 7;
        u.pm = tl; u.pn = e * 4 + (r & 3); u.ks = r >> 2; return true;
    }
    __device__ __forceinline__ void a_ready(const pg8::Unit&) const {}
    __device__ __forceinline__ void done(const pg8::Unit&) const {}
};
struct MoeSched {
    const int* tile_e; int tile0, ntc, NT, G, c, up;
    __device__ __forceinline__ bool next(int i, pg8::Unit& u) const {
        const int L = i * G + c; if (L >= ntc * NT) return false;
        const int tl = L % ntc, pnl = L / ntc;
        const int e = __builtin_amdgcn_readfirstlane(__hip_atomic_load(tile_e + tile0 + tl, __ATOMIC_RELAXED, __HIP_MEMORY_SCOPE_AGENT)) & 7;
        u.pm = up ? tile0 + tl : tl; u.pn = e * NT + pnl; return true;
    }
    __device__ __forceinline__ void a_ready(const pg8::Unit&) const {}
    __device__ __forceinline__ void done(const pg8::Unit&) const {}
};

struct EpiStoreBf16 {
    static constexpr bool PERM = true, AFTER_DRAIN = false;
    pg8::bf16_t* O; int ldc, pn_mod, pm_off; float scale;
    __device__ __forceinline__ void operator()(const pg8::f32x4 (&acc)[2][2][4][2], const pg8::Unit& u, int wr, int wc, int fr, int fq) const {
        const int row0 = (u.pm + pm_off) * 256 + wr * 64 + fr, col0 = (u.pn % pn_mod) * 256 + wc * 32 + 8 * fq;
#pragma unroll
        for (int ai = 0; ai < 2; ++ai)
#pragma unroll
            for (int m = 0; m < 4; ++m) { pg8::bf16_t* rowp = O + (size_t)(row0 + ai * 128 + m * 16) * ldc + col0;
#pragma unroll
                for (int bj = 0; bj < 2; ++bj) { const pg8::f32x4 v0 = acc[ai][bj][m][0] * scale, v1 = acc[ai][bj][m][1] * scale;
                    pg8::u32x4 w; w.x = pg8::cvt_pk_bf16(v0[0], v0[1]); w.y = pg8::cvt_pk_bf16(v0[2], v0[3]); w.z = pg8::cvt_pk_bf16(v1[0], v1[1]); w.w = pg8::cvt_pk_bf16(v1[2], v1[3]);
                    *(pg8::u32x4*)(rowp + bj * 128) = w; } }
    }
};
struct EpiGateBf16 {
    static constexpr bool PERM = true, AFTER_DRAIN = false;
    pg8::bf16_t* D; const float* gate; float scale;
    __device__ __forceinline__ void operator()(const pg8::f32x4 (&acc)[2][2][4][2], const pg8::Unit& u, int wr, int wc, int fr, int fq) const {
        int upm = u.pm, upn = u.pn; asm volatile("" : "+v"(fr), "+v"(fq), "+s"(upm), "+s"(upn));
        const int b = upm / 17, lt = b * 16 + (upm - 17 * b) - 1;
        const float* g = gate + b * 6144;
        const int row0 = lt * 256 + wr * 64 + fr, col0 = upn * 256 + wc * 32 + 8 * fq;
#pragma unroll
        for (int bj = 0; bj < 2; ++bj) { const pg8::f32x4 g0 = *(const pg8::f32x4*)(g + col0 + bj * 128) * scale, g1 = *(const pg8::f32x4*)(g + col0 + bj * 128 + 4) * scale;
#pragma unroll
            for (int ai = 0; ai < 2; ++ai)
#pragma unroll
                for (int m = 0; m < 4; ++m) { const pg8::f32x4 v0 = acc[ai][bj][m][0] * g0, v1 = acc[ai][bj][m][1] * g1;
                    pg8::u32x4 w; w.x = pg8::cvt_pk_bf16(v0[0], v0[1]); w.y = pg8::cvt_pk_bf16(v0[2], v0[3]); w.z = pg8::cvt_pk_bf16(v1[0], v1[1]); w.w = pg8::cvt_pk_bf16(v1[2], v1[3]);
                    *(pg8::u32x4*)(D + (size_t)(row0 + ai * 128 + m * 16) * DM + col0 + bj * 128) = w; } }
    }
};
struct EpiStoreBf16K {
    static constexpr bool PERM = true, AFTER_DRAIN = false;
    pg8::bf16_t* O; int ldc; float scale;
    __device__ __forceinline__ void operator()(const pg8::f32x4 (&acc)[2][2][4][2], const pg8::Unit& u, int wr, int wc, int fr, int fq) const {
        const int row0 = (u.ks * 8 + u.pm) * 256 + wr * 64 + fr, col0 = (u.pn & 3) * 256 + wc * 32 + 8 * fq;
#pragma unroll
        for (int ai = 0; ai < 2; ++ai)
#pragma unroll
            for (int m = 0; m < 4; ++m) { pg8::bf16_t* rowp = O + (size_t)(row0 + ai * 128 + m * 16) * ldc + col0;
#pragma unroll
                for (int bj = 0; bj < 2; ++bj) { const pg8::f32x4 v0 = acc[ai][bj][m][0] * scale, v1 = acc[ai][bj][m][1] * scale;
                    pg8::u32x4 w; w.x = pg8::cvt_pk_bf16(v0[0], v0[1]); w.y = pg8::cvt_pk_bf16(v0[2], v0[3]); w.z = pg8::cvt_pk_bf16(v1[0], v1[1]); w.w = pg8::cvt_pk_bf16(v1[2], v1[3]);
                    *(pg8::u32x4*)(rowp + bj * 128) = w; } }
    }
};
template <bool OUT8> struct EpiSwiglu {
    static constexpr bool PERM = true, AFTER_DRAIN = false;
    void* O; int ldc, pn_mod, pm_off; float ascale, oscale;
    __device__ __forceinline__ void operator()(const pg8::f32x4 (&acc)[2][2][4][2], const pg8::Unit& u, int wr, int wc, int fr, int fq) const {
        typedef unsigned u32x2v __attribute__((ext_vector_type(2)));
        const int row0 = (u.pm + pm_off) * 256 + wr * 64 + fr, col0 = (u.pn % pn_mod) * 128 + wc * 32 + 8 * fq;
#pragma unroll
        for (int ai = 0; ai < 2; ++ai)
#pragma unroll
            for (int m = 0; m < 4; ++m) { const size_t eo = (size_t)(row0 + ai * 128 + m * 16) * ldc + col0;
                const float c1 = -ascale * LOG2E, c2 = ascale * ascale * (OUT8 ? oscale : 1.0f);
                const pg8::f32x4 a0 = acc[ai][0][m][0], a1 = acc[ai][0][m][1];
                const pg8::f32x4 t0 = a0 * c1, t1 = a1 * c1;
                pg8::f32x4 e0, e1;
#pragma unroll
                for (int i = 0; i < 4; ++i) { e0[i] = __builtin_amdgcn_exp2f(t0[i]); e1[i] = __builtin_amdgcn_exp2f(t1[i]); }
                const pg8::f32x4 d0 = e0 + 1.0f, d1 = e1 + 1.0f;
                pg8::f32x4 r0, r1;
#pragma unroll
                for (int i = 0; i < 4; ++i) { r0[i] = __builtin_amdgcn_rcpf(d0[i]); r1[i] = __builtin_amdgcn_rcpf(d1[i]); }
                const pg8::f32x4 u0 = (a0 * r0) * (acc[ai][1][m][0] * c2), u1 = (a1 * r1) * (acc[ai][1][m][1] * c2);
                const float uu[8] = {u0[0], u0[1], u0[2], u0[3], u1[0], u1[1], u1[2], u1[3]};
                if (OUT8) { u32x2v w; w.x = pk4_fp8(uu[0], uu[1], uu[2], uu[3]); w.y = pk4_fp8(uu[4], uu[5], uu[6], uu[7]);
                    *(u32x2v*)((unsigned char*)O + eo) = w; }
                else { pg8::u32x4 w; w.x = pg8::cvt_pk_bf16(uu[0], uu[1]); w.y = pg8::cvt_pk_bf16(uu[2], uu[3]); w.z = pg8::cvt_pk_bf16(uu[4], uu[5]); w.w = pg8::cvt_pk_bf16(uu[6], uu[7]);
                    *(pg8::u32x4*)((pg8::bf16_t*)O + eo) = w; } }
    }
};
struct EpiProj {
    static constexpr bool PERM = true, AFTER_DRAIN = false;
    pg8::bf16_t* QA; unsigned char* KA; unsigned char* VA; pg8::bf16_t* QC; unsigned char* KC; unsigned char* VC; pg8::bf16_t* CQ; unsigned char* KB; float* SSQ; float* SSK;
    const float* aq; const float* ak; const LAS float* tab64; const LAS float* tab32;
    __device__ __forceinline__ void operator()(const pg8::f32x4 (&acc)[2][2][4][2], const pg8::Unit& u, int wr, int wc, int fr_, int fq_) const {
        int fr = fr_, fq = fq_, upm = u.pm, upn = u.pn; asm volatile("" : "+v"(fr), "+v"(fq), "+s"(upm), "+s"(upn));
        const int b = upm / 17, tj = (upm % 17) * 256; const bool isl = tj != 0;
        const int t0 = tj + wr * 64 + fr;
        const int row0 = upm * 256 + wr * 64 + fr;
        if (upn < 4) {
            const bool isA = upn < 2; const int hq = (upn & 1) * 4 + wc; const bool isq = hq < 6;
            pg8::f32x4 g0[2], g1[2];
            if (isA) { const float* gp = (isq ? aq : ak) + fq * 8; g0[0] = *(const pg8::f32x4*)gp; g0[1] = *(const pg8::f32x4*)(gp + 4); g1[0] = *(const pg8::f32x4*)(gp + 32); g1[1] = *(const pg8::f32x4*)(gp + 36); }
            unsigned char* dp; int astep, mstep, bstep;
            if (isq) { dp = (unsigned char*)(isA ? QA : QC) + (((size_t)(b * 6 + hq) * TT + t0) * 64 + fq * 8) * 2; astep = 128 * 128; mstep = 16 * 128; bstep = 64; }
            else { dp = (isA ? KA : KC) + ((size_t)(b * 2 + hq - 6) * KTILES + (t0 >> 6)) * 8192 + fq * 1024 + fr * 16; astep = 2 * 8192; mstep = 256; bstep = 4096; }
            const float qs = isq ? 0.125f * LOG2E : 1.0f;
#pragma unroll
            for (int ai = 0; ai < 2; ++ai)
#pragma unroll
                for (int m = 0; m < 4; ++m) {
                    float a[8], c[8];
#pragma unroll
                    for (int i = 0; i < 4; ++i) { a[i] = acc[ai][0][m][0][i]; a[4 + i] = acc[ai][0][m][1][i]; c[i] = acc[ai][1][m][0][i]; c[4 + i] = acc[ai][1][m][1][i]; }
                    if (isA) { float ss = 0.f;
#pragma unroll
                        for (int e = 0; e < 8; ++e) ss += a[e] * a[e] + c[e] * c[e];
                        ss += __shfl_xor(ss, 16); ss += __shfl_xor(ss, 32);
                        const float rinv = fast_rsqrt(ss * (1.f / 64.f) + EPS);
#pragma unroll
                        for (int e = 0; e < 8; ++e) { a[e] *= rinv * g0[e >> 2][e & 3]; c[e] *= rinv * g1[e >> 2][e & 3]; } }
                    if (isl) { const int lp = t0 + ai * 128 + m * 16 - CTXL; const LAS float* ta = tab64 + (((lp >> 6) & 63) * 16 + (fq & 1) * 8) * 2; const LAS float* tc = tab64 + ((lp & 63) * 16 + (fq & 1) * 8) * 2;
#pragma unroll
                        for (int e = 0; e < 8; ++e) { const float ya = __shfl_xor(a[e], 32), yc = __shfl_xor(c[e], 32);
                            a[e] = (fq >> 1) ? a[e] * ta[2 * e] + ya * ta[2 * e + 1] : a[e] * ta[2 * e] - ya * ta[2 * e + 1];
                            c[e] = (fq >> 1) ? c[e] * tc[2 * e] + yc * tc[2 * e + 1] : c[e] * tc[2 * e] - yc * tc[2 * e + 1]; } }
                    pg8::u32x4 wa, wc2;
                    wa.x = pk2(a[0] * qs, a[1] * qs); wa.y = pk2(a[2] * qs, a[3] * qs); wa.z = pk2(a[4] * qs, a[5] * qs); wa.w = pk2(a[6] * qs, a[7] * qs);
                    wc2.x = pk2(c[0] * qs, c[1] * qs); wc2.y = pk2(c[2] * qs, c[3] * qs); wc2.z = pk2(c[4] * qs, c[5] * qs); wc2.w = pk2(c[6] * qs, c[7] * qs);
                    unsigned char* d = dp + (size_t)ai * astep + m * mstep;
                    *(pg8::u32x4*)d = wa; *(pg8::u32x4*)(d + bstep) = wc2;
                    asm volatile("" ::: "memory");
                }
        } else if (upn == 4) {
            unsigned char* dp = ((wc < 2) ? VA : VC) + ((size_t)(b * 2 + (wc & 1)) * KTILES + (t0 >> 6)) * 8192 + fr * 64 + fq * 16;
#pragma unroll
            for (int ai = 0; ai < 2; ++ai)
#pragma unroll
                for (int m = 0; m < 4; ++m)
#pragma unroll
                    for (int bj = 0; bj < 2; ++bj) { const pg8::f32x4 v0 = acc[ai][bj][m][0], v1 = acc[ai][bj][m][1];
                        pg8::u32x4 w; w.x = pk2(v0[0], v0[1]); w.y = pk2(v0[2], v0[3]); w.z = pk2(v1[0], v1[1]); w.w = pk2(v1[2], v1[3]);
                        *(pg8::u32x4*)(dp + (size_t)ai * 2 * 8192 + m * 1024 + bj * 4096) = w; asm volatile("" ::: "memory"); }
        } else {
            const bool iscq = upn == 5;
            pg8::bf16_t* cp = CQ + (size_t)row0 * 384 + (iscq ? 0 : 256) + wc * 32 + fq * 8; float* sp = (iscq ? SSQ : SSK) + (size_t)row0 * 4 + wc;
#pragma unroll
            for (int ai = 0; ai < 2; ++ai)
#pragma unroll
                for (int m = 0; m < 4; ++m) { const size_t ro = (size_t)(ai * 128 + m * 16);
                    float ss = 0.f;
#pragma unroll
                    for (int bj = 0; bj < 2; ++bj) { if (bj == 1 && !iscq) continue;
                        const pg8::f32x4 v0 = acc[ai][bj][m][0], v1 = acc[ai][bj][m][1];
                        ss += (v0[0] * v0[0] + v0[1] * v0[1]) + (v0[2] * v0[2] + v0[3] * v0[3]) + (v1[0] * v1[0] + v1[1] * v1[1]) + (v1[2] * v1[2] + v1[3] * v1[3]);
                        pg8::u32x4 w; w.x = pk2(v0[0], v0[1]); w.y = pk2(v0[2], v0[3]); w.z = pk2(v1[0], v1[1]); w.w = pk2(v1[2], v1[3]);
                        *(pg8::u32x4*)(cp + ro * 384 + bj * 128) = w; }
                    ss += __shfl_xor(ss, 16); ss += __shfl_xor(ss, 32);
                    if (fq == 0) sp[ro * 4] = ss;
                    asm volatile("" ::: "memory");
                }
            if (!iscq && wc == 0) {
                unsigned char* kp = KB + ((size_t)(b * 4) * KTILES + (t0 >> 6)) * 12288 + (8 + fq) * 1024 + fr * 16;
#pragma unroll
                for (int ai = 0; ai < 2; ++ai)
#pragma unroll
                    for (int m = 0; m < 4; ++m) { float v[8];
#pragma unroll
                        for (int i = 0; i < 4; ++i) { v[i] = acc[ai][1][m][0][i]; v[4 + i] = acc[ai][1][m][1][i]; }
                        if (isl) { const int lp = t0 + ai * 128 + m * 16 - CTXL; const LAS float* t4 = tab32 + (((fq >> 1) ? (lp & 63) : ((lp >> 6) & 63)) * 8) * 2;
#pragma unroll
                            for (int e = 0; e < 8; ++e) { const float yp = __shfl_xor(v[e], 16); v[e] = (fq & 1) ? v[e] * t4[2 * e] + yp * t4[2 * e + 1] : v[e] * t4[2 * e] - yp * t4[2 * e + 1]; } }
                        pg8::u32x4 w; w.x = pk2(v[0], v[1]); w.y = pk2(v[2], v[3]); w.z = pk2(v[4], v[5]); w.w = pk2(v[6], v[7]);
#pragma unroll
                        for (int h = 0; h < 4; ++h) *(pg8::u32x4*)(kp + (size_t)h * KTILES * 12288 + (size_t)ai * 2 * 12288 + m * 256) = w;
                        asm volatile("" ::: "memory"); }
            }
        }
        asm volatile("s_waitcnt vmcnt(0)" ::: "memory");
    }
};
struct EpiUpB {
    static constexpr bool PERM = true, AFTER_DRAIN = false;
    pg8::bf16_t* QB; unsigned char* KB; unsigned char* VB; const float* SSQ; const float* SSK;
    __device__ __forceinline__ void operator()(const pg8::f32x4 (&acc)[2][2][4][2], const pg8::Unit& u, int wr, int wc, int fr_, int fq_) const {
        int fr = fr_, fq = fq_, upm = u.pm, upn = u.pn; asm volatile("" : "+v"(fr), "+v"(fq), "+s"(upm), "+s"(upn));
        const int b = upm / 17, t0 = (upm % 17) * 256 + wr * 64 + fr;
        const float* ssp = ((upn < 2) ? SSQ : SSK) + (size_t)(upm * 256 + wr * 64 + fr) * 4; const float sdiv = (upn < 2) ? (1.f / 256.f) : (1.f / 128.f);
        float rinv[2][4];
#pragma unroll
        for (int ai = 0; ai < 2; ++ai)
#pragma unroll
            for (int m = 0; m < 4; ++m) { const pg8::f32x4 s4 = *(const pg8::f32x4*)(ssp + (size_t)(ai * 128 + m * 16) * 4); rinv[ai][m] = fast_rsqrt(((s4[0] + s4[1]) + (s4[2] + s4[3])) * sdiv + EPS); }
#pragma unroll
        for (int bj = 0; bj < 2; ++bj) {
            unsigned char* p; int astep, mstep; float sc = 1.0f;
            if (upn < 2) { const int cbase = upn * 256 + bj * 128 + wc * 32; if (cbase >= 384) continue; const int h = cbase / 96;
                p = (unsigned char*)QB + (((size_t)(b * 4 + h) * TT + t0) * 96 + (cbase + 8 * fq - h * 96)) * 2; astep = 128 * 192; mstep = 16 * 192; sc = 0.10206207261596575f * LOG2E; }
            else { const int h = bj * 2 + (wc >> 1), c = (wc & 1) * 4 + fq;
                if (upn == 2) { p = KB + ((size_t)(b * 4 + h) * KTILES + (t0 >> 6)) * 12288 + c * 1024 + fr * 16; astep = 2 * 12288; mstep = 256; }
                else { p = VB + ((size_t)(b * 4 + h) * KTILES + (t0 >> 6)) * 8192 + (c >> 2) * 4096 + fr * 64 + (c & 3) * 16; astep = 2 * 8192; mstep = 1024; } }
#pragma unroll
            for (int ai = 0; ai < 2; ++ai)
#pragma unroll
                for (int m = 0; m < 4; ++m) { const float rs = rinv[ai][m] * sc;
                    const pg8::f32x4 v0 = acc[ai][bj][m][0] * rs, v1 = acc[ai][bj][m][1] * rs;
                    pg8::u32x4 w; w.x = pk2(v0[0], v0[1]); w.y = pk2(v0[2], v0[3]); w.z = pk2(v1[0], v1[1]); w.w = pk2(v1[2], v1[3]);
                    *(pg8::u32x4*)(p + (size_t)ai * astep + m * mstep) = w;
                }
        }
        asm volatile("s_waitcnt vmcnt(0)" ::: "memory");
    }
};
struct EpiResid {
    static constexpr bool PERM = false, AFTER_DRAIN = false;
    const float* base_lat; const float* base_ctx; float* out_lat; float* out_ctx; const float* gate; float scale;
    __device__ __forceinline__ void operator()(const pg8::f32x4 (&acc)[2][2][4][2], const pg8::Unit& u, int wr, int wc, int fr, int fq) const {
        const int b = u.pm / 17, j = u.pm % 17;
        const float* bs; float* os; const float* g;
        if (j == 0) { bs = base_ctx + (size_t)b * CTXL * DM; os = out_ctx + (size_t)b * CTXL * DM; g = gate + 8 * 6144; }
        else { const size_t ro = ((size_t)b * SEQ + (size_t)(j - 1) * 256) * DM; bs = base_lat + ro; os = out_lat + ro; g = gate + b * 6144; }
        const int col0 = u.pn * 256 + wc * 32 + 4 * fq;
#pragma unroll
        for (int bj = 0; bj < 2; ++bj)
#pragma unroll
            for (int n = 0; n < 2; ++n) { const pg8::f32x4 gv = *(const pg8::f32x4*)(g + col0 + bj * 128 + n * 16) * scale;
                pg8::f32x4 xb[2][4];
#pragma unroll
                for (int ai = 0; ai < 2; ++ai)
#pragma unroll
                    for (int m = 0; m < 4; ++m) xb[ai][m] = *(const pg8::f32x4*)(bs + (size_t)(ai * 128 + wr * 64 + m * 16 + fr) * DM + col0 + bj * 128 + n * 16);
#pragma unroll
                for (int ai = 0; ai < 2; ++ai)
#pragma unroll
                    for (int m = 0; m < 4; ++m) *(pg8::f32x4*)(os + (size_t)(ai * 128 + wr * 64 + m * 16 + fr) * DM + col0 + bj * 128 + n * 16) = xb[ai][m] + gv * acc[ai][bj][m][n];
                asm volatile("" ::: "memory"); }
    }
};
struct EpiResidPart {
    static constexpr bool PERM = false, AFTER_DRAIN = false;
    const float* base_lo; const float* base_hi; float* out_lo; float* out_hi; const float* gate; float scale;
    __device__ __forceinline__ void operator()(const pg8::f32x4 (&acc)[2][2][4][2], const pg8::Unit& u, int wr, int wc, int fr, int fq) const {
        int upm = u.pm, upn = u.pn; asm volatile("" : "+v"(fr), "+v"(fq), "+s"(upm), "+s"(upn));
        const int b = upm / 17; const bool hi = u.ks != 0;
        const float* bs = ((hi && base_hi) ? base_hi : base_lo) + (size_t)b * CTXL * DM; float* os = (hi ? out_hi : out_lo) + (size_t)b * CTXL * DM; const float* g = gate + 8 * 6144;
        const float keep = (hi && !base_hi) ? 0.f : 1.f;
        const int col0 = upn * 256 + wc * 32 + 4 * fq;
#pragma unroll
        for (int bj = 0; bj < 2; ++bj)
#pragma unroll
            for (int n = 0; n < 2; ++n) { const pg8::f32x4 gv = *(const pg8::f32x4*)(g + col0 + bj * 128 + n * 16) * scale;
                pg8::f32x4 xb[2][4];
#pragma unroll
                for (int ai = 0; ai < 2; ++ai)
#pragma unroll
                    for (int m = 0; m < 4; ++m) xb[ai][m] = *(const pg8::f32x4*)(bs + (size_t)(ai * 128 + wr * 64 + m * 16 + fr) * DM + col0 + bj * 128 + n * 16);
#pragma unroll
                for (int ai = 0; ai < 2; ++ai)
#pragma unroll
                    for (int m = 0; m < 4; ++m) *(pg8::f32x4*)(os + (size_t)(ai * 128 + wr * 64 + m * 16 + fr) * DM + col0 + bj * 128 + n * 16) = xb[ai][m] * keep + gv * acc[ai][bj][m][n];
                asm volatile("" ::: "memory"); }
    }
};

namespace att {
using f32x16 = __attribute__((ext_vector_type(16))) float;
using s16x4 = __attribute__((ext_vector_type(4))) short;
typedef short v4i16_t __attribute__((ext_vector_type(4)));
constexpr int KSLOT = 12288, VSLOT = 8192;
constexpr int L_K = 0, L_V = 2 * KSLOT, L_O = L_V + 2 * VSLOT, OSTR = 144, L_END = L_O + NWAVES * 32 * OSTR;
static_assert(L_END <= RING_BYTES, "attention LDS");
constexpr float THR = 8.0f, NEGBIG = -1e30f;
__device__ __forceinline__ int crow(int r, int hi) { return (r & 3) + 8 * (r >> 2) + 4 * hi; }
__device__ __forceinline__ float swapmax(float m) { auto rr = __builtin_amdgcn_permlane32_swap(__float_as_uint(m), __float_as_uint(m), false, false); float r; asm("v_max_f32_e32 %0, %1, %2" : "=v"(r) : "v"(__uint_as_float(rr[0])), "v"(__uint_as_float(rr[1]))); return r; }
__device__ __forceinline__ float swapsum(float m) { auto rr = __builtin_amdgcn_permlane32_swap(__float_as_uint(m), __float_as_uint(m), false, false); return __uint_as_float(rr[0]) + __uint_as_float(rr[1]); }
__device__ __forceinline__ s16x4 vtr(const LAS unsigned char* p) { return __builtin_bit_cast(s16x4, __builtin_amdgcn_ds_read_tr16_b64_v4i16((LAS v4i16_t*)p)); }
typedef float f32x2_t __attribute__((ext_vector_type(2))); typedef __bf16 bf16x2_t __attribute__((ext_vector_type(2)));
__device__ __forceinline__ unsigned cvtpk(float lo, float hi) { f32x2_t v = {lo, hi}; bf16x2_t b = __builtin_convertvector(v, bf16x2_t); return __builtin_bit_cast(unsigned, b); }
__device__ __forceinline__ float max3f(float a, float b, float c) { float r; asm("v_max3_f32 %0, %1, %2, %3" : "=v"(r) : "v"(a), "v"(b), "v"(c)); return r; }
__device__ __forceinline__ float max2f(float a, float b) { float r; asm("v_max_f32_e32 %0, %1, %2" : "=v"(r) : "v"(a), "v"(b)); return r; }
__device__ __forceinline__ float fadd_s(float a, float b) { float r; asm("v_add_f32_e32 %0, %1, %2" : "=v"(r) : "v"(a), "v"(b)); return r; }
__device__ __forceinline__ void glds16(const void* gsrc, unsigned lds_dst) { unsigned keep;
    asm volatile("s_mov_b32 %0, m0\n\ts_mov_b32 m0, %2\n\ts_nop 0\n\tglobal_load_lds_dwordx4 %1, off\n\ts_mov_b32 m0, %0" : "=&s"(keep) : "v"(gsrc), "s"(lds_dst) : "memory"); }

struct UnitDesc {
    const bf16* Q;
    const unsigned char* Kimg; const unsigned char* Vimg;
    bf16* O;
    int n0, s1t0, n1;
    int qpos0;
    float minit, linit;
};

__device__ __forceinline__ void rope_q96(bf16* Q, int qpos0) {
    const int tid = threadIdx.x, lane = tid & 63, r32 = lane & 31, hi = lane >> 5, wid = tid >> 6;
    const int lp = qpos0 + wid * 32 + r32;
#pragma unroll
    for (int ds = 4; ds < 6; ++ds) { const int pos = (ds == 4) ? ((lp >> 6) & 63) : (lp & 63);
        v4u* qp = (v4u*)(Q + (size_t)(wid * 32 + r32) * 96 + ds * 16 + hi * 8);
        float v[8]; unpack8(*qp, v); float o[8];
#pragma unroll
        for (int e = 0; e < 8; ++e) { constexpr float invf[8] = {1.0f, 0.31622776601683794f, 0.1f, 0.031622776601683794f, 0.01f, 0.0031622776601683794f, 0.001f, 0.00031622776601683794f};
            const float rev = ((float)pos * invf[e]) * 0.15915494309189535f; const float cs = __builtin_amdgcn_cosf(rev), sn = __builtin_amdgcn_sinf(rev);
            const float yp = __shfl_xor(v[e], 32); o[e] = hi ? v[e] * cs + yp * sn : v[e] * cs - yp * sn; }
        *qp = pack8(o); }
    asm volatile("s_waitcnt vmcnt(0)" ::: "memory");
}

template <int DK, bool WIN>
__device__ __forceinline__ void unit(LAS unsigned char* lds, const UnitDesc& u) {
    int tid = threadIdx.x; asm volatile("" : "+v"(tid));
    const int lane = tid & 63, r32 = lane & 31, hi = lane >> 5; const int wid = __builtin_amdgcn_readfirstlane(tid >> 6);
    constexpr int KT_BYTES = DK * 128, NDS = DK / 16;
    const int NT = u.n0 + u.n1;
    const unsigned lds0 = (unsigned)(uintptr_t)lds;
#define ATT_TILE(i_) (((i_) < u.n0) ? (i_) : u.s1t0 + ((i_) - u.n0))
#define ATT_ISSUE_K(i_, slot_) do { const unsigned char* kg_ = u.Kimg + (size_t)ATT_TILE(i_) * KT_BYTES + wid * 1024 + lane * 16; \
        glds16(kg_, (unsigned)__builtin_amdgcn_readfirstlane(lds0 + L_K + (slot_) * KSLOT + wid * 1024)); \
        if (DK == 96) { if (wid < 4) glds16(kg_ + 8192, (unsigned)__builtin_amdgcn_readfirstlane(lds0 + L_K + (slot_) * KSLOT + 8192 + wid * 1024)); } } while (0)
#define ATT_ISSUE_V(i_, slot_) do { const unsigned char* vg_ = u.Vimg + (size_t)ATT_TILE(i_) * 8192 + wid * 1024 + lane * 16; \
        glds16(vg_, (unsigned)__builtin_amdgcn_readfirstlane(lds0 + L_V + (slot_) * VSLOT + wid * 1024)); } while (0)
#define ATT_QK(P0, P1, slot_) do { const LAS unsigned char* kb_ = lds + L_K + (slot_) * KSLOT + hi * 1024 + r32 * 16; \
        bf16x8 kf_[3][2];          \
        kf_[0][0] = *(const LAS bf16x8*)(kb_); kf_[0][1] = *(const LAS bf16x8*)(kb_ + 512); kf_[1][0] = *(const LAS bf16x8*)(kb_ + 2048); kf_[1][1] = *(const LAS bf16x8*)(kb_ + 2048 + 512); \
        _Pragma("unroll") for (int ds = 0; ds < NDS; ++ds) { \
            if (ds + 2 < NDS) { kf_[(ds + 2) % 3][0] = *(const LAS bf16x8*)(kb_ + (ds + 2) * 2048); kf_[(ds + 2) % 3][1] = *(const LAS bf16x8*)(kb_ + (ds + 2) * 2048 + 512); } \
            if (ds == 0) { P0 = __builtin_amdgcn_mfma_f32_32x32x16_bf16(kf_[0][0], qf[0], negm, 0, 0, 0); P1 = __builtin_amdgcn_mfma_f32_32x32x16_bf16(kf_[0][1], qf[0], negm, 0, 0, 0); } \
            else { P0 = __builtin_amdgcn_mfma_f32_32x32x16_bf16(kf_[ds % 3][0], qf[ds], P0, 0, 0, 0); P1 = __builtin_amdgcn_mfma_f32_32x32x16_bf16(kf_[ds % 3][1], qf[ds], P1, 0, 0, 0); } \
            __builtin_amdgcn_sched_barrier(0x407); } } while (0)
#define ATT_WAITBAR() do { asm volatile("s_waitcnt vmcnt(0) lgkmcnt(0)" ::: "memory"); __builtin_amdgcn_s_barrier(); asm volatile("" ::: "memory"); } while (0)
    ATT_ISSUE_K(0, 0); ATT_ISSUE_V(0, 0); ATT_ISSUE_K(1, 1);
    bf16x8 qf[NDS];
#pragma unroll
    for (int ds = 0; ds < NDS; ++ds) qf[ds] = *(const bf16x8*)(u.Q + (size_t)(wid * 32 + r32) * DK + ds * 16 + hi * 8);
    f32x16 o0 = {}, o1 = {};
    const bool has_sink = u.linit != 0.f;
    float lsum = (hi == 0) ? u.linit : 0.f;
    f32x16 negm;
    { const float m0 = has_sink ? -u.minit : 0.f;
#pragma unroll
      for (int r = 0; r < 16; ++r) negm[r] = m0; }
    asm volatile("" : "+v"(negm));
    const int qlo = u.qpos0 + wid * 32, qp = qlo + r32;
    f32x16 sa0, sa1, sb0, sb1;
    ATT_WAITBAR();
    ATT_QK(sa0, sa1, 0);
    asm volatile("s_nop 15\n\ts_nop 7" : "+v"(sa0), "+v"(sa1));
    bool actc = true; int kposc = 0;
    ATT_WAITBAR();
#define ATT_STEP(i_, C0, C1, N0, N1, QKM_) do {        \
        if ((i_) + 2 < NT) ATT_ISSUE_K((i_) + 2, (i_) & 1); \
        if ((i_) + 1 < NT) ATT_ISSUE_V((i_) + 1, ((i_) + 1) & 1); \
        bool actn = (QKM_ == 2) ? ((i_) + 1 < NT) : (QKM_ == 1); int kposn = 0; \
        if (WIN) { if (actn && (i_) + 1 >= u.n0) { kposn = (u.s1t0 + ((i_) + 1 - u.n0) - 4) * 64; actn = (kposn + 63 >= qlo - 128) && (kposn <= qlo + 31 + 128); } } \
        if (actn) ATT_QK(N0, N1, ((i_) + 1) & 1); \
        if (actc) { \
            if (WIN) { if ((i_) >= u.n0) { \
                _Pragma("unroll") for (int r = 0; r < 16; ++r) { const int dk = kposc + crow(r, hi) - qp; if (dk > 128 || dk < -128) C0[r] = NEGBIG; if (dk + 32 > 128 || dk + 32 < -128) C1[r] = NEGBIG; } } } \
            float rma = max3f(C0[0], C0[1], C1[0]), rmb = max3f(C0[2], C0[3], C1[1]); rma = max3f(rma, C1[2], C1[3]); \
            _Pragma("unroll") for (int r = 4; r < 16; r += 4) { rma = max3f(rma, C0[r], C0[r + 1]); rmb = max3f(rmb, C0[r + 2], C0[r + 3]); rma = max3f(rma, C1[r], C1[r + 1]); rmb = max3f(rmb, C1[r + 2], C1[r + 3]); } \
            float rm = swapmax(max2f(rma, rmb)); \
            const bool force = (!has_sink) && ((i_) == 0); \
            if (force || __any(rm > THR)) { \
                const float dl = force ? rm : max2f(rm, 0.f), al = __builtin_amdgcn_exp2f(-dl); \
                _Pragma("unroll") for (int r = 0; r < 16; ++r) { C0[r] -= dl; C1[r] -= dl; o0[r] *= al; o1[r] *= al; negm[r] -= dl; } \
                if (actn) { _Pragma("unroll") for (int r = 0; r < 16; ++r) { N0[r] -= dl; N1[r] -= dl; } } \
                lsum *= al; asm volatile("" : "+v"(negm)); \
            } \
            float sacc = 0.f; \
            _Pragma("unroll") for (int r = 0; r < 16; ++r) { C0[r] = __builtin_amdgcn_exp2f(C0[r]); C1[r] = __builtin_amdgcn_exp2f(C1[r]); sacc += C0[r]; sacc += C1[r]; } \
            lsum += sacc; \
            v4u pw[4]; \
            _Pragma("unroll") for (int k = 0; k < 2; ++k) { \
                pw[k].x = cvtpk(C0[8 * k + 0], C0[8 * k + 1]); pw[k].y = cvtpk(C0[8 * k + 2], C0[8 * k + 3]); pw[k].z = cvtpk(C0[8 * k + 4], C0[8 * k + 5]); pw[k].w = cvtpk(C0[8 * k + 6], C0[8 * k + 7]); \
                pw[2 + k].x = cvtpk(C1[8 * k + 0], C1[8 * k + 1]); pw[2 + k].y = cvtpk(C1[8 * k + 2], C1[8 * k + 3]); pw[2 + k].z = cvtpk(C1[8 * k + 4], C1[8 * k + 5]); pw[2 + k].w = cvtpk(C1[8 * k + 6], C1[8 * k + 7]); } \
            const LAS unsigned char* vb = lds + L_V + ((i_) & 1) * VSLOT + ((lane >> 4) & 1) * 32 + (lane & 3) * 8 + (4 * hi + ((lane & 15) >> 2)) * 64; \
            _Pragma("unroll") for (int ks = 0; ks < 4; ++ks) { \
                const s16x4 a0 = vtr(vb + ks * 1024), a1 = vtr(vb + ks * 1024 + 512), b0 = vtr(vb + 4096 + ks * 1024), b1 = vtr(vb + 4096 + ks * 1024 + 512); \
                const bf16x8 vf0 = (bf16x8){a0[0], a0[1], a0[2], a0[3], a1[0], a1[1], a1[2], a1[3]}, vf1 = (bf16x8){b0[0], b0[1], b0[2], b0[3], b1[0], b1[1], b1[2], b1[3]}; \
                const bf16x8 pf = __builtin_bit_cast(bf16x8, pw[ks]); \
                o0 = __builtin_amdgcn_mfma_f32_32x32x16_bf16(vf0, pf, o0, 0, 0, 0); \
                o1 = __builtin_amdgcn_mfma_f32_32x32x16_bf16(vf1, pf, o1, 0, 0, 0); } \
        } \
        actc = actn; kposc = kposn; \
        ATT_WAITBAR(); } while (0)
    if (WIN) { for (int i = 0; i < NT; i += 2) { ATT_STEP(i, sa0, sa1, sb0, sb1, 2); ATT_STEP(i + 1, sb0, sb1, sa0, sa1, 2); } }
    else {
        for (int i = 0; i + 2 < NT; i += 2) { ATT_STEP(i, sa0, sa1, sb0, sb1, 1); ATT_STEP(i + 1, sb0, sb1, sa0, sa1, 1); }
        ATT_STEP(NT - 2, sa0, sa1, sb0, sb1, 1); ATT_STEP(NT - 1, sb0, sb1, sa0, sa1, 0);
    }
#undef ATT_STEP
#undef ATT_QK
#undef ATT_ISSUE_K
#undef ATT_ISSUE_V
#undef ATT_TILE
#undef ATT_WAITBAR
    const float inv = __builtin_amdgcn_rcpf(swapsum(lsum));
    LAS unsigned char* stg = lds + L_O + wid * (32 * OSTR);
    typedef unsigned u32x2v __attribute__((ext_vector_type(2)));
#pragma unroll
    for (int rg = 0; rg < 4; ++rg) {
        u32x2v w0, w1;
        w0.x = cvtpk(o0[4 * rg + 0] * inv, o0[4 * rg + 1] * inv); w0.y = cvtpk(o0[4 * rg + 2] * inv, o0[4 * rg + 3] * inv);
        w1.x = cvtpk(o1[4 * rg + 0] * inv, o1[4 * rg + 1] * inv); w1.y = cvtpk(o1[4 * rg + 2] * inv, o1[4 * rg + 3] * inv);
        *(LAS u32x2v*)(stg + r32 * OSTR + (8 * rg + 4 * hi) * 2) = w0;
        *(LAS u32x2v*)(stg + r32 * OSTR + (32 + 8 * rg + 4 * hi) * 2) = w1;
    }
    asm volatile("s_waitcnt lgkmcnt(0)" ::: "memory");
#pragma unroll
    for (int i = 0; i < 4; ++i) { const int row = i * 8 + (lane >> 3), ch = lane & 7; const v4u v = *(const LAS v4u*)(stg + row * OSTR + ch * 16);
        *(v4u*)(u.O + (size_t)(wid * 32 + row) * DM + ch * 8) = v; }
    asm volatile("s_waitcnt lgkmcnt(0)" ::: "memory");
}
}

__device__ __forceinline__ int win_map(int n) {
    if (n < 512) { const int hh = n >> 6, d = n & 63; return (hh >> 2) * 256 + (d >> 5) * 128 + (hh & 3) * 32 + (d & 31); }
    if (n < 640) { const int vh = (n - 512) >> 6, d = n & 63; return 4 * 256 + (d >> 5) * 128 + vh * 32 + (d & 31); }
    if (n < 896) return 5 * 256 + (n - 640);
    if (n < 1024) return 6 * 256 + (n - 896);
    if (n < 1056) return 6 * 256 + 128 + (n - 1024);
    const int n2 = n - 1056;
    if (n2 < 512) { const int hh = n2 >> 6, d = n2 & 63; return (2 + (hh >> 2)) * 256 + (d >> 5) * 128 + (hh & 3) * 32 + (d & 31); }
    const int vh = (n2 - 512) >> 6, d = n2 & 63; return 4 * 256 + (d >> 5) * 128 + (2 + vh) * 32 + (d & 31);
}
__device__ __forceinline__ void transpose_item(const float* W, int ldw, int k0, int n0, void* WT, int dpitch, int dk0, int rmode, int roff, LAS float* scr, int lane, int out8, const float* kscale = nullptr) {
    float tv[32];
#pragma unroll
    for (int i = 0; i < 32; ++i) { const int kk = 2 * i + (lane >> 5); tv[i] = W[(size_t)(k0 + kk) * ldw + n0 + (lane & 31)]; }
    if (kscale) {
#pragma unroll
        for (int i = 0; i < 32; ++i) tv[i] *= kscale[k0 + 2 * i + (lane >> 5)]; }
#pragma unroll
    for (int i = 0; i < 32; ++i) { const int kk = 2 * i + (lane >> 5); scr[kk * 33 + (lane & 31)] = tv[i]; }
    LDS_WAIT(); asm volatile("" ::: "memory");
    const int c = lane & 7;
#pragma unroll
    for (int j = 0; j < 4; ++j) { const int n = (lane >> 3) + 8 * j; const LAS float* s = scr + (8 * c) * 33 + n;
        const int nn = n0 + n; const int drow = (rmode == 1) ? (256 * (nn >> 7) + 128 * roff + (nn & 127)) : (rmode == 2) ? (roff + ((nn >> 6) & 1) * 256 + (nn >> 7) * 64 + (nn & 63)) : (rmode == 3) ? (win_map(n0) + n) : (roff + nn);
        const size_t eo = (size_t)drow * dpitch + dk0 + k0 + 8 * c;
        if (out8) { typedef unsigned u32x2v __attribute__((ext_vector_type(2))); u32x2v o;
            o.x = pk4_fp8(s[0 * 33] * F8_SW, s[1 * 33] * F8_SW, s[2 * 33] * F8_SW, s[3 * 33] * F8_SW); o.y = pk4_fp8(s[4 * 33] * F8_SW, s[5 * 33] * F8_SW, s[6 * 33] * F8_SW, s[7 * 33] * F8_SW);
            *(u32x2v*)((unsigned char*)WT + eo) = o; }
        else { v4u o; o.x = pk2(s[0 * 33], s[1 * 33]); o.y = pk2(s[2 * 33], s[3 * 33]); o.z = pk2(s[4 * 33], s[5 * 33]); o.w = pk2(s[6 * 33], s[7 * 33]);
            *(v4u*)((bf16*)WT + eo) = o; } }
    LDS_WAIT(); asm volatile("" ::: "memory");
}
__device__ __forceinline__ void transpose_mat(const Ctx& C, int item, const float* W, int K, int N, void* WT, int dpitch, int dk0, int rmode, int roff, int out8 = 0, const float* kscale = nullptr) {
    const int nblk = N / 32, kb = item / nblk, nb = item % nblk;
    transpose_item(W, N, 64 * kb, 32 * nb, WT, dpitch, dk0, rmode, roff, (LAS float*)(C.lds + C.wave * 16384), C.lane, out8, kscale);
}

__device__ __forceinline__ void phase_prologue(const Ctx& C) {
    float* mod = (float*)(C.ws + WS_MOD);
    if (C.vcu < 192) {
        const int L = C.vcu / 96, j0 = (C.vcu % 96) * 64;
        LAS float* sil = (LAS float*)C.lds; LAS float* part = (LAS float*)(C.lds + 40960);
        const float* cc = C.in[1]; const float* cx = C.in[3];
        for (int i = C.tid; i < 9 * 1024; i += 512) { const int r = i >> 10, k = i & 1023; const float v = (r < 8) ? cc[r * 1024 + k] : cx[k]; sil[i] = v / (1.0f + __expf(-v)); }
        __syncthreads();
        float acc[9];
#pragma unroll
        for (int r = 0; r < 9; ++r) acc[r] = 0.f;
        const float* wm = C.in[4] + (size_t)L * 1024 * 6144 + j0 + C.lane;
#pragma unroll 16
        for (int kk = 0; kk < 128; ++kk) { const int k = C.wave * 128 + kk; const float wv = wm[(size_t)k * 6144];
#pragma unroll
            for (int r = 0; r < 9; ++r) acc[r] += sil[r * 1024 + k] * wv; }
#pragma unroll
        for (int r = 0; r < 9; ++r) part[(C.wave * 9 + r) * 64 + C.lane] = acc[r];
        __syncthreads();
        for (int i = C.tid; i < 576; i += 512) { const int r = i >> 6, l = i & 63; float s = 0.f;
#pragma unroll
            for (int w = 0; w < 8; ++w) s += part[(w * 9 + r) * 64 + l];
            mod[(size_t)(L * 9 + r) * 6144 + j0 + l] = s + C.in[5][L * 6144 + j0 + l]; }
        __syncthreads();
    }
    const int gw = C.vcu * NWAVES + C.wave, NGW = C.G * NWAVES;
    bf16* win = (bf16*)(C.ws + WS_WIN); bf16* wout = (bf16*)(C.ws + WS_WOUT); unsigned char* wup = C.ws + WS_WUP; unsigned char* wdn = C.ws + WS_WDN; bf16* wub = (bf16*)(C.ws + WS_WUB);
    constexpr int I_IN = 16 * 53, I_OUT = 16 * 32, I_UP = 16 * 88, I_DN = 44 * 32, I_UQ = 4 * 12, I_UKV = 2 * 16, I_Z = 192;
    constexpr int NITEMS = 2 * I_IN + 2 * I_OUT + 2 * I_UP + I_DN + 2 * I_UQ + 2 * I_UKV + 2 * I_Z;
    for (int it = gw; it < NITEMS; it += NGW) {
        int r = it;
        if (r < 2 * I_IN) { const int L = r / I_IN; transpose_mat(C, r % I_IN, C.in[8] + (size_t)L * DM * INCOLS, DM, INCOLS, win + (size_t)L * NPROJ * DM, DM, 0, 3, 0); continue; } r -= 2 * I_IN;
        if (r < 2 * I_OUT) { const int L = r / I_OUT; transpose_mat(C, r % I_OUT, C.in[16] + (size_t)L * DM * DM, DM, DM, wout + (size_t)L * DM * DM, DM, 0, 0, 0); continue; } r -= 2 * I_OUT;
        if (r < I_UP) { transpose_mat(C, r, C.in[17], DM, FFD, wup, DM, 0, 1, 0, DENSE_F8 | DENSE_F8_UP); continue; } r -= I_UP;
        if (r < I_UP) { transpose_mat(C, r, C.in[18], DM, FFD, wup, DM, 0, 1, 1, DENSE_F8 | DENSE_F8_UP); continue; } r -= I_UP;
        if (r < I_DN) { transpose_mat(C, r, C.in[19], FFD, DM, wdn, FFD, 0, 0, 0, DENSE_F8 | DENSE_F8_DN); continue; } r -= I_DN;
        if (r < 2 * I_UQ) { const int L = r / I_UQ; transpose_mat(C, r % I_UQ, C.in[13] + (size_t)L * 256 * 384, 256, 384, wub + (size_t)L * 1024 * 384, 384, 0, 0, 0, 0, C.in[11] + L * 256); continue; } r -= 2 * I_UQ;
        if (r < 2 * I_UKV) { const int L = r / I_UKV; transpose_mat(C, r % I_UKV, C.in[14] + (size_t)L * 128 * 512, 128, 512, wub + (size_t)L * 1024 * 384, 384, 256, 2, 512, 0, C.in[12] + L * 128); continue; } r -= 2 * I_UKV;
        { const int L = r / I_Z, z = r % I_Z; *(v4u*)(win + (size_t)L * NPROJ * DM + (size_t)INCOLS * DM + (size_t)z * 512 + C.lane * 8) = (v4u){0u, 0u, 0u, 0u}; }
    }
}

__device__ __forceinline__ void norm_load(f32x4 (&v)[4], const float* xrow, const float* xadd, int lane) {
    const f32x4* xr = (const f32x4*)xrow + lane;
    if (xadd) { const f32x4* xa = (const f32x4*)xadd + lane;
#pragma unroll
        for (int j = 0; j < 4; ++j) v[j] = xr[64 * j] + xa[64 * j]; }
    else {
#pragma unroll
        for (int j = 0; j < 4; ++j) v[j] = xr[64 * j]; }
}
__device__ __forceinline__ unsigned long long* xs_row(const float* out, int n) {
    return (unsigned long long*)((unsigned char*)out + (size_t)n * 4096 + (size_t)(__builtin_popcount(n & 0x2D6) & 1) * 2048);
}
#define XS_UNPACK(dst_, d_) do { (dst_).x = bflo((unsigned)(d_)); (dst_).y = bfhi((unsigned)(d_)); (dst_).z = bflo((unsigned)((d_) >> 32)); (dst_).w = bfhi((unsigned)((d_) >> 32)); } while (0)
__device__ __forceinline__ void norm_finish(const f32x4 (&v)[4], const float* g, const float* sc, const float* sh, void* orow, int lane, int out8) {
    f32x4 gg[4], s1[4], s0[4]; float s = 0.f;
#pragma unroll
    for (int j = 0; j < 4; ++j) { gg[j] = ((const f32x4*)g)[lane + 64 * j]; s1[j] = ((const f32x4*)sc)[lane + 64 * j]; s0[j] = ((const f32x4*)sh)[lane + 64 * j]; }
#pragma unroll
    for (int j = 0; j < 4; ++j) { s += (v[j].x * v[j].x + v[j].y * v[j].y) + (v[j].z * v[j].z + v[j].w * v[j].w); }
    const float rinv = fast_rsqrt(wave_sum(s) * (1.f / DM) + EPS);
    unsigned long long* o8 = (unsigned long long*)orow + lane; unsigned* o4 = (unsigned*)orow + lane;
#pragma unroll
    for (int j = 0; j < 4; ++j) {
        const f32x4 y = v[j] * rinv * gg[j] * (s1[j] + 1.0f) + s0[j];
        if (out8) o4[64 * j] = pk4_fp8(y.x * F8_SA, y.y * F8_SA, y.z * F8_SA, y.w * F8_SA);
        else o8[64 * j] = (unsigned long long)pk2(y.x, y.y) | ((unsigned long long)pk2(y.z, y.w) << 32); }
}
__device__ __forceinline__ void norm_row(const float* xrow, const float* g, const float* sc, const float* sh, void* orow, int lane, int out8, const float* xadd = nullptr) {
    f32x4 v[4]; norm_load(v, xrow, xadd, lane); norm_finish(v, g, sc, sh, orow, lane, out8);
}
__device__ __forceinline__ void norm_finish_c(const f32x4 (&v)[4], const f32x4 (&ca)[4], const f32x4 (&cb)[4], void* orow, int lane, int out8) {
    float s = 0.f;
#pragma unroll
    for (int j = 0; j < 4; ++j) { s += (v[j].x * v[j].x + v[j].y * v[j].y) + (v[j].z * v[j].z + v[j].w * v[j].w); }
    const float rinv = fast_rsqrt(wave_sum(s) * (1.f / DM) + EPS);
    unsigned long long* o8 = (unsigned long long*)orow + lane; unsigned* o4 = (unsigned*)orow + lane;
#pragma unroll
    for (int j = 0; j < 4; ++j) {
        const f32x4 y = v[j] * rinv * ca[j] + cb[j];
        if (out8) o4[64 * j] = pk4_fp8(y.x * F8_SA, y.y * F8_SA, y.z * F8_SA, y.w * F8_SA);
        else o8[64 * j] = (unsigned long long)pk2(y.x, y.y) | ((unsigned long long)pk2(y.z, y.w) << 32); }
}
__device__ __forceinline__ void phase_norm(const Ctx& C, int L, int which, const float* xlat, const float* xctx, void* H, int out8, const float* ctxadd = nullptr, const bf16* latadd = nullptr, float* xout = nullptr, bool xs_in = false) {
    const int gw = C.vcu * NWAVES + C.wave, NGW = C.G * NWAVES;
    const float* g = (which ? C.in[7] : C.in[6]) + L * DM;
    const float* mod = (const float*)(C.ws + WS_MOD) + (size_t)L * 9 * 6144 + (which ? 3072 : 0);
    {
        const int rpw = (NLAT + NGW - 1) / NGW;
        const int nbeg = gw * rpw, nend = (nbeg + rpw < NLAT) ? nbeg + rpw : NLAT;
        f32x4 pa[4]; unsigned long long px[4], pd[4];
#define PL_LOAD(n_) do { \
        if (xs_in) { const unsigned long long* xr_ = xs_row(xlat, (n_)) + C.lane; _Pragma("unroll") for (int j = 0; j < 4; ++j) px[j] = xr_[64 * j]; } \
        else { const f32x4* xr_ = (const f32x4*)(xlat + (size_t)(n_) * DM) + C.lane; _Pragma("unroll") for (int j = 0; j < 4; ++j) pa[j] = xr_[64 * j]; } \
        if (latadd) { const unsigned long long* dr_ = (const unsigned long long*)(latadd + (size_t)(n_) * DM) + C.lane; _Pragma("unroll") for (int j = 0; j < 4; ++j) pd[j] = dr_[64 * j]; } } while (0)
        if (nbeg < nend) PL_LOAD(nbeg);
        f32x4 ca[4], cb[4]; int bprev = -1;
        for (int n = nbeg; n < nend; ++n) {
            f32x4 v[4];
#pragma unroll
            for (int j = 0; j < 4; ++j) {
                if (xs_in) XS_UNPACK(v[j], px[j]); else v[j] = pa[j];
                if (latadd) { f32x4 d; XS_UNPACK(d, pd[j]); v[j] = v[j] + d; } }
            if (n + 1 < nend) PL_LOAD(n + 1);
            const int b = n / SEQ;
            if (b != bprev) { bprev = b; const float* md = mod + (size_t)b * 6144;
#pragma unroll
                for (int j = 0; j < 4; ++j) { ca[j] = ((const f32x4*)g)[C.lane + 64 * j] * (((const f32x4*)(md + 1024))[C.lane + 64 * j] + 1.0f); cb[j] = ((const f32x4*)md)[C.lane + 64 * j]; }
#pragma unroll
                for (int j = 0; j < 4; ++j) asm volatile("" : "+v"(cb[j]));
            }
            const int m = b * TT + CTXL + (n - b * SEQ);
            norm_finish_c(v, ca, cb, (unsigned char*)H + (size_t)m * DM * (out8 ? 1 : 2), C.lane, out8);
            if (xout) { unsigned long long* xo = xs_row(xout, n) + C.lane;
#pragma unroll
                for (int j = 0; j < 4; ++j) xo[64 * j] = (unsigned long long)pk2(v[j].x, v[j].y) | ((unsigned long long)pk2(v[j].z, v[j].w) << 32); }
        }
#undef PL_LOAD
    }
    {
        const float* md = mod + (size_t)8 * 6144;
        for (int r = gw; r < NB * CTXL; r += NGW) {
            const int m = (r / CTXL) * TT + r % CTXL;
            norm_row(xctx + (size_t)r * DM, g, md + 1024, md, (unsigned char*)H + (size_t)m * DM * (out8 ? 1 : 2), C.lane, out8, ctxadd ? ctxadd + (size_t)r * DM : nullptr);
        }
    }
}

__device__ __forceinline__ void phase_norm_lat(const Ctx& C, int L, int which, const float* xlat, void* H, int c0) {
    const int gw = (C.wg - c0) * NWAVES + C.wave, NGW = (C.G - c0) * NWAVES;
    const float* g = (which ? C.in[7] : C.in[6]) + L * DM;
    const float* mod = (const float*)(C.ws + WS_MOD) + (size_t)L * 9 * 6144 + (which ? 3072 : 0);
    for (int n = gw; n < NLAT; n += NGW) {
        const int b = n / SEQ, m = b * TT + CTXL + n % SEQ;
        const float* md = mod + (size_t)b * 6144;
        norm_row(xlat + (size_t)n * DM, g, md + 1024, md, (unsigned char*)H + (size_t)m * DM * 2, C.lane, 0);
    }
}
__device__ __forceinline__ void phase_norm_ctx(const Ctx& C, int L, int which, const float* xctx, void* H) {
    const int gw = C.vcu * NWAVES + C.wave, NGW = C.G * NWAVES;
    const float* g = (which ? C.in[7] : C.in[6]) + L * DM;
    const float* md = (const float*)(C.ws + WS_MOD) + (size_t)L * 9 * 6144 + (which ? 3072 : 0) + (size_t)8 * 6144;
    for (int r = gw; r < NB * CTXL; r += NGW) {
        const int m = (r / CTXL) * TT + r % CTXL;
        norm_row(xctx + (size_t)r * DM, g, md + 1024, md, (unsigned char*)H + (size_t)m * DM * 2, C.lane, 0);
    }
}

__device__ __forceinline__ void build_rope_tables(const Ctx& C, LAS float* tab64, LAS float* tab32) {
    for (int i = C.tid; i < 1024; i += 512) { const int pos = i >> 4, f = i & 15; const float invf = exp2f(-(float)f * (13.287712379549449f / 16.0f)); const float rev = ((float)pos * invf) * 0.15915494309189535f;
        tab64[2 * i] = __builtin_amdgcn_cosf(rev); tab64[2 * i + 1] = __builtin_amdgcn_sinf(rev); }
    for (int i = C.tid; i < 512; i += 512) { const int pos = i >> 3, f = i & 7; const float invf = exp2f(-(float)f * (13.287712379549449f / 8.0f)); const float rev = ((float)pos * invf) * 0.15915494309189535f;
        tab32[2 * i] = __builtin_amdgcn_cosf(rev); tab32[2 * i + 1] = __builtin_amdgcn_sinf(rev); }
    __syncthreads();
}
__device__ __forceinline__ size_t kimg_off(int t, int c, int tile_bytes) { return (size_t)(t >> 6) * tile_bytes + c * 1024 + (t & 63) * 16; }
__device__ __forceinline__ size_t vimg_off(int t, int c) { return (size_t)(t >> 6) * 8192 + (c >> 2) * 4096 + ((t & 63) >> 4) * 1024 + (t & 15) * 64 + (c & 3) * 16; }

__device__ __forceinline__ void phase_attn(const Ctx& C, int L) {
    const bf16* QA = (const bf16*)(C.ws + WS_QA); const bf16* QB = (const bf16*)(C.ws + WS_QB); const bf16* QC = (const bf16*)(C.ws + WS_QC);
    const unsigned char* KA = C.ws + WS_KA; const unsigned char* VA = C.ws + WS_VA; const unsigned char* KB = C.ws + WS_KB; const unsigned char* VB = C.ws + WS_VB;
    const unsigned char* KC = C.ws + WS_KC; const unsigned char* VC = C.ws + WS_VC;
    bf16* mix = (bf16*)(C.ws + WS_H);
    const float* sinks = C.in[15] + L * 6;
    const int with_ctx = (L == 0);
    for (int idx = C.vcu; idx < 512 + (with_ctx ? 32 : 0); idx += C.G) {
        att::UnitDesc u; int b, h, row0;
        if (idx < 512) { b = idx >> 6; h = (idx >> 4) & 3; row0 = CTXL + (idx & 15) * 256; u.n0 = KTILES; u.qpos0 = (idx & 15) * 256; }
        else { const int j = idx - 512; b = j >> 2; h = j & 3; row0 = 0; u.n0 = 4; u.qpos0 = 0; }
        u.Q = QB + ((size_t)(b * 4 + h) * TT + row0) * 96; u.Kimg = KB + (size_t)(b * 4 + h) * KTILES * 12288; u.Vimg = VB + (size_t)(b * 4 + h) * KTILES * 8192;
        u.O = mix + ((size_t)b * TT + row0) * DM + 384 + h * 64; u.s1t0 = 0; u.n1 = 0; u.minit = att::NEGBIG; u.linit = 0.f;
        if (idx < 512) att::rope_q96((bf16*)u.Q, u.qpos0);
        att::unit<96, false>(C.lds, u);
    }
    for (int idx = C.vcu; idx < 768 + (with_ctx ? 96 : 0); idx += C.G) {
        att::UnitDesc u; int b, h, row0, isC = 0;
        if (idx < 768) { b = idx / 96; h = (idx >> 4) % 6; row0 = CTXL + (idx & 15) * 256; u.n0 = KTILES; }
        else { int j = idx - 768; if (j >= 48) { j -= 48; isC = 1; } b = j / 6; h = j % 6; row0 = 0; u.n0 = 4; }
        const int hk = h / 3;
        u.Q = (isC ? QC : QA) + ((size_t)(b * 6 + h) * TT + row0) * 64; u.Kimg = (isC ? KC : KA) + (size_t)(b * 2 + hk) * KTILES * 8192; u.Vimg = (isC ? VC : VA) + (size_t)(b * 2 + hk) * KTILES * 8192;
        u.O = mix + ((size_t)b * TT + row0) * DM + (isC ? 640 : 0) + h * 64; u.s1t0 = 0; u.n1 = 0; u.qpos0 = 0;
        u.minit = isC ? sinks[h] * LOG2E : att::NEGBIG; u.linit = isC ? 1.f : 0.f;
        att::unit<64, false>(C.lds, u);
    }
    for (int idx = C.vcu; idx < 768; idx += C.G) {
        att::UnitDesc u; const int b = idx / 96, h = (idx >> 4) % 6, qb = idx & 15, hk = h / 3, row0 = CTXL + qb * 256;
        const int lt0 = 4 * qb - 2, ls = lt0 < 0 ? 0 : lt0, le = (lt0 + 10 > 64) ? 64 : lt0 + 10;
        u.Q = QC + ((size_t)(b * 6 + h) * TT + row0) * 64; u.Kimg = KC + (size_t)(b * 2 + hk) * KTILES * 8192; u.Vimg = VC + (size_t)(b * 2 + hk) * KTILES * 8192;
        u.O = mix + ((size_t)b * TT + row0) * DM + 640 + h * 64; u.n0 = 4; u.s1t0 = 4 + ls; u.n1 = le - ls; u.qpos0 = qb * 256;
        u.minit = sinks[h] * LOG2E; u.linit = 1.f;
        att::unit<64, true>(C.lds, u);
    }
}

constexpr int MOE_I_UP = 16 * 112, MOE_I_DN = 56 * 32, MOE_ITEMS = NEXP * (2 * MOE_I_UP + MOE_I_DN);
struct MoeItem { const float* Wb; int ldw; unsigned char* WT; int dpitch, k0, n0, inter, roff; };
__device__ __forceinline__ MoeItem moe_item_desc(const Ctx& C, int it) {
    unsigned char* wmup = C.ws + WS_WMUP; unsigned char* wmdn = C.ws + WS_WMDN;
    const int e = it / (2 * MOE_I_UP + MOE_I_DN); int r = it % (2 * MOE_I_UP + MOE_I_DN);
    MoeItem d;
    if (r < 2 * MOE_I_UP) { const int w3 = r >= MOE_I_UP; if (w3) r -= MOE_I_UP; const int nblk = FFE / 32, kb = r / nblk, nb = r % nblk;
        d.ldw = FFE; d.k0 = 64 * kb; d.n0 = 32 * nb; d.Wb = (w3 ? C.in[22] : C.in[21]) + (size_t)e * DM * FFE + (size_t)d.k0 * FFE + d.n0; d.WT = wmup + (size_t)e * 2 * FFE * DM; d.dpitch = DM; d.inter = 1; d.roff = w3; }
    else { r -= 2 * MOE_I_UP; const int nblk = DM / 32, kb = r / nblk, nb = r % nblk;
        d.ldw = DM; d.k0 = 64 * kb; d.n0 = 32 * nb; d.Wb = C.in[23] + (size_t)e * FFE * DM + (size_t)d.k0 * DM + d.n0; d.WT = wmdn + (size_t)e * DM * FFE; d.dpitch = FFE; d.inter = 0; d.roff = 0; }
    return d;
}
__device__ __forceinline__ void moe_item_load(const MoeItem& d, float (&tv)[32], int lane) {
#pragma unroll
    for (int i = 0; i < 32; ++i) tv[i] = d.Wb[(unsigned)((2 * i + (lane >> 5)) * d.ldw + (lane & 31))];
}
__device__ __forceinline__ void moe_item_store(const MoeItem& d, const float (&tv)[32], LAS float* scr, int lane) {
#pragma unroll
    for (int i = 0; i < 32; ++i) { const int kk = 2 * i + (lane >> 5); scr[kk * 33 + (lane & 31)] = tv[i]; }
    LDS_WAIT(); asm volatile("" ::: "memory");
    const int c = lane & 7;
#pragma unroll
    for (int j = 0; j < 4; ++j) { const int n = (lane >> 3) + 8 * j; const LAS float* sp = scr + (8 * c) * 33 + n;
        const int nn = d.n0 + n; const int drow = d.inter ? (256 * (nn >> 7) + 128 * d.roff + (nn & 127)) : nn;
        typedef unsigned u32x2v __attribute__((ext_vector_type(2))); u32x2v o;
        o.x = pk4_fp8(sp[0 * 33] * F8_SW, sp[1 * 33] * F8_SW, sp[2 * 33] * F8_SW, sp[3 * 33] * F8_SW); o.y = pk4_fp8(sp[4 * 33] * F8_SW, sp[5 * 33] * F8_SW, sp[6 * 33] * F8_SW, sp[7 * 33] * F8_SW);
        *(u32x2v*)(d.WT + (size_t)drow * d.dpitch + d.k0 + 8 * c) = o; }
    LDS_WAIT(); asm volatile("" ::: "memory");
}
__device__ __forceinline__ void moe_convert_two(const Ctx& C, int it0, int it1) {
    LAS float* scr = (LAS float*)(C.lds + C.wave * 16384);
    const bool v0 = it0 < MOE_ITEMS, v1 = it1 < MOE_ITEMS;
    float ta[32], tb[32];
    MoeItem d0, d1;
    if (v0) { d0 = moe_item_desc(C, it0); moe_item_load(d0, ta, C.lane); }
    if (v1) { d1 = moe_item_desc(C, it1); moe_item_load(d1, tb, C.lane); }
    if (v0) moe_item_store(d0, ta, scr, C.lane);
    if (v1) moe_item_store(d1, tb, scr, C.lane);
}
__device__ __forceinline__ void moe_convert_steal(const Ctx& C, unsigned* ctr, unsigned* done, int need_done, bool count_done) {
    LAS int* sh = (LAS int*)(C.lds + 130048);
    if (count_done && C.tid == 0) __hip_atomic_fetch_add(done, 1u, __ATOMIC_RELAXED, __HIP_MEMORY_SCOPE_AGENT);
    for (;;) {
        __syncthreads();
        if (C.tid == 0) { int base = -1;
            if (!count_done || (int)__hip_atomic_load(done, __ATOMIC_RELAXED, __HIP_MEMORY_SCOPE_AGENT) < need_done) base = (int)__hip_atomic_fetch_add(ctr, 16u, __ATOMIC_RELAXED, __HIP_MEMORY_SCOPE_AGENT);
            sh[0] = base; }
        __syncthreads();
        const int base = sh[0];
        if (base < 0 || base >= MOE_ITEMS) break;
        moe_convert_two(C, base + C.wave, base + C.wave + NWAVES);
    }
    __syncthreads();
}

__device__ __forceinline__ void phase_route1(const Ctx& C) {
    LAS f32x4* wr0 = (LAS f32x4*)C.lds; LAS f32x4* wr1 = wr0 + 1024;
    LAS int* hist = (LAS int*)(C.lds + 32768);
    const f32x4* wrg = (const f32x4*)C.in[20];
    for (int k = C.tid; k < 1024; k += 512) { const int slot = ((k >> 8) * 4 + (k & 3)) * 64 + ((k & 255) >> 2); wr0[slot] = wrg[2 * k]; wr1[slot] = wrg[2 * k + 1]; }
    if (C.tid < 8) hist[C.tid] = 0;
    __syncthreads();
    const float* g = C.in[7] + DM; const float* mod = (const float*)(C.ws + WS_MOD) + (size_t)9 * 6144 + 3072;
    unsigned char* H8 = C.ws + WS_H;
    int* tope = (int*)(C.ws + WS_RT + RT_TOPE); float* gate = (float*)(C.ws + WS_RT + RT_GATE);
    const int TPW = NLAT / C.G;
    f32x4 ca[4], cb[4];
    { const float* md = mod + (size_t)((C.wg * TPW) / SEQ) * 6144;
#pragma unroll
      for (int j = 0; j < 4; ++j) { ca[j] = ((const f32x4*)g)[C.lane + 64 * j] * (((const f32x4*)(md + 1024))[C.lane + 64 * j] + 1.0f); cb[j] = ((const f32x4*)md)[C.lane + 64 * j]; } }
    unsigned long long rx[4], rd[4];
#define R1_LOAD(n_) do { const unsigned long long* xr_ = xs_row(C.out, (n_)) + C.lane; const unsigned long long* dr_ = (const unsigned long long*)((const bf16*)(C.ws + WS_D1) + (size_t)(n_) * DM) + C.lane; \
        _Pragma("unroll") for (int j = 0; j < 4; ++j) { rx[j] = xr_[64 * j]; rd[j] = dr_[64 * j]; } } while (0)
    R1_LOAD(C.wg * TPW + C.wave);
    for (int i = C.wave; i < TPW; i += NWAVES) {
        const int n = C.wg * TPW + i;
        f32x4 v[4]; float s = 0.f;
#pragma unroll
        for (int j = 0; j < 4; ++j) { f32x4 d; XS_UNPACK(v[j], rx[j]); XS_UNPACK(d, rd[j]); v[j] = v[j] + d; s += (v[j].x * v[j].x + v[j].y * v[j].y) + (v[j].z * v[j].z + v[j].w * v[j].w); }
        if (i + NWAVES < TPW) R1_LOAD(n + NWAVES);
        const float rinv = fast_rsqrt(wave_sum(s) * (1.f / DM) + EPS);
        unsigned* o8 = (unsigned*)(H8 + (size_t)n * DM) + C.lane;
        float lg[8];
#pragma unroll
        for (int e = 0; e < 8; ++e) lg[e] = 0.f;
#pragma unroll
        for (int j = 0; j < 4; ++j) {
            const f32x4 y = v[j] * rinv * ca[j] + cb[j];
            o8[64 * j] = pk4_fp8(y.x * F8_SA, y.y * F8_SA, y.z * F8_SA, y.w * F8_SA);
#pragma unroll
            for (int q = 0; q < 4; ++q) { const f32x4 w0 = wr0[(4 * j + q) * 64 + C.lane], w1 = wr1[(4 * j + q) * 64 + C.lane]; const float yy = y[q];
                lg[0] += yy * w0.x; lg[1] += yy * w0.y; lg[2] += yy * w0.z; lg[3] += yy * w0.w; lg[4] += yy * w1.x; lg[5] += yy * w1.y; lg[6] += yy * w1.z; lg[7] += yy * w1.w; } }
#pragma unroll
        for (int e = 0; e < 8; ++e) lg[e] = wave_sum(lg[e]);
        int e1 = 0; float l1 = lg[0];
#pragma unroll
        for (int e = 1; e < 8; ++e) if (lg[e] > l1) { l1 = lg[e]; e1 = e; }
        int e2 = -1; float l2 = -3.0e38f;
#pragma unroll
        for (int e = 0; e < 8; ++e) if (e != e1 && lg[e] > l2) { l2 = lg[e]; e2 = e; }
        const float g2 = 1.0f / (1.0f + __expf(l1 - l2)), g1 = 1.0f - g2;
        if (C.lane == 0) { tope[2 * n] = e1; tope[2 * n + 1] = e2; gate[2 * n] = g1; gate[2 * n + 1] = g2; __hip_atomic_fetch_add(hist + e1, 1, __ATOMIC_RELAXED, __HIP_MEMORY_SCOPE_WORKGROUP); __hip_atomic_fetch_add(hist + e2, 1, __ATOMIC_RELAXED, __HIP_MEMORY_SCOPE_WORKGROUP); }
    }
    __syncthreads();
    if (C.tid < 8) ((int*)(C.ws + WS_RT + RT_HIST))[C.wg * 8 + C.tid] = hist[C.tid];
    __syncthreads();
    moe_convert_steal(C, (unsigned*)(C.ws + WS_CTL) + CW_STEAL, (unsigned*)(C.ws + WS_CTL) + CW_DONE, 0x7fffffff, false);
}

__device__ __forceinline__ void phase_route2(const Ctx& C) {
    LAS int* hl = (LAS int*)C.lds;
    LAS int* cnt = (LAS int*)(C.lds + 16384); LAS int* pre = cnt + 8; LAS int* off = cnt + 16;
    LAS int* ep = (LAS int*)(C.lds + 20480); LAS int* posl = ep + 512;
    const int* hist = (const int*)(C.ws + WS_RT + RT_HIST);
    for (int i = C.tid; i < C.G * 8; i += 512) hl[i] = hist[i];
    __syncthreads();
    if (C.tid < 8) { int s = 0, p = 0; for (int w = 0; w < C.G; ++w) { const int hv = hl[w * 8 + C.tid]; if (w < C.wg) p += hv; s += hv; } cnt[C.tid] = s; pre[C.tid] = p; }
    __syncthreads();
    if (C.tid == 0) { int o = 0; for (int e = 0; e < 8; ++e) { off[e] = o; o += (cnt[e] + 255) & ~255; } off[8] = o; }
    __syncthreads();
    const int TPW = NLAT / C.G, NP = 2 * TPW;
    const int* tope = (const int*)(C.ws + WS_RT + RT_TOPE); int* posg = (int*)(C.ws + WS_RT + RT_POS);
    for (int p = C.tid; p < NP; p += 512) ep[p] = tope[2 * (C.wg * TPW) + p];
    __syncthreads();
    for (int p = C.tid; p < NP; p += 512) { const int e = ep[p]; int rank = 0; for (int q = 0; q < p; ++q) rank += (ep[q] == e) ? 1 : 0; const int pos = off[e] + pre[e] + rank; posl[p] = pos; posg[2 * (C.wg * TPW) + p] = pos; }
    __syncthreads();
    const unsigned char* H8 = C.ws + WS_H; unsigned char* HFS = C.ws + WS_HFS;
    for (int i0 = C.wave; i0 < TPW; i0 += 8 * NWAVES) {
        v4u a[8];
#pragma unroll
        for (int k = 0; k < 8; ++k) { const int i = i0 + k * NWAVES; if (i < TPW) a[k] = ((const v4u*)(H8 + (size_t)(C.wg * TPW + i) * DM))[C.lane]; }
#pragma unroll
        for (int k = 0; k < 8; ++k) { const int i = i0 + k * NWAVES; if (i < TPW) { ((v4u*)(HFS + (size_t)posl[2 * i] * DM))[C.lane] = a[k]; ((v4u*)(HFS + (size_t)posl[2 * i + 1] * DM))[C.lane] = a[k]; } }
    }
    int* tile_e = (int*)(C.ws + WS_RT + RT_TILEE);
    if (C.wg == 0) { for (int tl = C.tid; tl < 272; tl += 512) { int e = 7; for (int q = 7; q >= 0; --q) if (tl * 256 < off[q + 1]) e = q; tile_e[tl] = e; } if (C.tid == 0) tile_e[272] = off[8] >> 8; }
    if (C.wg < 8) { const int e = C.wg; for (int r = off[e] + cnt[e] + C.wave; r < off[e + 1]; r += NWAVES) ((v4u*)(HFS + (size_t)r * DM))[C.lane] = (v4u){0u, 0u, 0u, 0u}; }
}

constexpr int FIN_BLK = 64, FIN_TAILROW = MOE_CH * (MOE_NCH - 1) * 256;
struct FinTok { f32x4 x[4], gg[4]; unsigned long long a[4], c[4]; };
__device__ __forceinline__ void fin_load(const Ctx& C, FinTok& t, int n, int p0, int p1) {
    const unsigned long long* xr = xs_row(C.out, n) + C.lane; const bf16* Y = (const bf16*)(C.ws + WS_Y);
    const unsigned long long* y0 = (const unsigned long long*)(Y + (size_t)p0 * DM) + C.lane; const unsigned long long* y1 = (const unsigned long long*)(Y + (size_t)p1 * DM) + C.lane;
    const float* gt = (const float*)(C.ws + WS_MOD) + (size_t)9 * 6144 + 5120 + (size_t)(n / SEQ) * 6144;
    const unsigned long long* dr = (const unsigned long long*)((const bf16*)(C.ws + WS_D1) + (size_t)n * DM) + C.lane;
#pragma unroll
    for (int j = 0; j < 4; ++j) { const unsigned long long xb = xr[64 * j]; f32x4 x; XS_UNPACK(x, xb); const unsigned long long d = dr[64 * j]; t.a[j] = y0[64 * j]; t.c[j] = y1[64 * j]; t.gg[j] = ((const f32x4*)gt)[C.lane + 64 * j];
        t.x[j].x = x.x + bflo((unsigned)d); t.x[j].y = x.y + bfhi((unsigned)d); t.x[j].z = x.z + bflo((unsigned)(d >> 32)); t.x[j].w = x.w + bfhi((unsigned)(d >> 32)); }
}
__device__ __forceinline__ void fin_finish(const Ctx& C, const FinTok& t, int n, float g0, float g1, const f32x4 (&fnv)[4]) {
    f32x4* xr = (f32x4*)(C.out + (size_t)n * DM) + C.lane;
    f32x4 v[4]; float s = 0.f;
#pragma unroll
    for (int j = 0; j < 4; ++j) { const unsigned long long a = t.a[j], c = t.c[j]; const f32x4 gg = t.gg[j];
        f32x4 ya, yc; ya.x = bflo((unsigned)a); ya.y = bfhi((unsigned)a); ya.z = bflo((unsigned)(a >> 32)); ya.w = bfhi((unsigned)(a >> 32));
        yc.x = bflo((unsigned)c); yc.y = bfhi((unsigned)c); yc.z = bflo((unsigned)(c >> 32)); yc.w = bfhi((unsigned)(c >> 32));
        v[j] = t.x[j] + gg * (ya * g0 + yc * g1); s += (v[j].x * v[j].x + v[j].y * v[j].y) + (v[j].z * v[j].z + v[j].w * v[j].w); }
    const float rinv = fast_rsqrt(wave_sum(s) * (1.f / DM) + EPS);
#pragma unroll
    for (int j = 0; j < 4; ++j) xr[64 * j] = v[j] * rinv * fnv[j];
}
__device__ __forceinline__ void fin_row_acc(const Ctx& C, int p, float g, f32x4 (&y)[4]) {
    if (p < FIN_TAILROW) { const unsigned long long* yr = (const unsigned long long*)((const bf16*)(C.ws + WS_Y) + (size_t)p * DM) + C.lane;
#pragma unroll
        for (int j = 0; j < 4; ++j) { const unsigned long long a = yr[64 * j]; y[j].x += g * bflo((unsigned)a); y[j].y += g * bfhi((unsigned)a); y[j].z += g * bflo((unsigned)(a >> 32)); y[j].w += g * bfhi((unsigned)(a >> 32)); } }
    else for (int ks = 0; ks < MOE_TAILK; ++ks) { const unsigned long long* yr = (const unsigned long long*)((const bf16*)(C.ws + WS_YT) + ((size_t)ks * 2048 + (p - FIN_TAILROW)) * DM) + C.lane;
#pragma unroll
        for (int j = 0; j < 4; ++j) { const unsigned long long a = yr[64 * j]; y[j].x += g * bflo((unsigned)a); y[j].y += g * bfhi((unsigned)a); y[j].z += g * bflo((unsigned)(a >> 32)); y[j].w += g * bfhi((unsigned)(a >> 32)); } }
}
__device__ __forceinline__ void fin_tail_token(const Ctx& C, int n, int p0, int p1, float g0, float g1) {
    const float* gt = (const float*)(C.ws + WS_MOD) + (size_t)9 * 6144 + 5120 + (size_t)(n / SEQ) * 6144; const float* fn = C.in[24];
    f32x4* xr = (f32x4*)(C.out + (size_t)n * DM) + C.lane; const unsigned long long* xs = xs_row(C.out, n) + C.lane;
    f32x4 y[4];
#pragma unroll
    for (int j = 0; j < 4; ++j) y[j] = (f32x4){0.f, 0.f, 0.f, 0.f};
    fin_row_acc(C, p0, g0, y); fin_row_acc(C, p1, g1, y);
    f32x4 v[4]; float s = 0.f;
#pragma unroll
    for (int j = 0; j < 4; ++j) { const f32x4 gg = ((const f32x4*)gt)[C.lane + 64 * j]; const unsigned long long d = ((const unsigned long long*)((const bf16*)(C.ws + WS_D1) + (size_t)n * DM) + C.lane)[64 * j];
        const unsigned long long xb = xs[64 * j]; f32x4 xd; XS_UNPACK(xd, xb); xd.x += bflo((unsigned)d); xd.y += bfhi((unsigned)d); xd.z += bflo((unsigned)(d >> 32)); xd.w += bfhi((unsigned)(d >> 32));
        v[j] = xd + gg * y[j]; s += (v[j].x * v[j].x + v[j].y * v[j].y) + (v[j].z * v[j].z + v[j].w * v[j].w); }
    const float rinv = fast_rsqrt(wave_sum(s) * (1.f / DM) + EPS);
#pragma unroll
    for (int j = 0; j < 4; ++j) xr[64 * j] = v[j] * rinv * ((const f32x4*)fn)[C.lane + 64 * j];
}
__device__ __forceinline__ void final_tokens(const Ctx& C, int nbase, int nstride, int cnt, bool want_tail) {
    const int* posg = (const int*)(C.ws + WS_RT + RT_POS); const float* gate = (const float*)(C.ws + WS_RT + RT_GATE);
    int p0v = 0, p1v = 0; float g0v = 0.f, g1v = 0.f; bool sel = false;
    if (C.lane < cnt) { const int n = nbase + C.lane * nstride; p0v = posg[2 * n]; p1v = posg[2 * n + 1]; g0v = gate[2 * n]; g1v = gate[2 * n + 1]; sel = ((p0v >= FIN_TAILROW) || (p1v >= FIN_TAILROW)) == want_tail; }
    unsigned long long todo = __ballot(sel);
    f32x4 fnv[4];
#pragma unroll
    for (int j = 0; j < 4; ++j) fnv[j] = ((const f32x4*)C.in[24])[C.lane + 64 * j];
    if (want_tail) {
        while (todo) { const int k = __builtin_ctzll(todo); todo &= todo - 1;
            fin_tail_token(C, nbase + k * nstride, __builtin_amdgcn_readlane(p0v, k), __builtin_amdgcn_readlane(p1v, k),
                           __builtin_bit_cast(float, __builtin_amdgcn_readlane(__builtin_bit_cast(int, g0v), k)), __builtin_bit_cast(float, __builtin_amdgcn_readlane(__builtin_bit_cast(int, g1v), k))); }
        return;
    }
    while (todo) {
        const int k0 = __builtin_ctzll(todo); todo &= todo - 1;
        const int n0 = nbase + k0 * nstride; const int a0 = __builtin_amdgcn_readlane(p0v, k0), b0 = __builtin_amdgcn_readlane(p1v, k0);
        const float ga0 = __builtin_bit_cast(float, __builtin_amdgcn_readlane(__builtin_bit_cast(int, g0v), k0)), gb0 = __builtin_bit_cast(float, __builtin_amdgcn_readlane(__builtin_bit_cast(int, g1v), k0));
        FinTok t0; fin_load(C, t0, n0, a0, b0);
        if (todo) {
            const int k1 = __builtin_ctzll(todo); todo &= todo - 1;
            const int n1 = nbase + k1 * nstride; const int a1 = __builtin_amdgcn_readlane(p0v, k1), b1 = __builtin_amdgcn_readlane(p1v, k1);
            const float ga1 = __builtin_bit_cast(float, __builtin_amdgcn_readlane(__builtin_bit_cast(int, g0v), k1)), gb1 = __builtin_bit_cast(float, __builtin_amdgcn_readlane(__builtin_bit_cast(int, g1v), k1));
            FinTok t1; fin_load(C, t1, n1, a1, b1);
            fin_finish(C, t0, n0, ga0, gb0, fnv); fin_finish(C, t1, n1, ga1, gb1, fnv);
        } else fin_finish(C, t0, n0, ga0, gb0, fnv);
    }
}
__device__ __forceinline__ void final_steal(const Ctx& C) {
    LAS int* sh = (LAS int*)(C.lds + 130048);
    unsigned* ctr = (unsigned*)(C.ws + WS_CTL) + CW_FINAL;
    for (;;) {
        __syncthreads();
        if (C.tid == 0) sh[0] = (int)__hip_atomic_fetch_add(ctr, 1u, __ATOMIC_RELAXED, __HIP_MEMORY_SCOPE_AGENT);
        __syncthreads();
        const int blk = sh[0];
        if (blk >= NLAT / FIN_BLK) break;
        final_tokens(C, blk * FIN_BLK + C.wave * (FIN_BLK / NWAVES), 1, FIN_BLK / NWAVES, false);
    }
    __syncthreads();
}
__device__ __forceinline__ void phase_final(const Ctx& C) {
    final_steal(C);
    const int gw = C.vcu * NWAVES + C.wave, NGW = C.G * NWAVES;
    final_tokens(C, gw, NGW, NLAT / NGW, true);
}
#ifndef MK_SPLIT
#define MK_SPLIT 0
#endif
constexpr int N_PHASES = 31;
#define GP_ALIGN true
#define GP_SP2 true


#ifndef PH_MASK
#define PH_MASK 0x7fffffffu
#endif
#define IN(k) (((PH_MASK >> (k)) & 1u) && lo <= (k) && (k) < hi)
#define SEAM(k) do { if (IN(k) && IN((k) + 1)) xcd_barrier(bar); } while (0)
#ifndef PH_REP
#define PH_REP 0u
#endif
#ifndef PH_URE
#define PH_URE 0u
#endif
#define UREP(k) (1 + (int)((PH_URE >> (k)) & 1u))
#define REPEAT(k) for (int rep_ = 0; rep_ < 1 + (int)((PH_REP >> (k)) & 1u); ++rep_)
#ifndef MK_STEAL
#define MK_STEAL 1
#endif
#define STEAL(k) do { if (MK_STEAL) moe_convert_steal(C, (unsigned*)(C.ws + WS_CTL) + CW_STEAL, (unsigned*)(C.ws + WS_CTL) + CW_DONE + 64 * (k), (int)C.G, true); } while (0)
template <int L>
__device__ __forceinline__ void layer_phases(const Ctx& C0, const Args& args, const XcdBarrier& bar, const int lo, const int hi) {
    Ctx C = C0; asm volatile("" : "+v"(C.tid), "+v"(C.lane));
    unsigned char* ws = C.ws;
    float* xc = (float*)(ws + WS_XC);
    bf16* Hb = (bf16*)(ws + WS_H);
    const float* modall = (const float*)(ws + WS_MOD);
        const int pb = 1 + 10 * L;
        const float* xlat = (L == 0) ? args.in[0] : (const float*)args.out;
        const float* xctx = (L == 0) ? args.in[2] : (const float*)xc;
        const float* modL = modall + (size_t)L * 9 * 6144;
        if (IN(pb + 0)) { REPEAT(pb + 0) phase_norm(C, L, 0, xlat, xctx, Hb, 0, L == 1 ? (const float*)(ws + WS_PART) : nullptr, L == 1 ? (const bf16*)(ws + WS_D2) : nullptr, L == 1 ? args.out : nullptr, L == 1); SEAM(pb + 0); }
        if (IN(pb + 1)) {
            LAS float* tab64 = (LAS float*)(C.lds + LDSCTL_OFF + 1024); LAS float* tab32 = tab64 + 2048;
            build_rope_tables(C, tab64, tab32);
            pg8::Gemm g{(const pg8::bf16_t*)Hb, (const pg8::bf16_t*)(ws + WS_WIN) + (size_t)L * NPROJ * DM, MROWS, NPROJ, DM};
            TileSched S; S.init(MROWS / 256, NPROJ / 256, C.G, C.wg, 0, UREP(pb + 1));
            EpiProj E{(pg8::bf16_t*)(ws + WS_QA), ws + WS_KA, ws + WS_VA, (pg8::bf16_t*)(ws + WS_QC), ws + WS_KC, ws + WS_VC, (pg8::bf16_t*)(ws + WS_CQKV), ws + WS_KB, (float*)(ws + WS_SSQ), (float*)(ws + WS_SSK),
                      args.in[9] + L * 64, args.in[10] + L * 64, tab64, tab32};
            REPEAT(pb + 1) pg8::gemm_phase<EpiProj, TileSched, GP_ALIGN, GP_SP2>(C.lds, g, S, E);
            STEAL(pb + 1);
            if (IN(pb + 1) && IN(pb + 3)) xcd_barrier(bar);
        }
        if (IN(pb + 3)) {
            int kub = 384; asm volatile("" : "+s"(kub));
            int kwin = 256; asm volatile("" : "+s"(kwin));
            pg8::Gemm g{(const pg8::bf16_t*)(ws + WS_CQKV), (const pg8::bf16_t*)(ws + WS_WUB) + (size_t)L * 1024 * 384, MROWS, 1024, kub, kwin, 0, 0, 256};
            UpBSched S; S.T.init(MROWS / 256, 4, C.G, C.wg, 0, UREP(pb + 3));
            EpiUpB E{(pg8::bf16_t*)(ws + WS_QB), ws + WS_KB, ws + WS_VB, (const float*)(ws + WS_SSQ), (const float*)(ws + WS_SSK)};
            REPEAT(pb + 3) pg8::gemm_phase<EpiUpB, UpBSched, GP_ALIGN, GP_SP2, false, true>(C.lds, g, S, E);
            STEAL(pb + 3);
            if (IN(pb + 3) && IN(pb + 5)) xcd_barrier(bar);
        }
        if (IN(pb + 5)) { REPEAT(pb + 5) phase_attn(C, L); SEAM(pb + 5); }
        if (IN(pb + 6)) {
            pg8::Gemm g{(const pg8::bf16_t*)Hb, (const pg8::bf16_t*)(ws + WS_WOUT) + (size_t)L * DM * DM, MROWS, DM, DM};
            TileSched S; S.init(NLAT / 256, 4, C.G, C.wg, 1, L == 0 ? UREP(7) : 1);
            {
                EpiGateBf16 E{(pg8::bf16_t*)(ws + (L == 0 ? WS_D0 : WS_D1)), modL + 2048, 1.0f};
                REPEAT(pb + 6) pg8::gemm_phase<EpiGateBf16, TileSched, GP_ALIGN, GP_SP2>(C.lds, g, S, E); }
            if (L == 0) {
                pg8::Gemm g2{(const pg8::bf16_t*)Hb, (const pg8::bf16_t*)(ws + WS_WOUT), MROWS, DM, DM, DM / 2};
                CtxSplitSched S2{C.wg};
                EpiResidPart E2{xctx, nullptr, xc, (float*)(ws + WS_PART2), modL + 2048, 1.0f};
                pg8::gemm_phase<EpiResidPart, CtxSplitSched, GP_ALIGN, GP_SP2, false, true>(C.lds, g2, S2, E2);
                STEAL(pb + 6);
            }
            SEAM(pb + 6);
        }
        if (L == 0) {
            if (IN(8)) { REPEAT(8) phase_norm(C, 0, 1, args.in[0], xc, Hb, DENSE_F8 | DENSE_F8_UP, (const float*)(ws + WS_PART2), (const bf16*)(ws + WS_D0), args.out); SEAM(8); }
            if (IN(9)) {
                constexpr bool F8D = (DENSE_F8 | DENSE_F8_DN) != 0, F8IN = (DENSE_F8 | DENSE_F8_UP) != 0;
                pg8::Gemm g{(const pg8::bf16_t*)Hb, (const pg8::bf16_t*)(ws + WS_WUP), MROWS, 2 * FFD, F8IN ? DM / 2 : DM};
                TileSched S; S.init(MROWS / 256, 2 * FFD / 256, C.G, C.wg, 0, UREP(9));
                EpiSwiglu<F8D> E{(void*)(ws + WS_U), FFD, 2 * FFD / 256, 0, F8IN ? 1.0f / (F8_SA * F8_SW) : 1.0f, F8_SU};
                REPEAT(9) pg8::gemm_phase<EpiSwiglu<F8D>, TileSched, GP_ALIGN, GP_SP2, F8IN>(C.lds, g, S, E);
                STEAL(9);
                SEAM(9);
            }
            if (IN(10)) {
                constexpr bool F8D = (DENSE_F8 | DENSE_F8_DN) != 0;
                pg8::Gemm g{(const pg8::bf16_t*)(ws + WS_U), (const pg8::bf16_t*)(ws + WS_WDN), MROWS, DM, F8D ? FFD / 2 : FFD};
                EpiGateBf16 E{(pg8::bf16_t*)(ws + WS_D2), modL + 5120, F8D ? 1.0f / (F8_SU * F8_SW) : 1.0f};
                TileSched S; S.init(NLAT / 256, 4, C.G, C.wg, 1);
                REPEAT(10) pg8::gemm_phase<EpiGateBf16, TileSched, GP_ALIGN, GP_SP2, F8D>(C.lds, g, S, E);
                {
                    pg8::Gemm g2{(const pg8::bf16_t*)(ws + WS_U), (const pg8::bf16_t*)(ws + WS_WDN), MROWS, DM, F8D ? FFD / 2 : FFD, F8D ? 768 : FFD / 2, F8D ? FFD / 2 - 768 : 0, 2};
                    CtxSplitSched S2{C.wg};
                    EpiResidPart E2{xc, (const float*)(ws + WS_PART2), xc, (float*)(ws + WS_PART), modL + 5120, F8D ? 1.0f / (F8_SU * F8_SW) : 1.0f};
                    pg8::gemm_phase<EpiResidPart, CtxSplitSched, GP_ALIGN, GP_SP2, F8D, true>(C.lds, g2, S2, E2);
                }
                STEAL(10);
                SEAM(10);
            }
        }
    }

__global__ void __launch_bounds__(NWAVES * 64, 2) mk_fwd(Args args) {
    extern __shared__ __attribute__((aligned(16))) unsigned char lds_raw[];
    Ctx C;
    C.lds = (LAS unsigned char*)lds_raw;
    C.tid = threadIdx.x; C.lane = C.tid & 63; C.wave = __builtin_amdgcn_readfirstlane(C.tid >> 6);
    C.G = gridDim.x; C.wg = blockIdx.x; { const int bx = blockIdx.x; C.vcu = (C.G % 8 == 0) ? (bx % 8) * (C.G / 8) + bx / 8 : bx; }
    C.in = args.in; C.out = args.out; C.ws = args.ws;
    volatile LAS unsigned* MISC = (volatile LAS unsigned*)(C.lds + MISC_OFF);
    for (int u = C.tid; u < (LDS_BYTES - LDSCTL_OFF) / 4; u += NWAVES * 64) ((LAS unsigned*)(C.lds + LDSCTL_OFF))[u] = 0u;
    __syncthreads();
    unsigned* ctl = (unsigned*)(C.ws + WS_CTL);
    XcdBarrier bar = xcd_barrier_post(ctl + CW_BAR, MISC + 8);
    const int lo = args.ph_lo, hi = args.ph_hi;
    unsigned char* ws = C.ws;
    float* xc = (float*)(ws + WS_XC);
    bf16* Hb = (bf16*)(ws + WS_H);
    const float* modall = (const float*)(ws + WS_MOD);

    if (IN(0)) { REPEAT(0) { phase_prologue(C); __syncthreads(); } SEAM(0); }

    layer_phases<0>(C, args, bar, lo, hi);
    layer_phases<1>(C, args, bar, lo, hi);
    Ctx Cr = C; asm volatile("" : "+v"(Cr.tid), "+v"(Cr.lane));
    if (IN(18)) { REPEAT(18) { phase_route1(Cr); __syncthreads(); } SEAM(18); }
    if (IN(19)) { REPEAT(19) { phase_route2(Cr); __syncthreads(); } SEAM(19); }
    {
        const int* tile_e = (const int*)(ws + WS_RT + RT_TILEE);
        for (int ch = 0; ch < MOE_NCH - 1; ++ch) {
            const int pu = 20 + 2 * ch;
            int ntiles = 0;
            if (IN(pu) || IN(pu + 1)) ntiles = __builtin_amdgcn_readfirstlane(__hip_atomic_load(tile_e + 272, __ATOMIC_RELAXED, __HIP_MEMORY_SCOPE_AGENT));
            int ntc = ntiles - MOE_CH * ch; ntc = ntc < 0 ? 0 : (ntc > MOE_CH ? MOE_CH : ntc);
            if (IN(pu)) {
                pg8::Gemm g{(const pg8::bf16_t*)(ws + WS_HFS), (const pg8::bf16_t*)(ws + WS_WMUP), MOE_MAXT * 256, NEXP * 2 * FFE, DM / 2};
                MoeSched S{tile_e, MOE_CH * ch, ntc, 2 * FFE / 256, C.G, C.wg, 1};
                EpiSwiglu<true> E{(void*)(ws + ((ch & 1) ? WS_UM2 : WS_UM)), FFE, 2 * FFE / 256, -MOE_CH * ch, 1.0f / (F8_SA * F8_SW), F8_SU};
                REPEAT(pu) pg8::gemm_phase<EpiSwiglu<true>, MoeSched, GP_ALIGN, GP_SP2, true>(C.lds, g, S, E);
                SEAM(pu);
            }
            if (IN(pu + 1)) {
                pg8::Gemm g{(const pg8::bf16_t*)(ws + ((ch & 1) ? WS_UM2 : WS_UM)), (const pg8::bf16_t*)(ws + WS_WMDN), MOE_CH * 256, NEXP * DM, FFE / 2};
                MoeSched S{tile_e, MOE_CH * ch, ntc, 4, C.G, C.wg, 0};
                EpiStoreBf16 E{(pg8::bf16_t*)(ws + WS_Y), DM, 4, MOE_CH * ch, 1.0f / (F8_SU * F8_SW)};
                REPEAT(pu + 1) pg8::gemm_phase<EpiStoreBf16, MoeSched, GP_ALIGN, GP_SP2, true>(C.lds, g, S, E);
                if (ch == MOE_NCH - 2 || MK_SPLIT) SEAM(pu + 1);
            }
        }
        {
            constexpr int ch = MOE_NCH - 1, pu = 20 + 2 * ch;
            int ntiles = 0;
            if (IN(pu) || IN(pu + 1)) ntiles = __builtin_amdgcn_readfirstlane(__hip_atomic_load(tile_e + 272, __ATOMIC_RELAXED, __HIP_MEMORY_SCOPE_AGENT));
            int ntc = ntiles - MOE_CH * ch; ntc = ntc < 0 ? 0 : (ntc > 8 ? 8 : ntc);
            if (IN(pu)) {
                pg8::Gemm g{(const pg8::bf16_t*)(ws + WS_HFS), (const pg8::bf16_t*)(ws + WS_WMUP), MOE_MAXT * 256, NEXP * 2 * FFE, DM / 2};
                MoeSched S{tile_e, MOE_CH * ch, ntc, 2 * FFE / 256, C.G, C.wg, 1};
                EpiSwiglu<true> E{(void*)(ws + WS_UM), FFE, 2 * FFE / 256, -MOE_CH * ch, 1.0f / (F8_SA * F8_SW), F8_SU};
                pg8::gemm_phase<EpiSwiglu<true>, MoeSched, GP_ALIGN, GP_SP2, true>(C.lds, g, S, E);
                final_steal(Cr);
                SEAM(pu);
            }
            if (IN(pu + 1)) {
                pg8::Gemm gt{(const pg8::bf16_t*)(ws + WS_UM), (const pg8::bf16_t*)(ws + WS_WMDN), MOE_CH * 256, NEXP * DM, FFE / 2, FFE / 2 / MOE_TAILK};
                MoeTailSched S{tile_e, MOE_CH * ch, ntc, C.G, C.wg};
                EpiStoreBf16K E{(pg8::bf16_t*)(ws + WS_YT), DM, 1.0f / (F8_SU * F8_SW)};
                pg8::gemm_phase<EpiStoreBf16K, MoeTailSched, GP_ALIGN, GP_SP2, true, true>(C.lds, gt, S, E);
                final_steal(Cr);
                SEAM(pu + 1);
            }
        }
    }
    if (IN(30)) { phase_final(Cr); }
#undef IN
#undef SEAM
}

extern "C" void kernel_launch(void* const* d_in, const int* in_sizes, int n_in, void* d_out, int out_size, void* d_ws, size_t ws_size, hipStream_t stream) {
    static int grid = 0;
    if (grid == 0) {
        if (n_in != 25 || in_sizes[0] != NLAT * DM || out_size != NLAT * DM || ws_size < WS_END) { fprintf(stderr, "kernel_launch: unexpected shapes (n_in %d, in0 %d, out %d, ws %zu < %zu)\n", n_in, n_in > 0 ? in_sizes[0] : -1, out_size, ws_size, (size_t)WS_END); grid = -1; return; }
        int dev = 0, cus = 0, per_cu = 0;
        if (hipGetDevice(&dev) != hipSuccess || hipDeviceGetAttribute(&cus, hipDeviceAttributeMultiprocessorCount, dev) != hipSuccess) { grid = -1; return; }
        if (hipFuncSetAttribute((const void*)mk_fwd, hipFuncAttributeMaxDynamicSharedMemorySize, LDS_BYTES) != hipSuccess) { fprintf(stderr, "kernel_launch: hipFuncSetAttribute failed\n"); grid = -1; return; }
        if (hipOccupancyMaxActiveBlocksPerMultiprocessor(&per_cu, (const void*)mk_fwd, NWAVES * 64, LDS_BYTES) != hipSuccess || per_cu < 1) fprintf(stderr, "kernel_launch: occupancy query reports %d\n", per_cu);
        (void)hipGetLastError();
        grid = 256;
        if (cus < 256) { fprintf(stderr, "kernel_launch: %d CUs < 256\n", cus); grid = -1; return; }
    }
    if (grid < 0) return;
    if (hipMemsetAsync((char*)d_ws, 0, ZERO_BYTES, stream) != hipSuccess) return;
    Args a{};
    for (int i = 0; i < 25; ++i) a.in[i] = (const float*)d_in[i];
    a.out = (float*)d_out; a.ws = (unsigned char*)d_ws;
#if MK_SPLIT
    for (int p = 0; p < N_PHASES; ++p) { a.ph_lo = p; a.ph_hi = p + 1; hipLaunchKernelGGL(mk_fwd, dim3(grid), dim3(NWAVES * 64), LDS_BYTES, stream, a); }
#else
    a.ph_lo = 0; a.ph_hi = N_PHASES;
    hipLaunchKernelGGL(mk_fwd, dim3(grid), dim3(NWAVES * 64), LDS_BYTES, stream, a);
#endif
}
```

```cpp
#include <hip/hip_runtime.h>
#include <cstdio>
#include <cstdint>
namespace pg8 {
#define PG8_LAS __attribute__((address_space(3)))
typedef unsigned short bf16_t;
typedef short bf16x8 __attribute__((ext_vector_type(8)));
typedef float f32x4 __attribute__((ext_vector_type(4)));
typedef unsigned u32x4 __attribute__((ext_vector_type(4)));
constexpr int BM = 256, BK = 64, HALF = 128, HTB = HALF * BK * 2  , STAGE_BYTES = 8 * HTB, NXCD = 8, WGM = 8;

__host__ __device__ __forceinline__ int lds_byte(int r, int c) { const int st = (r >> 4) * 2 + (c >> 5), rr = r & 15, cc = c & 31, ob = rr * 64 + cc * 2; return st * 1024 + (ob ^ (((ob >> 9) & 1) << 5)); }
__host__ __device__ __forceinline__ void stage_rc(int b, int& R, int& C) { const int st = b / 1024, sb = b % 1024, swz = sb ^ (((sb >> 9) & 1) << 5); R = (st >> 1) * 16 + swz / 64; C = (st & 1) * 32 + (swz % 64) / 2; }
__host__ __device__ __forceinline__ int perm32(int rho) { const int n = rho >> 4, i = rho & 15; return 8 * (i >> 2) + 4 * n + (i & 3); }

struct Unit { int pm, pn, ks; };
struct Gemm { const bf16_t* A; const bf16_t* Bt; int M, N, K; int KL = 0, KLL = 0, NKS = 0, KO1 = -1; };

struct StaticOrder {
    int nM, nN, nwg, G, c;
    __host__ __device__ void init(int M, int N, int G_, int c_) { nM = M / BM; nN = N / BM; nwg = nM * nN; G = G_; c = c_; }
    __host__ __device__ bool next(int i, Unit& u) const {
        const long L = (long)i * G + c; if (L >= nwg) return false;
        int wgid = (int)L; { const int q = nwg / NXCD, r = nwg % NXCD, xcd = wgid % NXCD, off = wgid / NXCD; wgid = (xcd < r ? xcd * (q + 1) : r * (q + 1) + (xcd - r) * q) + off; }
        const int nig = WGM * nN, gid = wgid / nig, fm = gid * WGM, gsz = (nM - fm) < WGM ? (nM - fm) : WGM;
        u.pm = fm + ((wgid % nig) % gsz); u.pn = (wgid % nig) / gsz; return true;
    }
    __device__ __forceinline__ void a_ready(const Unit&) const {}
    __device__ __forceinline__ void done(const Unit&) const {}
};

__device__ __forceinline__ unsigned cvt_pk_bf16(float lo, float hi) { unsigned r; asm volatile("v_cvt_pk_bf16_f32 %0, %1, %2" : "=v"(r) : "v"(lo), "v"(hi)); return r; }
typedef float f32x2 __attribute__((ext_vector_type(2)));
typedef int i32x4_t __attribute__((ext_vector_type(4))); typedef int i32x8_t __attribute__((ext_vector_type(8)));
__device__ __forceinline__ i32x8_t cat8(bf16x8 a, bf16x8 b) { return __builtin_shufflevector(__builtin_bit_cast(i32x4_t, a), __builtin_bit_cast(i32x4_t, b), 0, 1, 2, 3, 4, 5, 6, 7); }
template <class Epi, class Sched, bool ALIGN_EPI = false, bool SP2 = false, bool F8 = false, bool KSPLIT = false>
__device__ __forceinline__ void gemm_phase(PG8_LAS unsigned char* lds, const Gemm g, const Sched& S, const Epi& E) {
    const int tid = threadIdx.x, wid = __builtin_amdgcn_readfirstlane(tid >> 6), lane = tid & 63, wr = wid >> 2, wc = wid & 3, fr = lane & 15, fq = lane >> 4;
    const int K = g.K; int nt = (KSPLIT ? g.KL : K) / BK;
    const size_t ksb = KSPLIT ? (size_t)g.KL * 2 : 0;
    unsigned voffA[2], voffB[2];
#pragma unroll
    for (int i = 0; i < 2; ++i) { int R, C; stage_rc(tid * 16 + i * 8192, R, C); const int Rb = Epi::PERM ? ((R & ~31) + perm32(R & 31)) : R;
        voffA[i] = (unsigned)(R * K + C) * 2u; voffB[i] = (unsigned)(Rb * K + C) * 2u; }
    const size_t kstep = (size_t)(BK * 2);
    const size_t hstep = (size_t)HALF * K * 2;
    const size_t tstep = 2 * hstep;
    const unsigned ldsw = (unsigned)wid * 1024u;
    const int aoff = lds_byte(wr * 64 + fr, fq * 8), boff = lds_byte(wc * 32 + fr, fq * 8);
#define PG8_SA(b, h) (((b) * 2 + (h)) * HTB)
#define PG8_SB(b, h) ((4 + (b) * 2 + (h)) * HTB)
#define PG8_STAGE(bufoff, gbase, voff) do { _Pragma("unroll") for (int _i = 0; _i < 2; ++_i) \
        __builtin_amdgcn_global_load_lds((const unsigned*)((const char*)(gbase) + (voff)[_i]), (PG8_LAS unsigned*)(lds + (bufoff) + ldsw + _i * 8192), 16, 0, 0); } while (0)
#define PG8_LDA(dst, b, h) do { if constexpr (F8) { _Pragma("unroll") for (int m = 0; m < 4; ++m) dst##8[m] = cat8(*(const PG8_LAS bf16x8*)(lds + PG8_SA(b, h) + aoff + m * 2048), *(const PG8_LAS bf16x8*)(lds + PG8_SA(b, h) + aoff + m * 2048 + 1024)); } else { \
        _Pragma("unroll") for (int m = 0; m < 4; ++m) _Pragma("unroll") for (int k = 0; k < 2; ++k) dst[m][k] = *(const PG8_LAS bf16x8*)(lds + PG8_SA(b, h) + aoff + m * 2048 + k * 1024); } } while (0)
#define PG8_LDB(dst, b, h) do { if constexpr (F8) { _Pragma("unroll") for (int n = 0; n < 2; ++n) dst##8[n] = cat8(*(const PG8_LAS bf16x8*)(lds + PG8_SB(b, h) + boff + n * 2048), *(const PG8_LAS bf16x8*)(lds + PG8_SB(b, h) + boff + n * 2048 + 1024)); } else { \
        _Pragma("unroll") for (int n = 0; n < 2; ++n) _Pragma("unroll") for (int k = 0; k < 2; ++k) dst[n][k] = *(const PG8_LAS bf16x8*)(lds + PG8_SB(b, h) + boff + n * 2048 + k * 1024); } } while (0)
#define PG8_MMA(ai, bj, At, Bt) do { __builtin_amdgcn_s_setprio(1); if constexpr (F8) { _Pragma("unroll") for (int m = 0; m < 4; ++m) _Pragma("unroll") for (int n = 0; n < 2; ++n) \
        asm volatile("v_mfma_f32_16x16x128_f8f6f4 %0, %1, %2, %0" : "+v"(acc[ai][bj][m][n]) : "v"(Bt##8[n]), "v"(At##8[m])); } else { \
        _Pragma("unroll") for (int m = 0; m < 4; ++m) _Pragma("unroll") for (int n = 0; n < 2; ++n) _Pragma("unroll") for (int k = 0; k < 2; ++k) \
        acc[ai][bj][m][n] = __builtin_amdgcn_mfma_f32_16x16x32_bf16(Bt[n][k], At[m][k], acc[ai][bj][m][n], 0, 0, 0); } __builtin_amdgcn_s_setprio(0); } while (0)
#define PG8_WAIT_V(n) asm volatile("s_waitcnt vmcnt(" #n ")" ::: "memory")
#define PG8_WAIT_L(n) asm volatile("s_waitcnt lgkmcnt(" #n ")" ::: "memory")
#define PG8_BAR __builtin_amdgcn_s_barrier()
#define PG8_SCHED __builtin_amdgcn_sched_barrier(0)
    Unit cur, nxt; int ui = 0;
    if (!S.next(0, cur)) return;
    f32x4 acc[2][2][4][2];
#pragma unroll
    for (int a = 0; a < 2; ++a)
#pragma unroll
        for (int b = 0; b < 2; ++b)
#pragma unroll
            for (int m = 0; m < 4; ++m)
#pragma unroll
                for (int n = 0; n < 2; ++n) acc[a][b][m][n] = (f32x4){0.f, 0.f, 0.f, 0.f};
    bf16x8 At[4][2], B0[2][2], B1[2][2]; i32x8_t At8[4], B08[2], B18[2];
    const char* cA = (const char*)g.A + (size_t)cur.pm * tstep; const char* cB = (const char*)g.Bt + (size_t)cur.pn * tstep;
    if constexpr (KSPLIT) { const size_t ko = (g.KO1 >= 0) ? (cur.ks ? (size_t)g.KO1 : 0) : (size_t)cur.ks * ksb; cA += ko; cB += ko; if (g.KLL && cur.ks == g.NKS - 1) nt = g.KLL / BK; }
    S.a_ready(cur);
    if constexpr (SP2) {
        PG8_STAGE(PG8_SB(0, 0), cB, voffB); PG8_STAGE(PG8_SB(0, 1), cB + hstep, voffB); PG8_STAGE(PG8_SA(0, 0), cA, voffA); PG8_STAGE(PG8_SA(0, 1), cA + hstep, voffA);
        if (wr == 1) PG8_BAR;
        PG8_WAIT_V(2); PG8_BAR;
        PG8_STAGE(PG8_SB(1, 0), cB + kstep, voffB); PG8_STAGE(PG8_SA(1, 0), cA + kstep, voffA); PG8_STAGE(PG8_SB(1, 1), cB + hstep + kstep, voffB);
        PG8_WAIT_V(6); PG8_BAR;
    } else {
        PG8_STAGE(PG8_SB(0, 0), cB, voffB); PG8_STAGE(PG8_SA(0, 0), cA, voffA); PG8_STAGE(PG8_SB(0, 1), cB + hstep, voffB); PG8_STAGE(PG8_SA(0, 1), cA + hstep, voffA);
        if (wr == 1) PG8_BAR;
        PG8_WAIT_V(4); PG8_BAR;
        PG8_STAGE(PG8_SB(1, 0), cB + kstep, voffB); PG8_STAGE(PG8_SA(1, 0), cA + kstep, voffA); PG8_STAGE(PG8_SB(1, 1), cB + hstep + kstep, voffB);
        PG8_WAIT_V(6); PG8_BAR;
    }
    for (;;) {
        const bool has_next = S.next(ui + 1, nxt);
        const size_t nko = KSPLIT ? ((g.KO1 >= 0) ? (nxt.ks ? (size_t)g.KO1 : 0) : (size_t)nxt.ks * ksb) : 0;
        const char* nA = has_next ? (const char*)g.A + (size_t)nxt.pm * tstep + nko : cA; const char* nB = has_next ? (const char*)g.Bt + (size_t)nxt.pn * tstep + nko : cB;
        for (int t = 0; t < nt; t += 2) {
            const bool last = (t == nt - 2);
            const char* a1 = cA + (size_t)(t + 1) * kstep;
            const char* a2 = last ? nA : cA + (size_t)(t + 2) * kstep; const char* b2 = last ? nB : cB + (size_t)(t + 2) * kstep;
            const char* a3 = a2 + kstep; const char* b3 = b2 + kstep;
            if (last && has_next) S.a_ready(nxt);
            if constexpr (SP2) {
            PG8_LDB(B0, 0, 0); PG8_LDB(B1, 0, 1); PG8_SCHED; PG8_LDA(At, 0, 0); PG8_STAGE(PG8_SA(1, 1), a1 + hstep, voffA);
            PG8_WAIT_V(8); PG8_WAIT_L(0); PG8_BAR; PG8_MMA(0, 0, At, B0); PG8_MMA(0, 1, At, B1); PG8_BAR; PG8_SCHED;
            PG8_LDA(At, 0, 1); PG8_STAGE(PG8_SB(0, 0), b2, voffB); PG8_STAGE(PG8_SB(0, 1), b2 + hstep, voffB); PG8_STAGE(PG8_SA(0, 0), a2, voffA);
            PG8_WAIT_V(8); PG8_WAIT_L(0); PG8_BAR; PG8_MMA(1, 0, At, B0); PG8_MMA(1, 1, At, B1); PG8_BAR; PG8_SCHED;
            PG8_LDB(B0, 1, 0); PG8_LDB(B1, 1, 1); PG8_SCHED; PG8_LDA(At, 1, 0); PG8_STAGE(PG8_SA(0, 1), a2 + hstep, voffA);
            PG8_WAIT_V(8); PG8_WAIT_L(0); PG8_BAR; PG8_MMA(0, 0, At, B0); PG8_MMA(0, 1, At, B1); PG8_BAR; PG8_SCHED;
            PG8_LDA(At, 1, 1); PG8_STAGE(PG8_SB(1, 0), b3, voffB); PG8_STAGE(PG8_SB(1, 1), b3 + hstep, voffB); PG8_STAGE(PG8_SA(1, 0), a3, voffA);
            PG8_WAIT_V(8); PG8_WAIT_L(0); PG8_BAR; PG8_MMA(1, 0, At, B0); PG8_MMA(1, 1, At, B1); PG8_BAR; PG8_SCHED;
            } else {
            PG8_LDB(B0, 0, 0); PG8_SCHED; PG8_LDA(At, 0, 0); PG8_STAGE(PG8_SA(1, 1), a1 + hstep, voffA);
            PG8_WAIT_L(8); PG8_BAR; PG8_WAIT_L(0); PG8_MMA(0, 0, At, B0); PG8_BAR; PG8_SCHED;
            PG8_LDB(B1, 0, 1); PG8_STAGE(PG8_SB(0, 0), b2, voffB);
            PG8_BAR; PG8_WAIT_L(0); PG8_MMA(0, 1, At, B1); PG8_BAR;
            PG8_LDA(At, 0, 1); PG8_STAGE(PG8_SA(0, 0), a2, voffA);
            PG8_BAR; PG8_WAIT_L(0); PG8_MMA(1, 0, At, B0); PG8_BAR; PG8_SCHED;
            PG8_STAGE(PG8_SB(0, 1), b2 + hstep, voffB);
            PG8_WAIT_V(6); PG8_BAR; PG8_MMA(1, 1, At, B1); PG8_BAR;
            PG8_LDB(B0, 1, 0); PG8_SCHED; PG8_LDA(At, 1, 0); PG8_STAGE(PG8_SA(0, 1), a2 + hstep, voffA);
            PG8_WAIT_L(8); PG8_BAR; PG8_WAIT_L(0); PG8_MMA(0, 0, At, B0); PG8_BAR; PG8_SCHED;
            PG8_LDB(B1, 1, 1); PG8_STAGE(PG8_SB(1, 0), b3, voffB);
            PG8_BAR; PG8_WAIT_L(0); PG8_MMA(0, 1, At, B1); PG8_BAR;
            PG8_LDA(At, 1, 1); PG8_STAGE(PG8_SA(1, 0), a3, voffA);
            PG8_BAR; PG8_WAIT_L(0); PG8_MMA(1, 0, At, B0); PG8_BAR; PG8_SCHED;
            PG8_STAGE(PG8_SB(1, 1), b3 + hstep, voffB);
            PG8_WAIT_V(6); PG8_BAR; PG8_MMA(1, 1, At, B1); PG8_BAR;
            }
        }
        if constexpr (F8) { asm volatile("s_nop 15\n\ts_nop 15" ::: "memory"); __builtin_amdgcn_sched_barrier(0); }
        if constexpr (ALIGN_EPI) { if (wr == 0) PG8_BAR; }
        if constexpr (!Epi::AFTER_DRAIN) { E(acc, cur, wr, wc, fr, fq); S.done(cur); }
        if (!has_next) break;
#pragma unroll
        for (int a = 0; a < 2; ++a)
#pragma unroll
            for (int b = 0; b < 2; ++b)
#pragma unroll
                for (int m = 0; m < 4; ++m)
#pragma unroll
                    for (int n = 0; n < 2; ++n) acc[a][b][m][n] = (f32x4){0.f, 0.f, 0.f, 0.f};
        cur = nxt; cA = nA; cB = nB; ++ui;
        if constexpr (KSPLIT) nt = ((g.KLL && cur.ks == g.NKS - 1) ? g.KLL : g.KL) / BK;
        if constexpr (ALIGN_EPI) { if (wr == 1) PG8_BAR; }
    }
    PG8_WAIT_V(0);
    if constexpr (!ALIGN_EPI) { if (wr == 0) PG8_BAR; }
    PG8_BAR;
    if constexpr (Epi::AFTER_DRAIN) { E.fused(acc, cur, wr, wc, fr, fq, lds, wid, lane); S.done(cur); }
#undef PG8_SA
#undef PG8_SB
#undef PG8_STAGE
#undef PG8_LDA
#undef PG8_LDB
#undef PG8_MMA
#undef PG8_WAIT_V
#undef PG8_WAIT_L
#undef PG8_BAR
#undef PG8_SCHED
}
}
#define GAS __attribute__((address_space(1)))
#define LAS __attribute__((address_space(3)))
typedef unsigned short bf16;
typedef unsigned v4u __attribute__((ext_vector_type(4)));
typedef float f32x4 __attribute__((ext_vector_type(4)));
typedef short bf16x8 __attribute__((ext_vector_type(8)));
typedef GAS unsigned gu32;
typedef GAS unsigned long long gu64;
#define RLX_AGENT __ATOMIC_RELAXED, __HIP_MEMORY_SCOPE_AGENT
#define LDS_WAIT() asm volatile("s_waitcnt lgkmcnt(0)" ::: "memory")
#define VM_WAIT() asm volatile("s_waitcnt vmcnt(0)" ::: "memory")
__device__ __forceinline__ unsigned long long rt() { return __builtin_amdgcn_s_memrealtime(); }
__device__ __forceinline__ unsigned f2bf(float f) { unsigned u = __builtin_bit_cast(unsigned, f); return (u + 0x7fffu + ((u >> 16) & 1u)) >> 16; }
typedef float pk_f32x2 __attribute__((ext_vector_type(2))); typedef __bf16 pk_bf16x2 __attribute__((ext_vector_type(2)));
__device__ __forceinline__ unsigned pk2(float lo, float hi) { pk_f32x2 v = {lo, hi}; pk_bf16x2 b = __builtin_convertvector(v, pk_bf16x2); return __builtin_bit_cast(unsigned, b); }

#define XB_TMO      128
#define XB_XCNT(j)  (256  + 64 * (j))
#define XB_XSUB(j)  (1280 + 64 * (j))
#define XB_XGEN(j)  (2304 + 64 * (j))
#define XB_TOP      3328
#define XB_TOPGEN   3392
#define XCD_BAR_WORDS 3456
#define XB_SPIN_CAP (1u << 18)

__device__ __forceinline__ unsigned xb_ld(unsigned* p)              { return __hip_atomic_load(p, __ATOMIC_RELAXED, __HIP_MEMORY_SCOPE_AGENT); }
__device__ __forceinline__ unsigned xb_add(unsigned* p, unsigned v) { return __hip_atomic_fetch_add(p, v, __ATOMIC_RELAXED, __HIP_MEMORY_SCOPE_AGENT); }
__device__ __forceinline__ unsigned xb_xcc_id() { return (unsigned)__builtin_amdgcn_s_getreg((3 << 11) | 20) & 0xFu; }
#define XB_SPIN(cond, bar) do { unsigned _sp = 0; while (cond) { __builtin_amdgcn_s_sleep(1); \
    if ((++_sp & 255u) == 0u) { if (xb_ld(&(bar)[XB_TMO])) break; if (_sp > XB_SPIN_CAP) { atomicAdd(&(bar)[XB_TMO], 1u); break; } } } } while (0)

struct XcdBarrier {
    unsigned* bar; unsigned x;
    volatile LAS unsigned* st;
};

__device__ __forceinline__ XcdBarrier xcd_barrier_post(unsigned* bar, volatile LAS unsigned* st) {
    XcdBarrier b; b.bar = bar; b.x = xb_xcc_id(); b.st = st;
    if (threadIdx.x == 0) (void)xb_add(&bar[XB_XCNT(b.x)], 1u);
    return b;
}
__device__ __forceinline__ void xcd_barrier_complete(unsigned* bar, unsigned x, unsigned& nloc, unsigned& nx) {
    const unsigned G = gridDim.x * gridDim.y * gridDim.z;
    unsigned sum, cnt, mine, sp = 0u;
    for (;;) {
        sum = 0u; cnt = 0u; mine = 0u;
#pragma unroll
        for (unsigned j = 0; j < 16; ++j) { const unsigned c = xb_ld(&bar[XB_XCNT(j)]); sum += c; cnt += (c > 0u) ? 1u : 0u; mine = (j == x) ? c : mine; }
        if (sum == G) break;
        __builtin_amdgcn_s_sleep(1);
        if ((++sp & 255u) == 0u) { if (xb_ld(&bar[XB_TMO])) break; if (sp > XB_SPIN_CAP) { atomicAdd(&bar[XB_TMO], 1u); break; } }
    }
    nloc = mine > 0u ? mine : 1u; nx = cnt > 0u ? cnt : 1u;
}

__device__ __forceinline__ void xcd_barrier(const XcdBarrier& b) {
    asm volatile("s_waitcnt vmcnt(0)" ::: "memory");
    __syncthreads();
    if (threadIdx.x == 0) {
        unsigned* bar = b.bar;
        __builtin_amdgcn_s_waitcnt(0);
        unsigned nloc = b.st[0], nx = b.st[1];
        if (nloc == 0u) { xcd_barrier_complete(bar, b.x, nloc, nx); b.st[0] = nloc; b.st[1] = nx; }
        const unsigned old = xb_add(&bar[XB_XSUB(b.x)], 1u);
        const unsigned gen = old / nloc;
        if (old + 1u == (gen + 1u) * nloc) {
            __builtin_amdgcn_fence(__ATOMIC_RELEASE, "agent");
            asm volatile("s_waitcnt vmcnt(0)" ::: "memory");
            const unsigned og = xb_add(&bar[XB_TOP], 1u);
            const unsigned tg = og / nx;
            if (og + 1u == (tg + 1u) * nx) xb_add(&bar[XB_TOPGEN], 1u);
            else XB_SPIN(xb_ld(&bar[XB_TOPGEN]) == tg, bar);
            __builtin_amdgcn_fence(__ATOMIC_ACQUIRE, "agent");
            xb_add(&bar[XB_XGEN(b.x)], 1u);
            asm volatile("s_waitcnt vmcnt(0)" ::: "memory");
        } else {
            XB_SPIN(xb_ld(&bar[XB_XGEN(b.x)]) == gen, bar);
            __builtin_amdgcn_fence(__ATOMIC_ACQUIRE, "agent");
            asm volatile("s_waitcnt vmcnt(0)" ::: "memory");
        }
    }
    __syncthreads();
}

__device__ __forceinline__ void split_arrive(const XcdBarrier& b, unsigned* w) {
    asm volatile("s_waitcnt vmcnt(0)" ::: "memory");
    __syncthreads();
    if (threadIdx.x == 0) {
        __builtin_amdgcn_s_waitcnt(0);
        unsigned nloc = b.st[0], nx = b.st[1];
        if (nloc == 0u) { xcd_barrier_complete(b.bar, b.x, nloc, nx); b.st[0] = nloc; b.st[1] = nx; }
        const unsigned old = xb_add(&w[64 * b.x], 1u);
        if (old + 1u == nloc) {
            __builtin_amdgcn_fence(__ATOMIC_RELEASE, "agent");
            asm volatile("s_waitcnt vmcnt(0)" ::: "memory");
            const unsigned og = xb_add(&w[64 * 16], 1u);
            if (og + 1u == nx) xb_add(&w[64 * 17], 1u);
        }
    }
}
__device__ __forceinline__ void split_wait(const XcdBarrier& b, unsigned* w) {
    if (threadIdx.x == 0) {
        XB_SPIN(xb_ld(&w[64 * 17]) == 0u, b.bar);
        __builtin_amdgcn_fence(__ATOMIC_ACQUIRE, "agent");
        asm volatile("s_waitcnt vmcnt(0)" ::: "memory");
    }
    __syncthreads();
}

constexpr int NWAVES = 8;
constexpr int NB = 8, SEQ = 4096, CTXL = 256, TT = SEQ + CTXL, DM = 1024, MROWS = NB * TT;
constexpr int NLAT = NB * SEQ;
constexpr int NPROJ = 1792, INCOLS = 1696, FFD = 2816, FFE = 3584, NEXP = 8;
constexpr int KTILES = TT / 64;
constexpr float EPS = 1e-6f, LOG2E = 1.4426950408889634f;
constexpr int MOE_CH = 64, MOE_NCH = 5, MOE_MAXT = 264, MOE_TAILK = 7;

constexpr size_t MiB = 1u << 20;
constexpr size_t WS_CTL = 0, WS_WUB = 1 * MiB, ZERO_BYTES = 3 * MiB;
constexpr size_t WS_MOD = 3 * MiB;
constexpr size_t WS_WIN = 4 * MiB, WS_WOUT = 11 * MiB, WS_WUP = 15 * MiB, WS_WDN = 26 * MiB;
constexpr size_t WS_XC = 32 * MiB;
constexpr size_t WS_RT = 40 * MiB;
constexpr size_t RT_TOPE = 0, RT_GATE = 256 * 1024, RT_POS = 512 * 1024, RT_HIST = 768 * 1024, RT_TILEE = 776 * 1024;
constexpr size_t WS_H = 42 * MiB;
constexpr size_t WS_P = 110 * MiB;
constexpr size_t WS_Q = 229 * MiB;
constexpr size_t SZ_Q64 = (size_t)NB * 6 * TT * 64 * 2, SZ_KV2 = (size_t)NB * 2 * KTILES * 8192;
constexpr size_t WS_QA = WS_Q, WS_KA = WS_QA + SZ_Q64, WS_VA = WS_KA + SZ_KV2, WS_QC = WS_VA + SZ_KV2, WS_KC = WS_QC + SZ_Q64, WS_VC = WS_KC + SZ_KV2;
constexpr size_t WS_CQKV = WS_VC + SZ_KV2;
constexpr size_t WS_KR = WS_CQKV + (size_t)MROWS * 384 * 2;
constexpr size_t WS_SSQ = WS_KR, WS_SSK = WS_KR + (size_t)MROWS * 16;
constexpr size_t WS_QB = WS_KR + (size_t)MROWS * 32 * 2;
constexpr size_t WS_KB = WS_QB + (size_t)NB * 4 * TT * 96 * 2;
constexpr size_t WS_VB = WS_KB + (size_t)NB * 4 * KTILES * 12288;
constexpr size_t WS_QEND = WS_VB + (size_t)NB * 4 * KTILES * 8192;
constexpr size_t WS_PART2 = 392 * MiB;
constexpr size_t WS_UM2 = WS_H;
constexpr size_t WS_PART = 400 * MiB;
constexpr size_t WS_D1 = WS_P;
constexpr size_t WS_D0 = WS_P;
constexpr size_t WS_D2 = 300 * MiB;
constexpr size_t WS_YT = 534 * MiB;
constexpr size_t WS_U = WS_P;
constexpr size_t WS_HFS = 194 * MiB, WS_Y = 260 * MiB, WS_UM = 392 * MiB, WS_WMUP = 450 * MiB, WS_WMDN = 506 * MiB, WS_END = 562 * MiB;
static_assert(WS_QEND <= 411 * MiB && WS_U + (size_t)MROWS * FFD * 2 <= WS_QEND, "ws map");
static_assert(WS_HFS + (size_t)MOE_MAXT * 256 * DM <= WS_Y && WS_Y + (size_t)MOE_MAXT * 256 * DM * 2 <= WS_UM && WS_UM + (size_t)MOE_CH * 256 * FFE <= WS_WMUP && WS_QEND <= WS_WMUP && WS_WMUP + (size_t)NEXP * 2 * FFE * DM <= WS_WMDN && WS_WMDN + (size_t)NEXP * DM * FFE <= WS_END, "moe ws map");
constexpr int CW_BAR = 4096;
constexpr int CW_STEAL = 16384, CW_DONE = 16448, CW_FINAL = 20480, CW_SPLIT = 24576;

constexpr int RING_BYTES = 131072, LDSCTL_OFF = RING_BYTES, MISC_OFF = LDSCTL_OFF + 320, LDS_BYTES = 147456;

__device__ __forceinline__ float bflo(unsigned u) { return __builtin_bit_cast(float, u << 16); }
__device__ __forceinline__ float bfhi(unsigned u) { return __builtin_bit_cast(float, u & 0xffff0000u); }
__device__ __forceinline__ void unpack8(const v4u r, float (&v)[8]) { v[0] = bflo(r.x); v[1] = bfhi(r.x); v[2] = bflo(r.y); v[3] = bfhi(r.y); v[4] = bflo(r.z); v[5] = bfhi(r.z); v[6] = bflo(r.w); v[7] = bfhi(r.w); }
__device__ __forceinline__ v4u pack8(const float (&v)[8]) { v4u o; o.x = pk2(v[0], v[1]); o.y = pk2(v[2], v[3]); o.z = pk2(v[4], v[5]); o.w = pk2(v[6], v[7]); return o; }
__device__ __forceinline__ float wave_sum(float v) {
#define WS_DPP(ctrl_, rmask_) v += __builtin_bit_cast(float, __builtin_amdgcn_update_dpp(0, __builtin_bit_cast(int, v), ctrl_, rmask_, 0xf, false))
    WS_DPP(0xB1, 0xf);
    WS_DPP(0x4E, 0xf);
    WS_DPP(0x141, 0xf);
    WS_DPP(0x140, 0xf);
    WS_DPP(0x142, 0xa);
    WS_DPP(0x143, 0xc);
#undef WS_DPP
    return __builtin_bit_cast(float, __builtin_amdgcn_readlane(__builtin_bit_cast(int, v), 63));
}
__device__ __forceinline__ float fast_rsqrt(float x) { return __builtin_amdgcn_rsqf(x); }
__device__ __forceinline__ float silu_f(float a) { return a * __builtin_amdgcn_rcpf(1.0f + __builtin_amdgcn_exp2f(-a * LOG2E)); }

__device__ __forceinline__ float clamp8(float v) { return __builtin_amdgcn_fmed3f(v, -448.f, 448.f); }
__device__ __forceinline__ unsigned pk4_fp8(float a, float b, float c, float d) { int w = __builtin_amdgcn_cvt_pk_fp8_f32(clamp8(a), clamp8(b), 0, false); w = __builtin_amdgcn_cvt_pk_fp8_f32(clamp8(c), clamp8(d), w, true); return (unsigned)w; }
#ifndef DENSE_F8
#define DENSE_F8 0
#endif
#ifndef DENSE_F8_UP
#define DENSE_F8_UP 0
#endif
#ifndef DENSE_F8_DN
#define DENSE_F8_DN 1
#endif
constexpr float F8_SA = 8.f, F8_SW = 64.f, F8_SU = 2.f;
struct Args { const float* in[25]; float* out; unsigned char* ws; int ph_lo, ph_hi; };
struct Ctx {
    LAS unsigned char* lds; int tid, lane, wave, vcu, G, wg;
    const float* const* in; float* out; unsigned char* ws;
};

struct TileSched {
    int nM, nN, nwg, G, c, skip, reps;
    __device__ __forceinline__ void init(int nM_, int nN_, int G_, int c_, int skip_, int reps_ = 1) { nM = nM_; nN = nN_; nwg = nM * nN; G = G_; c = c_; skip = skip_; reps = reps_; }
    __device__ __forceinline__ bool next(int i, pg8::Unit& u) const {
        const long L = (long)i * G + c; if (L >= (long)nwg * reps) return false;
        int wgid = (int)(L % nwg); { const int q = nwg / pg8::NXCD, r = nwg % pg8::NXCD, xcd = wgid % pg8::NXCD, off = wgid / pg8::NXCD; wgid = (xcd < r ? xcd * (q + 1) : r * (q + 1) + (xcd - r) * q) + off; }
        const int nig = pg8::WGM * nN, gid = wgid / nig, fm = gid * pg8::WGM, gsz = (nM - fm) < pg8::WGM ? (nM - fm) : pg8::WGM;
        int pm = fm + ((wgid % nig) % gsz); u.pn = (wgid % nig) / gsz;
        if (skip) pm = (pm >> 4) * 17 + 1 + (pm & 15);
        u.pm = pm; return true;
    }
    __device__ __forceinline__ void a_ready(const pg8::Unit&) const {}
    __device__ __forceinline__ void done(const pg8::Unit&) const {}
};
struct CtxSched {
    int c;
    __device__ __forceinline__ bool next(int i, pg8::Unit& u) const { if (i > 0 || c >= 32) return false; u.pm = 17 * (c >> 2); u.pn = c & 3; return true; }
    __device__ __forceinline__ void a_ready(const pg8::Unit&) const {}
    __device__ __forceinline__ void done(const pg8::Unit&) const {}
};
struct UpBSched {
    TileSched T;
    __device__ __forceinline__ bool next(int i, pg8::Unit& u) const { if (!T.next(i, u)) return false; u.ks = (u.pn >= 2) ? 1 : 0; return true; }
    __device__ __forceinline__ void a_ready(const pg8::Unit&) const {}
    __device__ __forceinline__ void done(const pg8::Unit&) const {}
};
struct CtxSplitSched {
    int c;
    __device__ __forceinline__ bool next(int i, pg8::Unit& u) const { if (i > 0 || c >= 64) return false; u.pm = 17 * (c >> 3); u.pn = (c >> 1) & 3; u.ks = c & 1; return true; }
    __device__ __forceinline__ void a_ready(const pg8::Unit&) const {}
    __device__ __forceinline__ void done(const pg8::Unit&) const {}
};
struct MoeTailSched {
    const int* tile_e; int tile0, ntc, G, c;
    __device__ __forceinline__ bool next(int i, pg8::Unit& u) const {
        const int L = i * G + c; if (L >= ntc * 4 * MOE_TAILK) return false;
        const int tl = L % ntc, r = L / ntc;
        const int e = __builtin_amdgcn_readfirstlane(__hip_atomic_load(tile_e + tile0 + tl, __ATOMIC_RELAXED, __HIP_MEMORY_SCOPE_AGENT)) & 7;
        u.pm = tl; u.pn = e * 4 + (r & 3); u.ks = r >> 2; return true;
    }
    __device__ __forceinline__ void a_ready(const pg8::Unit&) const {}
    __device__ __forceinline__ void done(const pg8::Unit&) const {}
};
struct MoeSched {
    const int* tile_e; int tile0, ntc, NT, G, c, up;
    __device__ __forceinline__ bool next(int i, pg8::Unit& u) const {
        const int L = i * G + c; if (L >= ntc * NT) return false;
        const int tl = L % ntc, pnl = L / ntc;
        const int e = __builtin_amdgcn_readfirstlane(__hip_atomic_load(tile_e + tile0 + tl, __ATOMIC_RELAXED, __HIP_MEMORY_SCOPE_AGENT)) & 7;
        u.pm = up ? tile0 + tl : tl; u.pn = e * NT + pnl; return true;
    }
    __device__ __forceinline__ void a_ready(const pg8::Unit&) const {}
    __device__ __forceinline__ void done(const pg8::Unit&) const {}
};

struct EpiStoreBf16 {
    static constexpr bool PERM = true, AFTER_DRAIN = false;
    pg8::bf16_t* O; int ldc, pn_mod, pm_off; float scale;
    __device__ __forceinline__ void operator()(const pg8::f32x4 (&acc)[2][2][4][2], const pg8::Unit& u, int wr, int wc, int fr, int fq) const {
        const int row0 = (u.pm + pm_off) * 256 + wr * 64 + fr, col0 = (u.pn % pn_mod) * 256 + wc * 32 + 8 * fq;
#pragma unroll
        for (int ai = 0; ai < 2; ++ai)
#pragma unroll
            for (int m = 0; m < 4; ++m) { pg8::bf16_t* rowp = O + (size_t)(row0 + ai * 128 + m * 16) * ldc + col0;
#pragma unroll
                for (int bj = 0; bj < 2; ++bj) { const pg8::f32x4 v0 = acc[ai][bj][m][0] * scale, v1 = acc[ai][bj][m][1] * scale;
                    pg8::u32x4 w; w.x = pg8::cvt_pk_bf16(v0[0], v0[1]); w.y = pg8::cvt_pk_bf16(v0[2], v0[3]); w.z = pg8::cvt_pk_bf16(v1[0], v1[1]); w.w = pg8::cvt_pk_bf16(v1[2], v1[3]);
                    *(pg8::u32x4*)(rowp + bj * 128) = w; } }
    }
};
struct EpiGateBf16 {
    static constexpr bool PERM = true, AFTER_DRAIN = false;
    pg8::bf16_t* D; const float* gate; float scale;
    __device__ __forceinline__ void operator()(const pg8::f32x4 (&acc)[2][2][4][2], const pg8::Unit& u, int wr, int wc, int fr, int fq) const {
        int upm = u.pm, upn = u.pn; asm volatile("" : "+v"(fr), "+v"(fq), "+s"(upm), "+s"(upn));
        const int b = upm / 17, lt = b * 16 + (upm - 17 * b) - 1;
        const float* g = gate + b * 6144;
        const int row0 = lt * 256 + wr * 64 + fr, col0 = upn * 256 + wc * 32 + 8 * fq;
#pragma unroll
        for (int bj = 0; bj < 2; ++bj) { const pg8::f32x4 g0 = *(const pg8::f32x4*)(g + col0 + bj * 128) * scale, g1 = *(const pg8::f32x4*)(g + col0 + bj * 128 + 4) * scale;
#pragma unroll
            for (int ai = 0; ai < 2; ++ai)
#pragma unroll
                for (int m = 0; m < 4; ++m) { const pg8::f32x4 v0 = acc[ai][bj][m][0] * g0, v1 = acc[ai][bj][m][1] * g1;
                    pg8::u32x4 w; w.x = pg8::cvt_pk_bf16(v0[0], v0[1]); w.y = pg8::cvt_pk_bf16(v0[2], v0[3]); w.z = pg8::cvt_pk_bf16(v1[0], v1[1]); w.w = pg8::cvt_pk_bf16(v1[2], v1[3]);
                    *(pg8::u32x4*)(D + (size_t)(row0 + ai * 128 + m * 16) * DM + col0 + bj * 128) = w; } }
    }
};
struct EpiStoreBf16K {
    static constexpr bool PERM = true, AFTER_DRAIN = false;
    pg8::bf16_t* O; int ldc; float scale;
    __device__ __forceinline__ void operator()(const pg8::f32x4 (&acc)[2][2][4][2], const pg8::Unit& u, int wr, int wc, int fr, int fq) const {
        const int row0 = (u.ks * 8 + u.pm) * 256 + wr * 64 + fr, col0 = (u.pn & 3) * 256 + wc * 32 + 8 * fq;
#pragma unroll
        for (int ai = 0; ai < 2; ++ai)
#pragma unroll
            for (int m = 0; m < 4; ++m) { pg8::bf16_t* rowp = O + (size_t)(row0 + ai * 128 + m * 16) * ldc + col0;
#pragma unroll
                for (int bj = 0; bj < 2; ++bj) { const pg8::f32x4 v0 = acc[ai][bj][m][0] * scale, v1 = acc[ai][bj][m][1] * scale;
                    pg8::u32x4 w; w.x = pg8::cvt_pk_bf16(v0[0], v0[1]); w.y = pg8::cvt_pk_bf16(v0[2], v0[3]); w.z = pg8::cvt_pk_bf16(v1[0], v1[1]); w.w = pg8::cvt_pk_bf16(v1[2], v1[3]);
                    *(pg8::u32x4*)(rowp + bj * 128) = w; } }
    }
};
template <bool OUT8> struct EpiSwiglu {
    static constexpr bool PERM = true, AFTER_DRAIN = false;
    void* O; int ldc, pn_mod, pm_off; float ascale, oscale;
    __device__ __forceinline__ void operator()(const pg8::f32x4 (&acc)[2][2][4][2], const pg8::Unit& u, int wr, int wc, int fr, int fq) const {
        typedef unsigned u32x2v __attribute__((ext_vector_type(2)));
        const int row0 = (u.pm + pm_off) * 256 + wr * 64 + fr, col0 = (u.pn % pn_mod) * 128 + wc * 32 + 8 * fq;
#pragma unroll
        for (int ai = 0; ai < 2; ++ai)
#pragma unroll
            for (int m = 0; m < 4; ++m) { const size_t eo = (size_t)(row0 + ai * 128 + m * 16) * ldc + col0;
                const float c1 = -ascale * LOG2E, c2 = ascale * ascale * (OUT8 ? oscale : 1.0f);
                const pg8::f32x4 a0 = acc[ai][0][m][0], a1 = acc[ai][0][m][1];
                const pg8::f32x4 t0 = a0 * c1, t1 = a1 * c1;
                pg8::f32x4 e0, e1;
#pragma unroll
                for (int i = 0; i < 4; ++i) { e0[i] = __builtin_amdgcn_exp2f(t0[i]); e1[i] = __builtin_amdgcn_exp2f(t1[i]); }
                const pg8::f32x4 d0 = e0 + 1.0f, d1 = e1 + 1.0f;
                pg8::f32x4 r0, r1;
#pragma unroll
                for (int i = 0; i < 4; ++i) { r0[i] = __builtin_amdgcn_rcpf(d0[i]); r1[i] = __builtin_amdgcn_rcpf(d1[i]); }
                const pg8::f32x4 u0 = (a0 * r0) * (acc[ai][1][m][0] * c2), u1 = (a1 * r1) * (acc[ai][1][m][1] * c2);
                const float uu[8] = {u0[0], u0[1], u0[2], u0[3], u1[0], u1[1], u1[2], u1[3]};
                if (OUT8) { u32x2v w; w.x = pk4_fp8(uu[0], uu[1], uu[2], uu[3]); w.y = pk4_fp8(uu[4], uu[5], uu[6], uu[7]);
                    *(u32x2v*)((unsigned char*)O + eo) = w; }
                else { pg8::u32x4 w; w.x = pg8::cvt_pk_bf16(uu[0], uu[1]); w.y = pg8::cvt_pk_bf16(uu[2], uu[3]); w.z = pg8::cvt_pk_bf16(uu[4], uu[5]); w.w = pg8::cvt_pk_bf16(uu[6], uu[7]);
                    *(pg8::u32x4*)((pg8::bf16_t*)O + eo) = w; } }
    }
};
struct EpiProj {
    static constexpr bool PERM = true, AFTER_DRAIN = false;
    pg8::bf16_t* QA; unsigned char* KA; unsigned char* VA; pg8::bf16_t* QC; unsigned char* KC; unsigned char* VC; pg8::bf16_t* CQ; unsigned char* KB; float* SSQ; float* SSK;
    const float* aq; const float* ak; const LAS float* tab64; const LAS float* tab32;
    __device__ __forceinline__ void operator()(const pg8::f32x4 (&acc)[2][2][4][2], const pg8::Unit& u, int wr, int wc, int fr_, int fq_) const {
        int fr = fr_, fq = fq_, upm = u.pm, upn = u.pn; asm volatile("" : "+v"(fr), "+v"(fq), "+s"(upm), "+s"(upn));
        const int b = upm / 17, tj = (upm % 17) * 256; const bool isl = tj != 0;
        const int t0 = tj + wr * 64 + fr;
        const int row0 = upm * 256 + wr * 64 + fr;
        if (upn < 4) {
            const bool isA = upn < 2; const int hq = (upn & 1) * 4 + wc; const bool isq = hq < 6;
            pg8::f32x4 g0[2], g1[2];
            if (isA) { const float* gp = (isq ? aq : ak) + fq * 8; g0[0] = *(const pg8::f32x4*)gp; g0[1] = *(const pg8::f32x4*)(gp + 4); g1[0] = *(const pg8::f32x4*)(gp + 32); g1[1] = *(const pg8::f32x4*)(gp + 36); }
            unsigned char* dp; int astep, mstep, bstep;
            if (isq) { dp = (unsigned char*)(isA ? QA : QC) + (((size_t)(b * 6 + hq) * TT + t0) * 64 + fq * 8) * 2; astep = 128 * 128; mstep = 16 * 128; bstep = 64; }
            else { dp = (isA ? KA : KC) + ((size_t)(b * 2 + hq - 6) * KTILES + (t0 >> 6)) * 8192 + fq * 1024 + fr * 16; astep = 2 * 8192; mstep = 256; bstep = 4096; }
            const float qs = isq ? 0.125f * LOG2E : 1.0f;
#pragma unroll
            for (int ai = 0; ai < 2; ++ai)
#pragma unroll
                for (int m = 0; m < 4; ++m) {
                    float a[8], c[8];
#pragma unroll
                    for (int i = 0; i < 4; ++i) { a[i] = acc[ai][0][m][0][i]; a[4 + i] = acc[ai][0][m][1][i]; c[i] = acc[ai][1][m][0][i]; c[4 + i] = acc[ai][1][m][1][i]; }
                    if (isA) { float ss = 0.f;
#pragma unroll
                        for (int e = 0; e < 8; ++e) ss += a[e] * a[e] + c[e] * c[e];
                        ss += __shfl_xor(ss, 16); ss += __shfl_xor(ss, 32);
                        const float rinv = fast_rsqrt(ss * (1.f / 64.f) + EPS);
#pragma unroll
                        for (int e = 0; e < 8; ++e) { a[e] *= rinv * g0[e >> 2][e & 3]; c[e] *= rinv * g1[e >> 2][e & 3]; } }
                    if (isl) { const int lp = t0 + ai * 128 + m * 16 - CTXL; const LAS float* ta = tab64 + (((lp >> 6) & 63) * 16 + (fq & 1) * 8) * 2; const LAS float* tc = tab64 + ((lp & 63) * 16 + (fq & 1) * 8) * 2;
#pragma unroll
                        for (int e = 0; e < 8; ++e) { const float ya = __shfl_xor(a[e], 32), yc = __shfl_xor(c[e], 32);
                            a[e] = (fq >> 1) ? a[e] * ta[2 * e] + ya * ta[2 * e + 1] : a[e] * ta[2 * e] - ya * ta[2 * e + 1];
                            c[e] = (fq >> 1) ? c[e] * tc[2 * e] + yc * tc[2 * e + 1] : c[e] * tc[2 * e] - yc * tc[2 * e + 1]; } }
                    pg8::u32x4 wa, wc2;
                    wa.x = pk2(a[0] * qs, a[1] * qs); wa.y = pk2(a[2] * qs, a[3] * qs); wa.z = pk2(a[4] * qs, a[5] * qs); wa.w = pk2(a[6] * qs, a[7] * qs);
                    wc2.x = pk2(c[0] * qs, c[1] * qs); wc2.y = pk2(c[2] * qs, c[3] * qs); wc2.z = pk2(c[4] * qs, c[5] * qs); wc2.w = pk2(c[6] * qs, c[7] * qs);
                    unsigned char* d = dp + (size_t)ai * astep + m * mstep;
                    *(pg8::u32x4*)d = wa; *(pg8::u32x4*)(d + bstep) = wc2;
                    asm volatile("" ::: "memory");
                }
        } else if (upn == 4) {
            unsigned char* dp = ((wc < 2) ? VA : VC) + ((size_t)(b * 2 + (wc & 1)) * KTILES + (t0 >> 6)) * 8192 + fr * 64 + fq * 16;
#pragma unroll
            for (int ai = 0; ai < 2; ++ai)
#pragma unroll
                for (int m = 0; m < 4; ++m)
#pragma unroll
                    for (int bj = 0; bj < 2; ++bj) { const pg8::f32x4 v0 = acc[ai][bj][m][0], v1 = acc[ai][bj][m][1];
                        pg8::u32x4 w; w.x = pk2(v0[0], v0[1]); w.y = pk2(v0[2], v0[3]); w.z = pk2(v1[0], v1[1]); w.w = pk2(v1[2], v1[3]);
                        *(pg8::u32x4*)(dp + (size_t)ai * 2 * 8192 + m * 1024 + bj * 4096) = w; asm volatile("" ::: "memory"); }
        } else {
            const bool iscq = upn == 5;
            pg8::bf16_t* cp = CQ + (size_t)row0 * 384 + (iscq ? 0 : 256) + wc * 32 + fq * 8; float* sp = (iscq ? SSQ : SSK) + (size_t)row0 * 4 + wc;
#pragma unroll
            for (int ai = 0; ai < 2; ++ai)
#pragma unroll
                for (int m = 0; m < 4; ++m) { const size_t ro = (size_t)(ai * 128 + m * 16);
                    float ss = 0.f;
#pragma unroll
                    for (int bj = 0; bj < 2; ++bj) { if (bj == 1 && !iscq) continue;
                        const pg8::f32x4 v0 = acc[ai][bj][m][0], v1 = acc[ai][bj][m][1];
                        ss += (v0[0] * v0[0] + v0[1] * v0[1]) + (v0[2] * v0[2] + v0[3] * v0[3]) + (v1[0] * v1[0] + v1[1] * v1[1]) + (v1[2] * v1[2] + v1[3] * v1[3]);
                        pg8::u32x4 w; w.x = pk2(v0[0], v0[1]); w.y = pk2(v0[2], v0[3]); w.z = pk2(v1[0], v1[1]); w.w = pk2(v1[2], v1[3]);
                        *(pg8::u32x4*)(cp + ro * 384 + bj * 128) = w; }
                    ss += __shfl_xor(ss, 16); ss += __shfl_xor(ss, 32);
                    if (fq == 0) sp[ro * 4] = ss;
                    asm volatile("" ::: "memory");
                }
            if (!iscq && wc == 0) {
                unsigned char* kp = KB + ((size_t)(b * 4) * KTILES + (t0 >> 6)) * 12288 + (8 + fq) * 1024 + fr * 16;
#pragma unroll
                for (int ai = 0; ai < 2; ++ai)
#pragma unroll
                    for (int m = 0; m < 4; ++m) { float v[8];
#pragma unroll
                        for (int i = 0; i < 4; ++i) { v[i] = acc[ai][1][m][0][i]; v[4 + i] = acc[ai][1][m][1][i]; }
                        if (isl) { const int lp = t0 + ai * 128 + m * 16 - CTXL; const LAS float* t4 = tab32 + (((fq >> 1) ? (lp & 63) : ((lp >> 6) & 63)) * 8) * 2;
#pragma unroll
                            for (int e = 0; e < 8; ++e) { const float yp = __shfl_xor(v[e], 16); v[e] = (fq & 1) ? v[e] * t4[2 * e] + yp * t4[2 * e + 1] : v[e] * t4[2 * e] - yp * t4[2 * e + 1]; } }
                        pg8::u32x4 w; w.x = pk2(v[0], v[1]); w.y = pk2(v[2], v[3]); w.z = pk2(v[4], v[5]); w.w = pk2(v[6], v[7]);
#pragma unroll
                        for (int h = 0; h < 4; ++h) *(pg8::u32x4*)(kp + (size_t)h * KTILES * 12288 + (size_t)ai * 2 * 12288 + m * 256) = w;
                        asm volatile("" ::: "memory"); }
            }
        }
        asm volatile("s_waitcnt vmcnt(0)" ::: "memory");
    }
};
struct EpiUpB {
    static constexpr bool PERM = true, AFTER_DRAIN = false;
    pg8::bf16_t* QB; unsigned char* KB; unsigned char* VB; const float* SSQ; const float* SSK;
    __device__ __forceinline__ void operator()(const pg8::f32x4 (&acc)[2][2][4][2], const pg8::Unit& u, int wr, int wc, int fr_, int fq_) const {
        int fr = fr_, fq = fq_, upm = u.pm, upn = u.pn; asm volatile("" : "+v"(fr), "+v"(fq), "+s"(upm), "+s"(upn));
        const int b = upm / 17, t0 = (upm % 17) * 256 + wr * 64 + fr;
        const float* ssp = ((upn < 2) ? SSQ : SSK) + (size_t)(upm * 256 + wr * 64 + fr) * 4; const float sdiv = (upn < 2) ? (1.f / 256.f) : (1.f / 128.f);
        float rinv[2][4];
#pragma unroll
        for (int ai = 0; ai < 2; ++ai)
#pragma unroll
            for (int m = 0; m < 4; ++m) { const pg8::f32x4 s4 = *(const pg8::f32x4*)(ssp + (size_t)(ai * 128 + m * 16) * 4); rinv[ai][m] = fast_rsqrt(((s4[0] + s4[1]) + (s4[2] + s4[3])) * sdiv + EPS); }
#pragma unroll
        for (int bj = 0; bj < 2; ++bj) {
            unsigned char* p; int astep, mstep; float sc = 1.0f;
            if (upn < 2) { const int cbase = upn * 256 + bj * 128 + wc * 32; if (cbase >= 384) continue; const int h = cbase / 96;
                p = (unsigned char*)QB + (((size_t)(b * 4 + h) * TT + t0) * 96 + (cbase + 8 * fq - h * 96)) * 2; astep = 128 * 192; mstep = 16 * 192; sc = 0.10206207261596575f * LOG2E; }
            else { const int h = bj * 2 + (wc >> 1), c = (wc & 1) * 4 + fq;
                if (upn == 2) { p = KB + ((size_t)(b * 4 + h) * KTILES + (t0 >> 6)) * 12288 + c * 1024 + fr * 16; astep = 2 * 12288; mstep = 256; }
                else { p = VB + ((size_t)(b * 4 + h) * KTILES + (t0 >> 6)) * 8192 + (c >> 2) * 4096 + fr * 64 + (c & 3) * 16; astep = 2 * 8192; mstep = 1024; } }
#pragma unroll
            for (int ai = 0; ai < 2; ++ai)
#pragma unroll
                for (int m = 0; m < 4; ++m) { const float rs = rinv[ai][m] * sc;
                    const pg8::f32x4 v0 = acc[ai][bj][m][0] * rs, v1 = acc[ai][bj][m][1] * rs;
                    pg8::u32x4 w; w.x = pk2(v0[0], v0[1]); w.y = pk2(v0[2], v0[3]); w.z = pk2(v1[0], v1[1]); w.w = pk2(v1[2], v1[3]);
                    *(pg8::u32x4*)(p + (size_t)ai * astep + m * mstep) = w;
                }
        }
        asm volatile("s_waitcnt vmcnt(0)" ::: "memory");
    }
};
struct EpiResid {
    static constexpr bool PERM = false, AFTER_DRAIN = false;
    const float* base_lat; const float* base_ctx; float* out_lat; float* out_ctx; const float* gate; float scale;
    __device__ __forceinline__ void operator()(const pg8::f32x4 (&acc)[2][2][4][2], const pg8::Unit& u, int wr, int wc, int fr, int fq) const {
        const int b = u.pm / 17, j = u.pm % 17;
        const float* bs; float* os; const float* g;
        if (j == 0) { bs = base_ctx + (size_t)b * CTXL * DM; os = out_ctx + (size_t)b * CTXL * DM; g = gate + 8 * 6144; }
        else { const size_t ro = ((size_t)b * SEQ + (size_t)(j - 1) * 256) * DM; bs = base_lat + ro; os = out_lat + ro; g = gate + b * 6144; }
        const int col0 = u.pn * 256 + wc * 32 + 4 * fq;
#pragma unroll
        for (int bj = 0; bj < 2; ++bj)
#pragma unroll
            for (int n = 0; n < 2; ++n) { const pg8::f32x4 gv = *(const pg8::f32x4*)(g + col0 + bj * 128 + n * 16) * scale;
                pg8::f32x4 xb[2][4];
#pragma unroll
                for (int ai = 0; ai < 2; ++ai)
#pragma unroll
                    for (int m = 0; m < 4; ++m) xb[ai][m] = *(const pg8::f32x4*)(bs + (size_t)(ai * 128 + wr * 64 + m * 16 + fr) * DM + col0 + bj * 128 + n * 16);
#pragma unroll
                for (int ai = 0; ai < 2; ++ai)
#pragma unroll
                    for (int m = 0; m < 4; ++m) *(pg8::f32x4*)(os + (size_t)(ai * 128 + wr * 64 + m * 16 + fr) * DM + col0 + bj * 128 + n * 16) = xb[ai][m] + gv * acc[ai][bj][m][n];
                asm volatile("" ::: "memory"); }
    }
};
struct EpiResidPart {
    static constexpr bool PERM = false, AFTER_DRAIN = false;
    const float* base_lo; const float* base_hi; float* out_lo; float* out_hi; const float* gate; float scale;
    __device__ __forceinline__ void operator()(const pg8::f32x4 (&acc)[2][2][4][2], const pg8::Unit& u, int wr, int wc, int fr, int fq) const {
        int upm = u.pm, upn = u.pn; asm volatile("" : "+v"(fr), "+v"(fq), "+s"(upm), "+s"(upn));
        const int b = upm / 17; const bool hi = u.ks != 0;
        const float* bs = ((hi && base_hi) ? base_hi : base_lo) + (size_t)b * CTXL * DM; float* os = (hi ? out_hi : out_lo) + (size_t)b * CTXL * DM; const float* g = gate + 8 * 6144;
        const float keep = (hi && !base_hi) ? 0.f : 1.f;
        const int col0 = upn * 256 + wc * 32 + 4 * fq;
#pragma unroll
        for (int bj = 0; bj < 2; ++bj)
#pragma unroll
            for (int n = 0; n < 2; ++n) { const pg8::f32x4 gv = *(const pg8::f32x4*)(g + col0 + bj * 128 + n * 16) * scale;
                pg8::f32x4 xb[2][4];
#pragma unroll
                for (int ai = 0; ai < 2; ++ai)
#pragma unroll
                    for (int m = 0; m < 4; ++m) xb[ai][m] = *(const pg8::f32x4*)(bs + (size_t)(ai * 128 + wr * 64 + m * 16 + fr) * DM + col0 + bj * 128 + n * 16);
#pragma unroll
                for (int ai = 0; ai < 2; ++ai)
#pragma unroll
                    for (int m = 0; m < 4; ++m) *(pg8::f32x4*)(os + (size_t)(ai * 128 + wr * 64 + m * 16 + fr) * DM + col0 + bj * 128 + n * 16) = xb[ai][m] * keep + gv * acc[ai][bj][m][n];
                asm volatile("" ::: "memory"); }
    }
};

namespace att {
using f32x16 = __attribute__((ext_vector_type(16))) float;
using s16x4 = __attribute__((ext_vector_type(4))) short;
typedef short v4i16_t __attribute__((ext_vector_type(4)));
constexpr int KSLOT = 12288, VSLOT = 8192;
constexpr int L_K = 0, L_V = 2 * KSLOT, L_O = L_V + 2 * VSLOT, OSTR = 144, L_END = L_O + NWAVES * 32 * OSTR;
static_assert(L_END <= RING_BYTES, "attention LDS");
constexpr float THR = 8.0f, NEGBIG = -1e30f;
__device__ __forceinline__ int crow(int r, int hi) { return (r & 3) + 8 * (r >> 2) + 4 * hi; }
__device__ __forceinline__ float swapmax(float m) { auto rr = __builtin_amdgcn_permlane32_swap(__float_as_uint(m), __float_as_uint(m), false, false); float r; asm("v_max_f32_e32 %0, %1, %2" : "=v"(r) : "v"(__uint_as_float(rr[0])), "v"(__uint_as_float(rr[1]))); return r; }
__device__ __forceinline__ float swapsum(float m) { auto rr = __builtin_amdgcn_permlane32_swap(__float_as_uint(m), __float_as_uint(m), false, false); return __uint_as_float(rr[0]) + __uint_as_float(rr[1]); }
__device__ __forceinline__ s16x4 vtr(const LAS unsigned char* p) { return __builtin_bit_cast(s16x4, __builtin_amdgcn_ds_read_tr16_b64_v4i16((LAS v4i16_t*)p)); }
typedef float f32x2_t __attribute__((ext_vector_type(2))); typedef __bf16 bf16x2_t __attribute__((ext_vector_type(2)));
__device__ __forceinline__ unsigned cvtpk(float lo, float hi) { f32x2_t v = {lo, hi}; bf16x2_t b = __builtin_convertvector(v, bf16x2_t); return __builtin_bit_cast(unsigned, b); }
__device__ __forceinline__ float max3f(float a, float b, float c) { float r; asm("v_max3_f32 %0, %1, %2, %3" : "=v"(r) : "v"(a), "v"(b), "v"(c)); return r; }
__device__ __forceinline__ float max2f(float a, float b) { float r; asm("v_max_f32_e32 %0, %1, %2" : "=v"(r) : "v"(a), "v"(b)); return r; }
__device__ __forceinline__ float fadd_s(float a, float b) { float r; asm("v_add_f32_e32 %0, %1, %2" : "=v"(r) : "v"(a), "v"(b)); return r; }
__device__ __forceinline__ void glds16(const void* gsrc, unsigned lds_dst) { unsigned keep;
    asm volatile("s_mov_b32 %0, m0\n\ts_mov_b32 m0, %2\n\ts_nop 0\n\tglobal_load_lds_dwordx4 %1, off\n\ts_mov_b32 m0, %0" : "=&s"(keep) : "v"(gsrc), "s"(lds_dst) : "memory"); }

struct UnitDesc {
    const bf16* Q;
    const unsigned char* Kimg; const unsigned char* Vimg;
    bf16* O;
    int n0, s1t0, n1;
    int qpos0;
    float minit, linit;
};

__device__ __forceinline__ void rope_q96(bf16* Q, int qpos0) {
    const int tid = threadIdx.x, lane = tid & 63, r32 = lane & 31, hi = lane >> 5, wid = tid >> 6;
    const int lp = qpos0 + wid * 32 + r32;
#pragma unroll
    for (int ds = 4; ds < 6; ++ds) { const int pos = (ds == 4) ? ((lp >> 6) & 63) : (lp & 63);
        v4u* qp = (v4u*)(Q + (size_t)(wid * 32 + r32) * 96 + ds * 16 + hi * 8);
        float v[8]; unpack8(*qp, v); float o[8];
#pragma unroll
        for (int e = 0; e < 8; ++e) { constexpr float invf[8] = {1.0f, 0.31622776601683794f, 0.1f, 0.031622776601683794f, 0.01f, 0.0031622776601683794f, 0.001f, 0.00031622776601683794f};
            const float rev = ((float)pos * invf[e]) * 0.15915494309189535f; const float cs = __builtin_amdgcn_cosf(rev), sn = __builtin_amdgcn_sinf(rev);
            const float yp = __shfl_xor(v[e], 32); o[e] = hi ? v[e] * cs + yp * sn : v[e] * cs - yp * sn; }
        *qp = pack8(o); }
    asm volatile("s_waitcnt vmcnt(0)" ::: "memory");
}

template <int DK, bool WIN>
__device__ __forceinline__ void unit(LAS unsigned char* lds, const UnitDesc& u) {
    int tid = threadIdx.x; asm volatile("" : "+v"(tid));
    const int lane = tid & 63, r32 = lane & 31, hi = lane >> 5; const int wid = __builtin_amdgcn_readfirstlane(tid >> 6);
    constexpr int KT_BYTES = DK * 128, NDS = DK / 16;
    const int NT = u.n0 + u.n1;
    const unsigned lds0 = (unsigned)(uintptr_t)lds;
#define ATT_TILE(i_) (((i_) < u.n0) ? (i_) : u.s1t0 + ((i_) - u.n0))
#define ATT_ISSUE_K(i_, slot_) do { const unsigned char* kg_ = u.Kimg + (size_t)ATT_TILE(i_) * KT_BYTES + wid * 1024 + lane * 16; \
        glds16(kg_, (unsigned)__builtin_amdgcn_readfirstlane(lds0 + L_K + (slot_) * KSLOT + wid * 1024)); \
        if (DK == 96) { if (wid < 4) glds16(kg_ + 8192, (unsigned)__builtin_amdgcn_readfirstlane(lds0 + L_K + (slot_) * KSLOT + 8192 + wid * 1024)); } } while (0)
#define ATT_ISSUE_V(i_, slot_) do { const unsigned char* vg_ = u.Vimg + (size_t)ATT_TILE(i_) * 8192 + wid * 1024 + lane * 16; \
        glds16(vg_, (unsigned)__builtin_amdgcn_readfirstlane(lds0 + L_V + (slot_) * VSLOT + wid * 1024)); } while (0)
#define ATT_QK(P0, P1, slot_) do { const LAS unsigned char* kb_ = lds + L_K + (slot_) * KSLOT + hi * 1024 + r32 * 16; \
        bf16x8 kf_[3][2];          \
        kf_[0][0] = *(const LAS bf16x8*)(kb_); kf_[0][1] = *(const LAS bf16x8*)(kb_ + 512); kf_[1][0] = *(const LAS bf16x8*)(kb_ + 2048); kf_[1][1] = *(const LAS bf16x8*)(kb_ + 2048 + 512); \
        _Pragma("unroll") for (int ds = 0; ds < NDS; ++ds) { \
            if (ds + 2 < NDS) { kf_[(ds + 2) % 3][0] = *(const LAS bf16x8*)(kb_ + (ds + 2) * 2048); kf_[(ds + 2) % 3][1] = *(const LAS bf16x8*)(kb_ + (ds + 2) * 2048 + 512); } \
            if (ds == 0) { P0 = __builtin_amdgcn_mfma_f32_32x32x16_bf16(kf_[0][0], qf[0], negm, 0, 0, 0); P1 = __builtin_amdgcn_mfma_f32_32x32x16_bf16(kf_[0][1], qf[0], negm, 0, 0, 0); } \
            else { P0 = __builtin_amdgcn_mfma_f32_32x32x16_bf16(kf_[ds % 3][0], qf[ds], P0, 0, 0, 0); P1 = __builtin_amdgcn_mfma_f32_32x32x16_bf16(kf_[ds % 3][1], qf[ds], P1, 0, 0, 0); } \
            __builtin_amdgcn_sched_barrier(0x407); } } while (0)
#define ATT_WAITBAR() do { asm volatile("s_waitcnt vmcnt(0) lgkmcnt(0)" ::: "memory"); __builtin_amdgcn_s_barrier(); asm volatile("" ::: "memory"); } while (0)
    ATT_ISSUE_K(0, 0); ATT_ISSUE_V(0, 0); ATT_ISSUE_K(1, 1);
    bf16x8 qf[NDS];
#pragma unroll
    for (int ds = 0; ds < NDS; ++ds) qf[ds] = *(const bf16x8*)(u.Q + (size_t)(wid * 32 + r32) * DK + ds * 16 + hi * 8);
    f32x16 o0 = {}, o1 = {};
    const bool has_sink = u.linit != 0.f;
    float lsum = (hi == 0) ? u.linit : 0.f;
    f32x16 negm;
    { const float m0 = has_sink ? -u.minit : 0.f;
#pragma unroll
      for (int r = 0; r < 16; ++r) negm[r] = m0; }
    asm volatile("" : "+v"(negm));
    const int qlo = u.qpos0 + wid * 32, qp = qlo + r32;
    f32x16 sa0, sa1, sb0, sb1;
    ATT_WAITBAR();
    ATT_QK(sa0, sa1, 0);
    asm volatile("s_nop 15\n\ts_nop 7" : "+v"(sa0), "+v"(sa1));
    bool actc = true; int kposc = 0;
    ATT_WAITBAR();
#define ATT_STEP(i_, C0, C1, N0, N1, QKM_) do {        \
        if ((i_) + 2 < NT) ATT_ISSUE_K((i_) + 2, (i_) & 1); \
        if ((i_) + 1 < NT) ATT_ISSUE_V((i_) + 1, ((i_) + 1) & 1); \
        bool actn = (QKM_ == 2) ? ((i_) + 1 < NT) : (QKM_ == 1); int kposn = 0; \
        if (WIN) { if (actn && (i_) + 1 >= u.n0) { kposn = (u.s1t0 + ((i_) + 1 - u.n0) - 4) * 64; actn = (kposn + 63 >= qlo - 128) && (kposn <= qlo + 31 + 128); } } \
        if (actn) ATT_QK(N0, N1, ((i_) + 1) & 1); \
        if (actc) { \
            if (WIN) { if ((i_) >= u.n0) { \
                _Pragma("unroll") for (int r = 0; r < 16; ++r) { const int dk = kposc + crow(r, hi) - qp; if (dk > 128 || dk < -128) C0[r] = NEGBIG; if (dk + 32 > 128 || dk + 32 < -128) C1[r] = NEGBIG; } } } \
            float rma = max3f(C0[0], C0[1], C1[0]), rmb = max3f(C0[2], C0[3], C1[1]); rma = max3f(rma, C1[2], C1[3]); \
            _Pragma("unroll") for (int r = 4; r < 16; r += 4) { rma = max3f(rma, C0[r], C0[r + 1]); rmb = max3f(rmb, C0[r + 2], C0[r + 3]); rma = max3f(rma, C1[r], C1[r + 1]); rmb = max3f(rmb, C1[r + 2], C1[r + 3]); } \
            float rm = swapmax(max2f(rma, rmb)); \
            const bool force = (!has_sink) && ((i_) == 0); \
            if (force || __any(rm > THR)) { \
                const float dl = force ? rm : max2f(rm, 0.f), al = __builtin_amdgcn_exp2f(-dl); \
                _Pragma("unroll") for (int r = 0; r < 16; ++r) { C0[r] -= dl; C1[r] -= dl; o0[r] *= al; o1[r] *= al; negm[r] -= dl; } \
                if (actn) { _Pragma("unroll") for (int r = 0; r < 16; ++r) { N0[r] -= dl; N1[r] -= dl; } } \
                lsum *= al; asm volatile("" : "+v"(negm)); \
            } \
            float sacc = 0.f; \
            _Pragma("unroll") for (int r = 0; r < 16; ++r) { C0[r] = __builtin_amdgcn_exp2f(C0[r]); C1[r] = __builtin_amdgcn_exp2f(C1[r]); sacc += C0[r]; sacc += C1[r]; } \
            lsum += sacc; \
            v4u pw[4]; \
            _Pragma("unroll") for (int k = 0; k < 2; ++k) { \
                pw[k].x = cvtpk(C0[8 * k + 0], C0[8 * k + 1]); pw[k].y = cvtpk(C0[8 * k + 2], C0[8 * k + 3]); pw[k].z = cvtpk(C0[8 * k + 4], C0[8 * k + 5]); pw[k].w = cvtpk(C0[8 * k + 6], C0[8 * k + 7]); \
                pw[2 + k].x = cvtpk(C1[8 * k + 0], C1[8 * k + 1]); pw[2 + k].y = cvtpk(C1[8 * k + 2], C1[8 * k + 3]); pw[2 + k].z = cvtpk(C1[8 * k + 4], C1[8 * k + 5]); pw[2 + k].w = cvtpk(C1[8 * k + 6], C1[8 * k + 7]); } \
            const LAS unsigned char* vb = lds + L_V + ((i_) & 1) * VSLOT + ((lane >> 4) & 1) * 32 + (lane & 3) * 8 + (4 * hi + ((lane & 15) >> 2)) * 64; \
            _Pragma("unroll") for (int ks = 0; ks < 4; ++ks) { \
                const s16x4 a0 = vtr(vb + ks * 1024), a1 = vtr(vb + ks * 1024 + 512), b0 = vtr(vb + 4096 + ks * 1024), b1 = vtr(vb + 4096 + ks * 1024 + 512); \
                const bf16x8 vf0 = (bf16x8){a0[0], a0[1], a0[2], a0[3], a1[0], a1[1], a1[2], a1[3]}, vf1 = (bf16x8){b0[0], b0[1], b0[2], b0[3], b1[0], b1[1], b1[2], b1[3]}; \
                const bf16x8 pf = __builtin_bit_cast(bf16x8, pw[ks]); \
                o0 = __builtin_amdgcn_mfma_f32_32x32x16_bf16(vf0, pf, o0, 0, 0, 0); \
                o1 = __builtin_amdgcn_mfma_f32_32x32x16_bf16(vf1, pf, o1, 0, 0, 0); } \
        } \
        actc = actn; kposc = kposn; \
        ATT_WAITBAR(); } while (0)
    if (WIN) { for (int i = 0; i < NT; i += 2) { ATT_STEP(i, sa0, sa1, sb0, sb1, 2); ATT_STEP(i + 1, sb0, sb1, sa0, sa1, 2); } }
    else {
        for (int i = 0; i + 2 < NT; i += 2) { ATT_STEP(i, sa0, sa1, sb0, sb1, 1); ATT_STEP(i + 1, sb0, sb1, sa0, sa1, 1); }
        ATT_STEP(NT - 2, sa0, sa1, sb0, sb1, 1); ATT_STEP(NT - 1, sb0, sb1, sa0, sa1, 0);
    }
#undef ATT_STEP
#undef ATT_QK
#undef ATT_ISSUE_K
#undef ATT_ISSUE_V
#undef ATT_TILE
#undef ATT_WAITBAR
    const float inv = __builtin_amdgcn_rcpf(swapsum(lsum));
    LAS unsigned char* stg = lds + L_O + wid * (32 * OSTR);
    typedef unsigned u32x2v __attribute__((ext_vector_type(2)));
#pragma unroll
    for (int rg = 0; rg < 4; ++rg) {
        u32x2v w0, w1;
        w0.x = cvtpk(o0[4 * rg + 0] * inv, o0[4 * rg + 1] * inv); w0.y = cvtpk(o0[4 * rg + 2] * inv, o0[4 * rg + 3] * inv);
        w1.x = cvtpk(o1[4 * rg + 0] * inv, o1[4 * rg + 1] * inv); w1.y = cvtpk(o1[4 * rg + 2] * inv, o1[4 * rg + 3] * inv);
        *(LAS u32x2v*)(stg + r32 * OSTR + (8 * rg + 4 * hi) * 2) = w0;
        *(LAS u32x2v*)(stg + r32 * OSTR + (32 + 8 * rg + 4 * hi) * 2) = w1;
    }
    asm volatile("s_waitcnt lgkmcnt(0)" ::: "memory");
#pragma unroll
    for (int i = 0; i < 4; ++i) { const int row = i * 8 + (lane >> 3), ch = lane & 7; const v4u v = *(const LAS v4u*)(stg + row * OSTR + ch * 16);
        *(v4u*)(u.O + (size_t)(wid * 32 + row) * DM + ch * 8) = v; }
    asm volatile("s_waitcnt lgkmcnt(0)" ::: "memory");
}
}

__device__ __forceinline__ int win_map(int n) {
    if (n < 512) { const int hh = n >> 6, d = n & 63; return (hh >> 2) * 256 + (d >> 5) * 128 + (hh & 3) * 32 + (d & 31); }
    if (n < 640) { const int vh = (n - 512) >> 6, d = n & 63; return 4 * 256 + (d >> 5) * 128 + vh * 32 + (d & 31); }
    if (n < 896) return 5 * 256 + (n - 640);
    if (n < 1024) return 6 * 256 + (n - 896);
    if (n < 1056) return 6 * 256 + 128 + (n - 1024);
    const int n2 = n - 1056;
    if (n2 < 512) { const int hh = n2 >> 6, d = n2 & 63; return (2 + (hh >> 2)) * 256 + (d >> 5) * 128 + (hh & 3) * 32 + (d & 31); }
    const int vh = (n2 - 512) >> 6, d = n2 & 63; return 4 * 256 + (d >> 5) * 128 + (2 + vh) * 32 + (d & 31);
}
__device__ __forceinline__ void transpose_item(const float* W, int ldw, int k0, int n0, void* WT, int dpitch, int dk0, int rmode, int roff, LAS float* scr, int lane, int out8, const float* kscale = nullptr) {
    float tv[32];
#pragma unroll
    for (int i = 0; i < 32; ++i) { const int kk = 2 * i + (lane >> 5); tv[i] = W[(size_t)(k0 + kk) * ldw + n0 + (lane & 31)]; }
    if (kscale) {
#pragma unroll
        for (int i = 0; i < 32; ++i) tv[i] *= kscale[k0 + 2 * i + (lane >> 5)]; }
#pragma unroll
    for (int i = 0; i < 32; ++i) { const int kk = 2 * i + (lane >> 5); scr[kk * 33 + (lane & 31)] = tv[i]; }
    LDS_WAIT(); asm volatile("" ::: "memory");
    const int c = lane & 7;
#pragma unroll
    for (int j = 0; j < 4; ++j) { const int n = (lane >> 3) + 8 * j; const LAS float* s = scr + (8 * c) * 33 + n;
        const int nn = n0 + n; const int drow = (rmode == 1) ? (256 * (nn >> 7) + 128 * roff + (nn & 127)) : (rmode == 2) ? (roff + ((nn >> 6) & 1) * 256 + (nn >> 7) * 64 + (nn & 63)) : (rmode == 3) ? (win_map(n0) + n) : (roff + nn);
        const size_t eo = (size_t)drow * dpitch + dk0 + k0 + 8 * c;
        if (out8) { typedef unsigned u32x2v __attribute__((ext_vector_type(2))); u32x2v o;
            o.x = pk4_fp8(s[0 * 33] * F8_SW, s[1 * 33] * F8_SW, s[2 * 33] * F8_SW, s[3 * 33] * F8_SW); o.y = pk4_fp8(s[4 * 33] * F8_SW, s[5 * 33] * F8_SW, s[6 * 33] * F8_SW, s[7 * 33] * F8_SW);
            *(u32x2v*)((unsigned char*)WT + eo) = o; }
        else { v4u o; o.x = pk2(s[0 * 33], s[1 * 33]); o.y = pk2(s[2 * 33], s[3 * 33]); o.z = pk2(s[4 * 33], s[5 * 33]); o.w = pk2(s[6 * 33], s[7 * 33]);
            *(v4u*)((bf16*)WT + eo) = o; } }
    LDS_WAIT(); asm volatile("" ::: "memory");
}
__device__ __forceinline__ void transpose_mat(const Ctx& C, int item, const float* W, int K, int N, void* WT, int dpitch, int dk0, int rmode, int roff, int out8 = 0, const float* kscale = nullptr) {
    const int nblk = N / 32, kb = item / nblk, nb = item % nblk;
    transpose_item(W, N, 64 * kb, 32 * nb, WT, dpitch, dk0, rmode, roff, (LAS float*)(C.lds + C.wave * 16384), C.lane, out8, kscale);
}

__device__ __forceinline__ void phase_prologue(const Ctx& C) {
    float* mod = (float*)(C.ws + WS_MOD);
    if (C.vcu < 192) {
        const int L = C.vcu / 96, j0 = (C.vcu % 96) * 64;
        LAS float* sil = (LAS float*)C.lds; LAS float* part = (LAS float*)(C.lds + 40960);
        const float* cc = C.in[1]; const float* cx = C.in[3];
        for (int i = C.tid; i < 9 * 1024; i += 512) { const int r = i >> 10, k = i & 1023; const float v = (r < 8) ? cc[r * 1024 + k] : cx[k]; sil[i] = v / (1.0f + __expf(-v)); }
        __syncthreads();
        float acc[9];
#pragma unroll
        for (int r = 0; r < 9; ++r) acc[r] = 0.f;
        const float* wm = C.in[4] + (size_t)L * 1024 * 6144 + j0 + C.lane;
#pragma unroll 16
        for (int kk = 0; kk < 128; ++kk) { const int k = C.wave * 128 + kk; const float wv = wm[(size_t)k * 6144];
#pragma unroll
            for (int r = 0; r < 9; ++r) acc[r] += sil[r * 1024 + k] * wv; }
#pragma unroll
        for (int r = 0; r < 9; ++r) part[(C.wave * 9 + r) * 64 + C.lane] = acc[r];
        __syncthreads();
        for (int i = C.tid; i < 576; i += 512) { const int r = i >> 6, l = i & 63; float s = 0.f;
#pragma unroll
            for (int w = 0; w < 8; ++w) s += part[(w * 9 + r) * 64 + l];
            mod[(size_t)(L * 9 + r) * 6144 + j0 + l] = s + C.in[5][L * 6144 + j0 + l]; }
        __syncthreads();
    }
    const int gw = C.vcu * NWAVES + C.wave, NGW = C.G * NWAVES;
    bf16* win = (bf16*)(C.ws + WS_WIN); bf16* wout = (bf16*)(C.ws + WS_WOUT); unsigned char* wup = C.ws + WS_WUP; unsigned char* wdn = C.ws + WS_WDN; bf16* wub = (bf16*)(C.ws + WS_WUB);
    constexpr int I_IN = 16 * 53, I_OUT = 16 * 32, I_UP = 16 * 88, I_DN = 44 * 32, I_UQ = 4 * 12, I_UKV = 2 * 16, I_Z = 192;
    constexpr int NITEMS = 2 * I_IN + 2 * I_OUT + 2 * I_UP + I_DN + 2 * I_UQ + 2 * I_UKV + 2 * I_Z;
    for (int it = gw; it < NITEMS; it += NGW) {
        int r = it;
        if (r < 2 * I_IN) { const int L = r / I_IN; transpose_mat(C, r % I_IN, C.in[8] + (size_t)L * DM * INCOLS, DM, INCOLS, win + (size_t)L * NPROJ * DM, DM, 0, 3, 0); continue; } r -= 2 * I_IN;
        if (r < 2 * I_OUT) { const int L = r / I_OUT; transpose_mat(C, r % I_OUT, C.in[16] + (size_t)L * DM * DM, DM, DM, wout + (size_t)L * DM * DM, DM, 0, 0, 0); continue; } r -= 2 * I_OUT;
        if (r < I_UP) { transpose_mat(C, r, C.in[17], DM, FFD, wup, DM, 0, 1, 0, DENSE_F8 | DENSE_F8_UP); continue; } r -= I_UP;
        if (r < I_UP) { transpose_mat(C, r, C.in[18], DM, FFD, wup, DM, 0, 1, 1, DENSE_F8 | DENSE_F8_UP); continue; } r -= I_UP;
        if (r < I_DN) { transpose_mat(C, r, C.in[19], FFD, DM, wdn, FFD, 0, 0, 0, DENSE_F8 | DENSE_F8_DN); continue; } r -= I_DN;
        if (r < 2 * I_UQ) { const int L = r / I_UQ; transpose_mat(C, r % I_UQ, C.in[13] + (size_t)L * 256 * 384, 256, 384, wub + (size_t)L * 1024 * 384, 384, 0, 0, 0, 0, C.in[11] + L * 256); continue; } r -= 2 * I_UQ;
        if (r < 2 * I_UKV) { const int L = r / I_UKV; transpose_mat(C, r % I_UKV, C.in[14] + (size_t)L * 128 * 512, 128, 512, wub + (size_t)L * 1024 * 384, 384, 256, 2, 512, 0, C.in[12] + L * 128); continue; } r -= 2 * I_UKV;
        { const int L = r / I_Z, z = r % I_Z; *(v4u*)(win + (size_t)L * NPROJ * DM + (size_t)INCOLS * DM + (size_t)z * 512 + C.lane * 8) = (v4u){0u, 0u, 0u, 0u}; }
    }
}

__device__ __forceinline__ void norm_load(f32x4 (&v)[4], const float* xrow, const float* xadd, int lane) {
    const f32x4* xr = (const f32x4*)xrow + lane;
    if (xadd) { const f32x4* xa = (const f32x4*)xadd + lane;
#pragma unroll
        for (int j = 0; j < 4; ++j) v[j] = xr[64 * j] + xa[64 * j]; }
    else {
#pragma unroll
        for (int j = 0; j < 4; ++j) v[j] = xr[64 * j]; }
}
__device__ __forceinline__ unsigned long long* xs_row(const float* out, int n) {
    return (unsigned long long*)((unsigned char*)out + (size_t)n * 4096 + (size_t)(__builtin_popcount(n & 0x2D6) & 1) * 2048);
}
#define XS_UNPACK(dst_, d_) do { (dst_).x = bflo((unsigned)(d_)); (dst_).y = bfhi((unsigned)(d_)); (dst_).z = bflo((unsigned)((d_) >> 32)); (dst_).w = bfhi((unsigned)((d_) >> 32)); } while (0)
__device__ __forceinline__ void norm_finish(const f32x4 (&v)[4], const float* g, const float* sc, const float* sh, void* orow, int lane, int out8) {
    f32x4 gg[4], s1[4], s0[4]; float s = 0.f;
#pragma unroll
    for (int j = 0; j < 4; ++j) { gg[j] = ((const f32x4*)g)[lane + 64 * j]; s1[j] = ((const f32x4*)sc)[lane + 64 * j]; s0[j] = ((const f32x4*)sh)[lane + 64 * j]; }
#pragma unroll
    for (int j = 0; j < 4; ++j) { s += (v[j].x * v[j].x + v[j].y * v[j].y) + (v[j].z * v[j].z + v[j].w * v[j].w); }
    const float rinv = fast_rsqrt(wave_sum(s) * (1.f / DM) + EPS);
    unsigned long long* o8 = (unsigned long long*)orow + lane; unsigned* o4 = (unsigned*)orow + lane;
#pragma unroll
    for (int j = 0; j < 4; ++j) {
        const f32x4 y = v[j] * rinv * gg[j] * (s1[j] + 1.0f) + s0[j];
        if (out8) o4[64 * j] = pk4_fp8(y.x * F8_SA, y.y * F8_SA, y.z * F8_SA, y.w * F8_SA);
        else o8[64 * j] = (unsigned long long)pk2(y.x, y.y) | ((unsigned long long)pk2(y.z, y.w) << 32); }
}
__device__ __forceinline__ void norm_row(const float* xrow, const float* g, const float* sc, const float* sh, void* orow, int lane, int out8, const float* xadd = nullptr) {
    f32x4 v[4]; norm_load(v, xrow, xadd, lane); norm_finish(v, g, sc, sh, orow, lane, out8);
}
__device__ __forceinline__ void norm_finish_c(const f32x4 (&v)[4], const f32x4 (&ca)[4], const f32x4 (&cb)[4], void* orow, int lane, int out8) {
    float s = 0.f;
#pragma unroll
    for (int j = 0; j < 4; ++j) { s += (v[j].x * v[j].x + v[j].y * v[j].y) + (v[j].z * v[j].z + v[j].w * v[j].w); }
    const float rinv = fast_rsqrt(wave_sum(s) * (1.f / DM) + EPS);
    unsigned long long* o8 = (unsigned long long*)orow + lane; unsigned* o4 = (unsigned*)orow + lane;
#pragma unroll
    for (int j = 0; j < 4; ++j) {
        const f32x4 y = v[j] * rinv * ca[j] + cb[j];
        if (out8) o4[64 * j] = pk4_fp8(y.x * F8_SA, y.y * F8_SA, y.z * F8_SA, y.w * F8_SA);
        else o8[64 * j] = (unsigned long long)pk2(y.x, y.y) | ((unsigned long long)pk2(y.z, y.w) << 32); }
}
__device__ __forceinline__ void phase_norm(const Ctx& C, int L, int which, const float* xlat, const float* xctx, void* H, int out8, const float* ctxadd = nullptr, const bf16* latadd = nullptr, float* xout = nullptr, bool xs_in = false) {
    const int gw = C.vcu * NWAVES + C.wave, NGW = C.G * NWAVES;
    const float* g = (which ? C.in[7] : C.in[6]) + L * DM;
    const float* mod = (const float*)(C.ws + WS_MOD) + (size_t)L * 9 * 6144 + (which ? 3072 : 0);
    {
        const int rpw = (NLAT + NGW - 1) / NGW;
        const int nbeg = gw * rpw, nend = (nbeg + rpw < NLAT) ? nbeg + rpw : NLAT;
        f32x4 pa[2][4]; unsigned long long px[2][4], pd[2][4];
#define PL_LOAD(S_, n_) do { \
        if (xs_in) { const unsigned long long* xr_ = xs_row(xlat, (n_)) + C.lane; _Pragma("unroll") for (int j = 0; j < 4; ++j) px[S_][j] = xr_[64 * j]; } \
        else { const f32x4* xr_ = (const f32x4*)(xlat + (size_t)(n_) * DM) + C.lane; _Pragma("unroll") for (int j = 0; j < 4; ++j) pa[S_][j] = xr_[64 * j]; } \
        if (latadd) { const unsigned long long* dr_ = (const unsigned long long*)(latadd + (size_t)(n_) * DM) + C.lane; _Pragma("unroll") for (int j = 0; j < 4; ++j) pd[S_][j] = dr_[64 * j]; } } while (0)
        f32x4 ca[4], cb[4]; int bprev = -1;
#define PN_ROW(S_, n_) do { \
            f32x4 v[4]; \
            _Pragma("unroll") for (int j = 0; j < 4; ++j) { \
                if (xs_in) XS_UNPACK(v[j], px[S_][j]); else v[j] = pa[S_][j]; \
                if (latadd) { f32x4 d; XS_UNPACK(d, pd[S_][j]); v[j] = v[j] + d; } } \
            if ((n_) + 2 < nend) PL_LOAD(S_, (n_) + 2); \
            const int b = (n_) / SEQ; \
            if (b != bprev) { bprev = b; const float* md = mod + (size_t)b * 6144; \
                _Pragma("unroll") for (int j = 0; j < 4; ++j) { ca[j] = ((const f32x4*)g)[C.lane + 64 * j] * (((const f32x4*)(md + 1024))[C.lane + 64 * j] + 1.0f); cb[j] = ((const f32x4*)md)[C.lane + 64 * j]; } } \
            const int m = b * TT + CTXL + ((n_) - b * SEQ); \
            norm_finish_c(v, ca, cb, (unsigned char*)H + (size_t)m * DM * (out8 ? 1 : 2), C.lane, out8); \
            if (xout) { unsigned long long* xo = xs_row(xout, (n_)) + C.lane; \
                _Pragma("unroll") for (int j = 0; j < 4; ++j) xo[64 * j] = (unsigned long long)pk2(v[j].x, v[j].y) | ((unsigned long long)pk2(v[j].z, v[j].w) << 32); } } while (0)
        if (nbeg < nend) PL_LOAD(0, nbeg);
        if (nbeg + 1 < nend) PL_LOAD(1, nbeg + 1);
        for (int n = nbeg; n < nend; n += 2) {
            PN_ROW(0, n);
            if (n + 1 < nend) PN_ROW(1, n + 1);
        }
#undef PN_ROW
#undef PL_LOAD
    }
    {
        const float* md = mod + (size_t)8 * 6144;
        for (int r = gw; r < NB * CTXL; r += NGW) {
            const int m = (r / CTXL) * TT + r % CTXL;
            norm_row(xctx + (size_t)r * DM, g, md + 1024, md, (unsigned char*)H + (size_t)m * DM * (out8 ? 1 : 2), C.lane, out8, ctxadd ? ctxadd + (size_t)r * DM : nullptr);
        }
    }
}

__device__ __forceinline__ void phase_norm_lat(const Ctx& C, int L, int which, const float* xlat, void* H, int c0) {
    const int gw = (C.wg - c0) * NWAVES + C.wave, NGW = (C.G - c0) * NWAVES;
    const float* g = (which ? C.in[7] : C.in[6]) + L * DM;
    const float* mod = (const float*)(C.ws + WS_MOD) + (size_t)L * 9 * 6144 + (which ? 3072 : 0);
    for (int n = gw; n < NLAT; n += NGW) {
        const int b = n / SEQ, m = b * TT + CTXL + n % SEQ;
        const float* md = mod + (size_t)b * 6144;
        norm_row(xlat + (size_t)n * DM, g, md + 1024, md, (unsigned char*)H + (size_t)m * DM * 2, C.lane, 0);
    }
}
__device__ __forceinline__ void phase_norm_ctx(const Ctx& C, int L, int which, const float* xctx, void* H) {
    const int gw = C.vcu * NWAVES + C.wave, NGW = C.G * NWAVES;
    const float* g = (which ? C.in[7] : C.in[6]) + L * DM;
    const float* md = (const float*)(C.ws + WS_MOD) + (size_t)L * 9 * 6144 + (which ? 3072 : 0) + (size_t)8 * 6144;
    for (int r = gw; r < NB * CTXL; r += NGW) {
        const int m = (r / CTXL) * TT + r % CTXL;
        norm_row(xctx + (size_t)r * DM, g, md + 1024, md, (unsigned char*)H + (size_t)m * DM * 2, C.lane, 0);
    }
}

__device__ __forceinline__ void build_rope_tables(const Ctx& C, LAS float* tab64, LAS float* tab32) {
    for (int i = C.tid; i < 1024; i += 512) { const int pos = i >> 4, f = i & 15; const float invf = exp2f(-(float)f * (13.287712379549449f / 16.0f)); const float rev = ((float)pos * invf) * 0.15915494309189535f;
        tab64[2 * i] = __builtin_amdgcn_cosf(rev); tab64[2 * i + 1] = __builtin_amdgcn_sinf(rev); }
    for (int i = C.tid; i < 512; i += 512) { const int pos = i >> 3, f = i & 7; const float invf = exp2f(-(float)f * (13.287712379549449f / 8.0f)); const float rev = ((float)pos * invf) * 0.15915494309189535f;
        tab32[2 * i] = __builtin_amdgcn_cosf(rev); tab32[2 * i + 1] = __builtin_amdgcn_sinf(rev); }
    __syncthreads();
}
__device__ __forceinline__ size_t kimg_off(int t, int c, int tile_bytes) { return (size_t)(t >> 6) * tile_bytes + c * 1024 + (t & 63) * 16; }
__device__ __forceinline__ size_t vimg_off(int t, int c) { return (size_t)(t >> 6) * 8192 + (c >> 2) * 4096 + ((t & 63) >> 4) * 1024 + (t & 15) * 64 + (c & 3) * 16; }

__device__ __forceinline__ void phase_attn(const Ctx& C, int L) {
    const bf16* QA = (const bf16*)(C.ws + WS_QA); const bf16* QB = (const bf16*)(C.ws + WS_QB); const bf16* QC = (const bf16*)(C.ws + WS_QC);
    const unsigned char* KA = C.ws + WS_KA; const unsigned char* VA = C.ws + WS_VA; const unsigned char* KB = C.ws + WS_KB; const unsigned char* VB = C.ws + WS_VB;
    const unsigned char* KC = C.ws + WS_KC; const unsigned char* VC = C.ws + WS_VC;
    bf16* mix = (bf16*)(C.ws + WS_H);
    const float* sinks = C.in[15] + L * 6;
    const int with_ctx = (L == 0);
    for (int idx = C.vcu; idx < 512 + (with_ctx ? 32 : 0); idx += C.G) {
        att::UnitDesc u; int b, h, row0;
        if (idx < 512) { b = idx >> 6; h = (idx >> 4) & 3; row0 = CTXL + (idx & 15) * 256; u.n0 = KTILES; u.qpos0 = (idx & 15) * 256; }
        else { const int j = idx - 512; b = j >> 2; h = j & 3; row0 = 0; u.n0 = 4; u.qpos0 = 0; }
        u.Q = QB + ((size_t)(b * 4 + h) * TT + row0) * 96; u.Kimg = KB + (size_t)(b * 4 + h) * KTILES * 12288; u.Vimg = VB + (size_t)(b * 4 + h) * KTILES * 8192;
        u.O = mix + ((size_t)b * TT + row0) * DM + 384 + h * 64; u.s1t0 = 0; u.n1 = 0; u.minit = att::NEGBIG; u.linit = 0.f;
        if (idx < 512) att::rope_q96((bf16*)u.Q, u.qpos0);
        att::unit<96, false>(C.lds, u);
    }
    for (int idx = C.vcu; idx < 768 + (with_ctx ? 96 : 0); idx += C.G) {
        att::UnitDesc u; int b, h, row0, isC = 0;
        if (idx < 768) { b = idx / 96; h = (idx >> 4) % 6; row0 = CTXL + (idx & 15) * 256; u.n0 = KTILES; }
        else { int j = idx - 768; if (j >= 48) { j -= 48; isC = 1; } b = j / 6; h = j % 6; row0 = 0; u.n0 = 4; }
        const int hk = h / 3;
        u.Q = (isC ? QC : QA) + ((size_t)(b * 6 + h) * TT + row0) * 64; u.Kimg = (isC ? KC : KA) + (size_t)(b * 2 + hk) * KTILES * 8192; u.Vimg = (isC ? VC : VA) + (size_t)(b * 2 + hk) * KTILES * 8192;
        u.O = mix + ((size_t)b * TT + row0) * DM + (isC ? 640 : 0) + h * 64; u.s1t0 = 0; u.n1 = 0; u.qpos0 = 0;
        u.minit = isC ? sinks[h] * LOG2E : att::NEGBIG; u.linit = isC ? 1.f : 0.f;
        att::unit<64, false>(C.lds, u);
    }
    for (int idx = C.vcu; idx < 768; idx += C.G) {
        att::UnitDesc u; const int b = idx / 96, h = (idx >> 4) % 6, qb = idx & 15, hk = h / 3, row0 = CTXL + qb * 256;
        const int lt0 = 4 * qb - 2, ls = lt0 < 0 ? 0 : lt0, le = (lt0 + 10 > 64) ? 64 : lt0 + 10;
        u.Q = QC + ((size_t)(b * 6 + h) * TT + row0) * 64; u.Kimg = KC + (size_t)(b * 2 + hk) * KTILES * 8192; u.Vimg = VC + (size_t)(b * 2 + hk) * KTILES * 8192;
        u.O = mix + ((size_t)b * TT + row0) * DM + 640 + h * 64; u.n0 = 4; u.s1t0 = 4 + ls; u.n1 = le - ls; u.qpos0 = qb * 256;
        u.minit = sinks[h] * LOG2E; u.linit = 1.f;
        att::unit<64, true>(C.lds, u);
    }
}

constexpr int MOE_I_UP = 16 * 112, MOE_I_DN = 56 * 32, MOE_ITEMS = NEXP * (2 * MOE_I_UP + MOE_I_DN);
struct MoeItem { const float* Wb; int ldw; unsigned char* WT; int dpitch, k0, n0, inter, roff; };
__device__ __forceinline__ MoeItem moe_item_desc(const Ctx& C, int it) {
    unsigned char* wmup = C.ws + WS_WMUP; unsigned char* wmdn = C.ws + WS_WMDN;
    const int e = it / (2 * MOE_I_UP + MOE_I_DN); int r = it % (2 * MOE_I_UP + MOE_I_DN);
    MoeItem d;
    if (r < 2 * MOE_I_UP) { const int w3 = r >= MOE_I_UP; if (w3) r -= MOE_I_UP; const int nblk = FFE / 32, kb = r / nblk, nb = r % nblk;
        d.ldw = FFE; d.k0 = 64 * kb; d.n0 = 32 * nb; d.Wb = (w3 ? C.in[22] : C.in[21]) + (size_t)e * DM * FFE + (size_t)d.k0 * FFE + d.n0; d.WT = wmup + (size_t)e * 2 * FFE * DM; d.dpitch = DM; d.inter = 1; d.roff = w3; }
    else { r -= 2 * MOE_I_UP; const int nblk = DM / 32, kb = r / nblk, nb = r % nblk;
        d.ldw = DM; d.k0 = 64 * kb; d.n0 = 32 * nb; d.Wb = C.in[23] + (size_t)e * FFE * DM + (size_t)d.k0 * DM + d.n0; d.WT = wmdn + (size_t)e * DM * FFE; d.dpitch = FFE; d.inter = 0; d.roff = 0; }
    return d;
}
__device__ __forceinline__ void moe_item_load(const MoeItem& d, float (&tv)[32], int lane) {
#pragma unroll
    for (int i = 0; i < 32; ++i) tv[i] = d.Wb[(unsigned)((2 * i + (lane >> 5)) * d.ldw + (lane & 31))];
}
__device__ __forceinline__ void moe_item_store(const MoeItem& d, const float (&tv)[32], LAS float* scr, int lane) {
#pragma unroll
    for (int i = 0; i < 32; ++i) { const int kk = 2 * i + (lane >> 5); scr[kk * 33 + (lane & 31)] = tv[i]; }
    LDS_WAIT(); asm volatile("" ::: "memory");
    const int c = lane & 7;
#pragma unroll
    for (int j = 0; j < 4; ++j) { const int n = (lane >> 3) + 8 * j; const LAS float* sp = scr + (8 * c) * 33 + n;
        const int nn = d.n0 + n; const int drow = d.inter ? (256 * (nn >> 7) + 128 * d.roff + (nn & 127)) : nn;
        typedef unsigned u32x2v __attribute__((ext_vector_type(2))); u32x2v o;
        o.x = pk4_fp8(sp[0 * 33] * F8_SW, sp[1 * 33] * F8_SW, sp[2 * 33] * F8_SW, sp[3 * 33] * F8_SW); o.y = pk4_fp8(sp[4 * 33] * F8_SW, sp[5 * 33] * F8_SW, sp[6 * 33] * F8_SW, sp[7 * 33] * F8_SW);
        *(u32x2v*)(d.WT + (size_t)drow * d.dpitch + d.k0 + 8 * c) = o; }
    LDS_WAIT(); asm volatile("" ::: "memory");
}
__device__ __forceinline__ void moe_convert_two(const Ctx& C, int it0, int it1) {
    LAS float* scr = (LAS float*)(C.lds + C.wave * 16384);
    const bool v0 = it0 < MOE_ITEMS, v1 = it1 < MOE_ITEMS;
    float ta[32], tb[32];
    MoeItem d0, d1;
    if (v0) { d0 = moe_item_desc(C, it0); moe_item_load(d0, ta, C.lane); }
    if (v1) { d1 = moe_item_desc(C, it1); moe_item_load(d1, tb, C.lane); }
    if (v0) moe_item_store(d0, ta, scr, C.lane);
    if (v1) moe_item_store(d1, tb, scr, C.lane);
}
__device__ __forceinline__ void moe_convert_steal(const Ctx& C, unsigned* ctr, unsigned* done, int need_done, bool count_done) {
    LAS int* sh = (LAS int*)(C.lds + 130048);
    if (count_done && C.tid == 0) __hip_atomic_fetch_add(done, 1u, __ATOMIC_RELAXED, __HIP_MEMORY_SCOPE_AGENT);
    for (;;) {
        __syncthreads();
        if (C.tid == 0) { int base = -1;
            if (!count_done || (int)__hip_atomic_load(done, __ATOMIC_RELAXED, __HIP_MEMORY_SCOPE_AGENT) < need_done) base = (int)__hip_atomic_fetch_add(ctr, 16u, __ATOMIC_RELAXED, __HIP_MEMORY_SCOPE_AGENT);
            sh[0] = base; }
        __syncthreads();
        const int base = sh[0];
        if (base < 0 || base >= MOE_ITEMS) break;
        moe_convert_two(C, base + C.wave, base + C.wave + NWAVES);
    }
    __syncthreads();
}

__device__ __forceinline__ void phase_route1(const Ctx& C) {
    LAS f32x4* wr0 = (LAS f32x4*)C.lds; LAS f32x4* wr1 = wr0 + 1024;
    LAS int* hist = (LAS int*)(C.lds + 32768);
    const f32x4* wrg = (const f32x4*)C.in[20];
    for (int k = C.tid; k < 1024; k += 512) { const int slot = ((k >> 8) * 4 + (k & 3)) * 64 + ((k & 255) >> 2); wr0[slot] = wrg[2 * k]; wr1[slot] = wrg[2 * k + 1]; }
    if (C.tid < 8) hist[C.tid] = 0;
    __syncthreads();
    const float* g = C.in[7] + DM; const float* mod = (const float*)(C.ws + WS_MOD) + (size_t)9 * 6144 + 3072;
    unsigned char* H8 = C.ws + WS_H;
    int* tope = (int*)(C.ws + WS_RT + RT_TOPE); float* gate = (float*)(C.ws + WS_RT + RT_GATE);
    const int TPW = NLAT / C.G;
    f32x4 ca[4], cb[4];
    { const float* md = mod + (size_t)((C.wg * TPW) / SEQ) * 6144;
#pragma unroll
      for (int j = 0; j < 4; ++j) { ca[j] = ((const f32x4*)g)[C.lane + 64 * j] * (((const f32x4*)(md + 1024))[C.lane + 64 * j] + 1.0f); cb[j] = ((const f32x4*)md)[C.lane + 64 * j]; } }
    unsigned long long rx[4], rd[4];
#define R1_LOAD(n_) do { const unsigned long long* xr_ = xs_row(C.out, (n_)) + C.lane; const unsigned long long* dr_ = (const unsigned long long*)((const bf16*)(C.ws + WS_D1) + (size_t)(n_) * DM) + C.lane; \
        _Pragma("unroll") for (int j = 0; j < 4; ++j) { rx[j] = xr_[64 * j]; rd[j] = dr_[64 * j]; } } while (0)
    R1_LOAD(C.wg * TPW + C.wave);
    for (int i = C.wave; i < TPW; i += NWAVES) {
        const int n = C.wg * TPW + i;
        f32x4 v[4]; float s = 0.f;
#pragma unroll
        for (int j = 0; j < 4; ++j) { f32x4 d; XS_UNPACK(v[j], rx[j]); XS_UNPACK(d, rd[j]); v[j] = v[j] + d; s += (v[j].x * v[j].x + v[j].y * v[j].y) + (v[j].z * v[j].z + v[j].w * v[j].w); }
        if (i + NWAVES < TPW) R1_LOAD(n + NWAVES);
        const float rinv = fast_rsqrt(wave_sum(s) * (1.f / DM) + EPS);
        unsigned* o8 = (unsigned*)(H8 + (size_t)n * DM) + C.lane;
        float lg[8];
#pragma unroll
        for (int e = 0; e < 8; ++e) lg[e] = 0.f;
#pragma unroll
        for (int j = 0; j < 4; ++j) {
            const f32x4 y = v[j] * rinv * ca[j] + cb[j];
            o8[64 * j] = pk4_fp8(y.x * F8_SA, y.y * F8_SA, y.z * F8_SA, y.w * F8_SA);
#pragma unroll
            for (int q = 0; q < 4; ++q) { const f32x4 w0 = wr0[(4 * j + q) * 64 + C.lane], w1 = wr1[(4 * j + q) * 64 + C.lane]; const float yy = y[q];
                lg[0] += yy * w0.x; lg[1] += yy * w0.y; lg[2] += yy * w0.z; lg[3] += yy * w0.w; lg[4] += yy * w1.x; lg[5] += yy * w1.y; lg[6] += yy * w1.z; lg[7] += yy * w1.w; } }
#pragma unroll
        for (int e = 0; e < 8; ++e) lg[e] = wave_sum(lg[e]);
        int e1 = 0; float l1 = lg[0];
#pragma unroll
        for (int e = 1; e < 8; ++e) if (lg[e] > l1) { l1 = lg[e]; e1 = e; }
        int e2 = -1; float l2 = -3.0e38f;
#pragma unroll
        for (int e = 0; e < 8; ++e) if (e != e1 && lg[e] > l2) { l2 = lg[e]; e2 = e; }
        const float g2 = 1.0f / (1.0f + __expf(l1 - l2)), g1 = 1.0f - g2;
        if (C.lane == 0) { tope[2 * n] = e1; tope[2 * n + 1] = e2; gate[2 * n] = g1; gate[2 * n + 1] = g2; __hip_atomic_fetch_add(hist + e1, 1, __ATOMIC_RELAXED, __HIP_MEMORY_SCOPE_WORKGROUP); __hip_atomic_fetch_add(hist + e2, 1, __ATOMIC_RELAXED, __HIP_MEMORY_SCOPE_WORKGROUP); }
    }
    __syncthreads();
    if (C.tid < 8) ((int*)(C.ws + WS_RT + RT_HIST))[C.wg * 8 + C.tid] = hist[C.tid];
    __syncthreads();
    moe_convert_steal(C, (unsigned*)(C.ws + WS_CTL) + CW_STEAL, (unsigned*)(C.ws + WS_CTL) + CW_DONE, 0x7fffffff, false);
}

__device__ __forceinline__ void phase_route2(const Ctx& C) {
    LAS int* hl = (LAS int*)C.lds;
    LAS int* cnt = (LAS int*)(C.lds + 16384); LAS int* pre = cnt + 8; LAS int* off = cnt + 16;
    LAS int* ep = (LAS int*)(C.lds + 20480); LAS int* posl = ep + 512;
    const int* hist = (const int*)(C.ws + WS_RT + RT_HIST);
    for (int i = C.tid; i < C.G * 8; i += 512) hl[i] = hist[i];
    __syncthreads();
    if (C.tid < 8) { int s = 0, p = 0; for (int w = 0; w < C.G; ++w) { const int hv = hl[w * 8 + C.tid]; if (w < C.wg) p += hv; s += hv; } cnt[C.tid] = s; pre[C.tid] = p; }
    __syncthreads();
    if (C.tid == 0) { int o = 0; for (int e = 0; e < 8; ++e) { off[e] = o; o += (cnt[e] + 255) & ~255; } off[8] = o; }
    __syncthreads();
    const int TPW = NLAT / C.G, NP = 2 * TPW;
    const int* tope = (const int*)(C.ws + WS_RT + RT_TOPE); int* posg = (int*)(C.ws + WS_RT + RT_POS);
    for (int p = C.tid; p < NP; p += 512) ep[p] = tope[2 * (C.wg * TPW) + p];
    __syncthreads();
    for (int p = C.tid; p < NP; p += 512) { const int e = ep[p]; int rank = 0; for (int q = 0; q < p; ++q) rank += (ep[q] == e) ? 1 : 0; const int pos = off[e] + pre[e] + rank; posl[p] = pos; posg[2 * (C.wg * TPW) + p] = pos; }
    __syncthreads();
    const unsigned char* H8 = C.ws + WS_H; unsigned char* HFS = C.ws + WS_HFS;
    for (int i0 = C.wave; i0 < TPW; i0 += 8 * NWAVES) {
        v4u a[8];
#pragma unroll
        for (int k = 0; k < 8; ++k) { const int i = i0 + k * NWAVES; if (i < TPW) a[k] = ((const v4u*)(H8 + (size_t)(C.wg * TPW + i) * DM))[C.lane]; }
#pragma unroll
        for (int k = 0; k < 8; ++k) { const int i = i0 + k * NWAVES; if (i < TPW) { ((v4u*)(HFS + (size_t)posl[2 * i] * DM))[C.lane] = a[k]; ((v4u*)(HFS + (size_t)posl[2 * i + 1] * DM))[C.lane] = a[k]; } }
    }
    int* tile_e = (int*)(C.ws + WS_RT + RT_TILEE);
    if (C.wg == 0) { for (int tl = C.tid; tl < 272; tl += 512) { int e = 7; for (int q = 7; q >= 0; --q) if (tl * 256 < off[q + 1]) e = q; tile_e[tl] = e; } if (C.tid == 0) tile_e[272] = off[8] >> 8; }
    if (C.wg < 8) { const int e = C.wg; for (int r = off[e] + cnt[e] + C.wave; r < off[e + 1]; r += NWAVES) ((v4u*)(HFS + (size_t)r * DM))[C.lane] = (v4u){0u, 0u, 0u, 0u}; }
}

constexpr int FIN_BLK = 64, FIN_TAILROW = MOE_CH * (MOE_NCH - 1) * 256;
struct FinTok { f32x4 x[4], gg[4]; unsigned long long a[4], c[4]; };
__device__ __forceinline__ void fin_load(const Ctx& C, FinTok& t, int n, int p0, int p1) {
    const unsigned long long* xr = xs_row(C.out, n) + C.lane; const bf16* Y = (const bf16*)(C.ws + WS_Y);
    const unsigned long long* y0 = (const unsigned long long*)(Y + (size_t)p0 * DM) + C.lane; const unsigned long long* y1 = (const unsigned long long*)(Y + (size_t)p1 * DM) + C.lane;
    const float* gt = (const float*)(C.ws + WS_MOD) + (size_t)9 * 6144 + 5120 + (size_t)(n / SEQ) * 6144;
    const unsigned long long* dr = (const unsigned long long*)((const bf16*)(C.ws + WS_D1) + (size_t)n * DM) + C.lane;
#pragma unroll
    for (int j = 0; j < 4; ++j) { const unsigned long long xb = xr[64 * j]; f32x4 x; XS_UNPACK(x, xb); const unsigned long long d = dr[64 * j]; t.a[j] = y0[64 * j]; t.c[j] = y1[64 * j]; t.gg[j] = ((const f32x4*)gt)[C.lane + 64 * j];
        t.x[j].x = x.x + bflo((unsigned)d); t.x[j].y = x.y + bfhi((unsigned)d); t.x[j].z = x.z + bflo((unsigned)(d >> 32)); t.x[j].w = x.w + bfhi((unsigned)(d >> 32)); }
}
__device__ __forceinline__ void fin_finish(const Ctx& C, const FinTok& t, int n, float g0, float g1, const f32x4 (&fnv)[4]) {
    f32x4* xr = (f32x4*)(C.out + (size_t)n * DM) + C.lane;
    f32x4 v[4]; float s = 0.f;
#pragma unroll
    for (int j = 0; j < 4; ++j) { const unsigned long long a = t.a[j], c = t.c[j]; const f32x4 gg = t.gg[j];
        f32x4 ya, yc; ya.x = bflo((unsigned)a); ya.y = bfhi((unsigned)a); ya.z = bflo((unsigned)(a >> 32)); ya.w = bfhi((unsigned)(a >> 32));
        yc.x = bflo((unsigned)c); yc.y = bfhi((unsigned)c); yc.z = bflo((unsigned)(c >> 32)); yc.w = bfhi((unsigned)(c >> 32));
        v[j] = t.x[j] + gg * (ya * g0 + yc * g1); s += (v[j].x * v[j].x + v[j].y * v[j].y) + (v[j].z * v[j].z + v[j].w * v[j].w); }
    const float rinv = fast_rsqrt(wave_sum(s) * (1.f / DM) + EPS);
#pragma unroll
    for (int j = 0; j < 4; ++j) xr[64 * j] = v[j] * rinv * fnv[j];
}
__device__ __forceinline__ void fin_row_acc(const Ctx& C, int p, float g, f32x4 (&y)[4]) {
    if (p < FIN_TAILROW) { const unsigned long long* yr = (const unsigned long long*)((const bf16*)(C.ws + WS_Y) + (size_t)p * DM) + C.lane;
#pragma unroll
        for (int j = 0; j < 4; ++j) { const unsigned long long a = yr[64 * j]; y[j].x += g * bflo((unsigned)a); y[j].y += g * bfhi((unsigned)a); y[j].z += g * bflo((unsigned)(a >> 32)); y[j].w += g * bfhi((unsigned)(a >> 32)); } }
    else for (int ks = 0; ks < MOE_TAILK; ++ks) { const unsigned long long* yr = (const unsigned long long*)((const bf16*)(C.ws + WS_YT) + ((size_t)ks * 2048 + (p - FIN_TAILROW)) * DM) + C.lane;
#pragma unroll
        for (int j = 0; j < 4; ++j) { const unsigned long long a = yr[64 * j]; y[j].x += g * bflo((unsigned)a); y[j].y += g * bfhi((unsigned)a); y[j].z += g * bflo((unsigned)(a >> 32)); y[j].w += g * bfhi((unsigned)(a >> 32)); } }
}
__device__ __forceinline__ void fin_tail_token(const Ctx& C, int n, int p0, int p1, float g0, float g1) {
    const float* gt = (const float*)(C.ws + WS_MOD) + (size_t)9 * 6144 + 5120 + (size_t)(n / SEQ) * 6144; const float* fn = C.in[24];
    f32x4* xr = (f32x4*)(C.out + (size_t)n * DM) + C.lane; const unsigned long long* xs = xs_row(C.out, n) + C.lane;
    f32x4 y[4];
#pragma unroll
    for (int j = 0; j < 4; ++j) y[j] = (f32x4){0.f, 0.f, 0.f, 0.f};
    fin_row_acc(C, p0, g0, y); fin_row_acc(C, p1, g1, y);
    f32x4 v[4]; float s = 0.f;
#pragma unroll
    for (int j = 0; j < 4; ++j) { const f32x4 gg = ((const f32x4*)gt)[C.lane + 64 * j]; const unsigned long long d = ((const unsigned long long*)((const bf16*)(C.ws + WS_D1) + (size_t)n * DM) + C.lane)[64 * j];
        const unsigned long long xb = xs[64 * j]; f32x4 xd; XS_UNPACK(xd, xb); xd.x += bflo((unsigned)d); xd.y += bfhi((unsigned)d); xd.z += bflo((unsigned)(d >> 32)); xd.w += bfhi((unsigned)(d >> 32));
        v[j] = xd + gg * y[j]; s += (v[j].x * v[j].x + v[j].y * v[j].y) + (v[j].z * v[j].z + v[j].w * v[j].w); }
    const float rinv = fast_rsqrt(wave_sum(s) * (1.f / DM) + EPS);
#pragma unroll
    for (int j = 0; j < 4; ++j) xr[64 * j] = v[j] * rinv * ((const f32x4*)fn)[C.lane + 64 * j];
}
__device__ __forceinline__ void final_tokens(const Ctx& C, int nbase, int nstride, int cnt, bool want_tail) {
    const int* posg = (const int*)(C.ws + WS_RT + RT_POS); const float* gate = (const float*)(C.ws + WS_RT + RT_GATE);
    int p0v = 0, p1v = 0; float g0v = 0.f, g1v = 0.f; bool sel = false;
    if (C.lane < cnt) { const int n = nbase + C.lane * nstride; p0v = posg[2 * n]; p1v = posg[2 * n + 1]; g0v = gate[2 * n]; g1v = gate[2 * n + 1]; sel = ((p0v >= FIN_TAILROW) || (p1v >= FIN_TAILROW)) == want_tail; }
    unsigned long long todo = __ballot(sel);
    f32x4 fnv[4];
#pragma unroll
    for (int j = 0; j < 4; ++j) fnv[j] = ((const f32x4*)C.in[24])[C.lane + 64 * j];
    if (want_tail) {
        while (todo) { const int k = __builtin_ctzll(todo); todo &= todo - 1;
            fin_tail_token(C, nbase + k * nstride, __builtin_amdgcn_readlane(p0v, k), __builtin_amdgcn_readlane(p1v, k),
                           __builtin_bit_cast(float, __builtin_amdgcn_readlane(__builtin_bit_cast(int, g0v), k)), __builtin_bit_cast(float, __builtin_amdgcn_readlane(__builtin_bit_cast(int, g1v), k))); }
        return;
    }
    while (todo) {
        const int k0 = __builtin_ctzll(todo); todo &= todo - 1;
        const int n0 = nbase + k0 * nstride; const int a0 = __builtin_amdgcn_readlane(p0v, k0), b0 = __builtin_amdgcn_readlane(p1v, k0);
        const float ga0 = __builtin_bit_cast(float, __builtin_amdgcn_readlane(__builtin_bit_cast(int, g0v), k0)), gb0 = __builtin_bit_cast(float, __builtin_amdgcn_readlane(__builtin_bit_cast(int, g1v), k0));
        FinTok t0; fin_load(C, t0, n0, a0, b0);
        if (todo) {
            const int k1 = __builtin_ctzll(todo); todo &= todo - 1;
            const int n1 = nbase + k1 * nstride; const int a1 = __builtin_amdgcn_readlane(p0v, k1), b1 = __builtin_amdgcn_readlane(p1v, k1);
            const float ga1 = __builtin_bit_cast(float, __builtin_amdgcn_readlane(__builtin_bit_cast(int, g0v), k1)), gb1 = __builtin_bit_cast(float, __builtin_amdgcn_readlane(__builtin_bit_cast(int, g1v), k1));
            FinTok t1; fin_load(C, t1, n1, a1, b1);
            fin_finish(C, t0, n0, ga0, gb0, fnv); fin_finish(C, t1, n1, ga1, gb1, fnv);
        } else fin_finish(C, t0, n0, ga0, gb0, fnv);
    }
}
__device__ __forceinline__ void final_steal(const Ctx& C) {
    LAS int* sh = (LAS int*)(C.lds + 130048);
    unsigned* ctr = (unsigned*)(C.ws + WS_CTL) + CW_FINAL;
    for (;;) {
        __syncthreads();
        if (C.tid == 0) sh[0] = (int)__hip_atomic_fetch_add(ctr, 1u, __ATOMIC_RELAXED, __HIP_MEMORY_SCOPE_AGENT);
        __syncthreads();
        const int blk = sh[0];
        if (blk >= NLAT / FIN_BLK) break;
        final_tokens(C, blk * FIN_BLK + C.wave * (FIN_BLK / NWAVES), 1, FIN_BLK / NWAVES, false);
    }
    __syncthreads();
}
__device__ __forceinline__ void phase_final(const Ctx& C) {
    final_steal(C);
    const int gw = C.vcu * NWAVES + C.wave, NGW = C.G * NWAVES;
    final_tokens(C, gw, NGW, NLAT / NGW, true);
}
#ifndef MK_SPLIT
#define MK_SPLIT 0
#endif
constexpr int N_PHASES = 31;
#define GP_ALIGN true
#define GP_SP2 true


#ifndef PH_MASK
#define PH_MASK 0x7fffffffu
#endif
#define IN(k) (((PH_MASK >> (k)) & 1u) && lo <= (k) && (k) < hi)
#define SEAM(k) do { if (IN(k) && IN((k) + 1)) xcd_barrier(bar); } while (0)
#ifndef PH_REP
#define PH_REP 0u
#endif
#ifndef PH_URE
#define PH_URE 0u
#endif
#define UREP(k) (1 + (int)((PH_URE >> (k)) & 1u))
#define REPEAT(k) for (int rep_ = 0; rep_ < 1 + (int)((PH_REP >> (k)) & 1u); ++rep_)
#ifndef MK_STEAL
#define MK_STEAL 1
#endif
#define STEAL(k) do { if (MK_STEAL) moe_convert_steal(C, (unsigned*)(C.ws + WS_CTL) + CW_STEAL, (unsigned*)(C.ws + WS_CTL) + CW_DONE + 64 * (k), (int)C.G, true); } while (0)
template <int L>
__device__ __forceinline__ void layer_phases(const Ctx& C0, const Args& args, const XcdBarrier& bar, const int lo, const int hi) {
    Ctx C = C0; asm volatile("" : "+v"(C.tid), "+v"(C.lane));
    unsigned char* ws = C.ws;
    float* xc = (float*)(ws + WS_XC);
    bf16* Hb = (bf16*)(ws + WS_H);
    const float* modall = (const float*)(ws + WS_MOD);
        const int pb = 1 + 10 * L;
        const float* xlat = (L == 0) ? args.in[0] : (const float*)args.out;
        const float* xctx = (L == 0) ? args.in[2] : (const float*)xc;
        const float* modL = modall + (size_t)L * 9 * 6144;
        if (IN(pb + 0)) { REPEAT(pb + 0) phase_norm(C, L, 0, xlat, xctx, Hb, 0, L == 1 ? (const float*)(ws + WS_PART) : nullptr, L == 1 ? (const bf16*)(ws + WS_D2) : nullptr, L == 1 ? args.out : nullptr, L == 1); SEAM(pb + 0); }
        if (IN(pb + 1)) {
            LAS float* tab64 = (LAS float*)(C.lds + LDSCTL_OFF + 1024); LAS float* tab32 = tab64 + 2048;
            build_rope_tables(C, tab64, tab32);
            pg8::Gemm g{(const pg8::bf16_t*)Hb, (const pg8::bf16_t*)(ws + WS_WIN) + (size_t)L * NPROJ * DM, MROWS, NPROJ, DM};
            TileSched S; S.init(MROWS / 256, NPROJ / 256, C.G, C.wg, 0, UREP(pb + 1));
            EpiProj E{(pg8::bf16_t*)(ws + WS_QA), ws + WS_KA, ws + WS_VA, (pg8::bf16_t*)(ws + WS_QC), ws + WS_KC, ws + WS_VC, (pg8::bf16_t*)(ws + WS_CQKV), ws + WS_KB, (float*)(ws + WS_SSQ), (float*)(ws + WS_SSK),
                      args.in[9] + L * 64, args.in[10] + L * 64, tab64, tab32};
            REPEAT(pb + 1) pg8::gemm_phase<EpiProj, TileSched, GP_ALIGN, GP_SP2>(C.lds, g, S, E);
            STEAL(pb + 1);
            if (IN(pb + 1) && IN(pb + 3)) xcd_barrier(bar);
        }
        if (IN(pb + 3)) {
            int kub = 384; asm volatile("" : "+s"(kub));
            int kwin = 256; asm volatile("" : "+s"(kwin));
            pg8::Gemm g{(const pg8::bf16_t*)(ws + WS_CQKV), (const pg8::bf16_t*)(ws + WS_WUB) + (size_t)L * 1024 * 384, MROWS, 1024, kub, kwin, 0, 0, 256};
            UpBSched S; S.T.init(MROWS / 256, 4, C.G, C.wg, 0, UREP(pb + 3));
            EpiUpB E{(pg8::bf16_t*)(ws + WS_QB), ws + WS_KB, ws + WS_VB, (const float*)(ws + WS_SSQ), (const float*)(ws + WS_SSK)};
            REPEAT(pb + 3) pg8::gemm_phase<EpiUpB, UpBSched, GP_ALIGN, GP_SP2, false, true>(C.lds, g, S, E);
            STEAL(pb + 3);
            if (IN(pb + 3) && IN(pb + 5)) xcd_barrier(bar);
        }
        if (IN(pb + 5)) { REPEAT(pb + 5) phase_attn(C, L); SEAM(pb + 5); }
        if (IN(pb + 6)) {
            pg8::Gemm g{(const pg8::bf16_t*)Hb, (const pg8::bf16_t*)(ws + WS_WOUT) + (size_t)L * DM * DM, MROWS, DM, DM};
            TileSched S; S.init(NLAT / 256, 4, C.G, C.wg, 1, L == 0 ? UREP(7) : 1);
            {
                EpiGateBf16 E{(pg8::bf16_t*)(ws + (L == 0 ? WS_D0 : WS_D1)), modL + 2048, 1.0f};
                REPEAT(pb + 6) pg8::gemm_phase<EpiGateBf16, TileSched, GP_ALIGN, GP_SP2>(C.lds, g, S, E); }
            if (L == 0) {
                pg8::Gemm g2{(const pg8::bf16_t*)Hb, (const pg8::bf16_t*)(ws + WS_WOUT), MROWS, DM, DM, DM / 2};
                CtxSplitSched S2{C.wg};
                EpiResidPart E2{xctx, nullptr, xc, (float*)(ws + WS_PART2), modL + 2048, 1.0f};
                pg8::gemm_phase<EpiResidPart, CtxSplitSched, GP_ALIGN, GP_SP2, false, true>(C.lds, g2, S2, E2);
                STEAL(pb + 6);
            }
            SEAM(pb + 6);
        }
        if (L == 0) {
            if (IN(8)) { REPEAT(8) phase_norm(C, 0, 1, args.in[0], xc, Hb, DENSE_F8 | DENSE_F8_UP, (const float*)(ws + WS_PART2), (const bf16*)(ws + WS_D0), args.out); SEAM(8); }
            if (IN(9)) {
                constexpr bool F8D = (DENSE_F8 | DENSE_F8_DN) != 0, F8IN = (DENSE_F8 | DENSE_F8_UP) != 0;
                pg8::Gemm g{(const pg8::bf16_t*)Hb, (const pg8::bf16_t*)(ws + WS_WUP), MROWS, 2 * FFD, F8IN ? DM / 2 : DM};
                TileSched S; S.init(MROWS / 256, 2 * FFD / 256, C.G, C.wg, 0, UREP(9));
                EpiSwiglu<F8D> E{(void*)(ws + WS_U), FFD, 2 * FFD / 256, 0, F8IN ? 1.0f / (F8_SA * F8_SW) : 1.0f, F8_SU};
                REPEAT(9) pg8::gemm_phase<EpiSwiglu<F8D>, TileSched, GP_ALIGN, GP_SP2, F8IN>(C.lds, g, S, E);
                STEAL(9);
                SEAM(9);
            }
            if (IN(10)) {
                constexpr bool F8D = (DENSE_F8 | DENSE_F8_DN) != 0;
                pg8::Gemm g{(const pg8::bf16_t*)(ws + WS_U), (const pg8::bf16_t*)(ws + WS_WDN), MROWS, DM, F8D ? FFD / 2 : FFD};
                EpiGateBf16 E{(pg8::bf16_t*)(ws + WS_D2), modL + 5120, F8D ? 1.0f / (F8_SU * F8_SW) : 1.0f};
                TileSched S; S.init(NLAT / 256, 4, C.G, C.wg, 1);
                REPEAT(10) pg8::gemm_phase<EpiGateBf16, TileSched, GP_ALIGN, GP_SP2, F8D>(C.lds, g, S, E);
                {
                    pg8::Gemm g2{(const pg8::bf16_t*)(ws + WS_U), (const pg8::bf16_t*)(ws + WS_WDN), MROWS, DM, F8D ? FFD / 2 : FFD, F8D ? 768 : FFD / 2, F8D ? FFD / 2 - 768 : 0, 2};
                    CtxSplitSched S2{C.wg};
                    EpiResidPart E2{xc, (const float*)(ws + WS_PART2), xc, (float*)(ws + WS_PART), modL + 5120, F8D ? 1.0f / (F8_SU * F8_SW) : 1.0f};
                    pg8::gemm_phase<EpiResidPart, CtxSplitSched, GP_ALIGN, GP_SP2, F8D, true>(C.lds, g2, S2, E2);
                }
                STEAL(10);
                SEAM(10);
            }
        }
    }

__global__ void __launch_bounds__(NWAVES * 64, 2) mk_fwd(Args args) {
    extern __shared__ __attribute__((aligned(16))) unsigned char lds_raw[];
    Ctx C;
    C.lds = (LAS unsigned char*)lds_raw;
    C.tid = threadIdx.x; C.lane = C.tid & 63; C.wave = __builtin_amdgcn_readfirstlane(C.tid >> 6);
    C.G = gridDim.x; C.wg = blockIdx.x; { const int bx = blockIdx.x; C.vcu = (C.G % 8 == 0) ? (bx % 8) * (C.G / 8) + bx / 8 : bx; }
    C.in = args.in; C.out = args.out; C.ws = args.ws;
    volatile LAS unsigned* MISC = (volatile LAS unsigned*)(C.lds + MISC_OFF);
    for (int u = C.tid; u < (LDS_BYTES - LDSCTL_OFF) / 4; u += NWAVES * 64) ((LAS unsigned*)(C.lds + LDSCTL_OFF))[u] = 0u;
    __syncthreads();
    unsigned* ctl = (unsigned*)(C.ws + WS_CTL);
    XcdBarrier bar = xcd_barrier_post(ctl + CW_BAR, MISC + 8);
    const int lo = args.ph_lo, hi = args.ph_hi;
    unsigned char* ws = C.ws;
    float* xc = (float*)(ws + WS_XC);
    bf16* Hb = (bf16*)(ws + WS_H);
    const float* modall = (const float*)(ws + WS_MOD);

    if (IN(0)) { REPEAT(0) { phase_prologue(C); __syncthreads(); } SEAM(0); }

    layer_phases<0>(C, args, bar, lo, hi);
    layer_phases<1>(C, args, bar, lo, hi);
    Ctx Cr = C; asm volatile("" : "+v"(Cr.tid), "+v"(Cr.lane));
    if (IN(18)) { REPEAT(18) { phase_route1(Cr); __syncthreads(); } SEAM(18); }
    if (IN(19)) { REPEAT(19) { phase_route2(Cr); __syncthreads(); } SEAM(19); }
    {
        const int* tile_e = (const int*)(ws + WS_RT + RT_TILEE);
        for (int ch = 0; ch < MOE_NCH - 1; ++ch) {
            const int pu = 20 + 2 * ch;
            int ntiles = 0;
            if (IN(pu) || IN(pu + 1)) ntiles = __builtin_amdgcn_readfirstlane(__hip_atomic_load(tile_e + 272, __ATOMIC_RELAXED, __HIP_MEMORY_SCOPE_AGENT));
            int ntc = ntiles - MOE_CH * ch; ntc = ntc < 0 ? 0 : (ntc > MOE_CH ? MOE_CH : ntc);
            if (IN(pu)) {
                pg8::Gemm g{(const pg8::bf16_t*)(ws + WS_HFS), (const pg8::bf16_t*)(ws + WS_WMUP), MOE_MAXT * 256, NEXP * 2 * FFE, DM / 2};
                MoeSched S{tile_e, MOE_CH * ch, ntc, 2 * FFE / 256, C.G, C.wg, 1};
                EpiSwiglu<true> E{(void*)(ws + ((ch & 1) ? WS_UM2 : WS_UM)), FFE, 2 * FFE / 256, -MOE_CH * ch, 1.0f / (F8_SA * F8_SW), F8_SU};
                REPEAT(pu) pg8::gemm_phase<EpiSwiglu<true>, MoeSched, GP_ALIGN, GP_SP2, true>(C.lds, g, S, E);
                SEAM(pu);
            }
            if (IN(pu + 1)) {
                pg8::Gemm g{(const pg8::bf16_t*)(ws + ((ch & 1) ? WS_UM2 : WS_UM)), (const pg8::bf16_t*)(ws + WS_WMDN), MOE_CH * 256, NEXP * DM, FFE / 2};
                MoeSched S{tile_e, MOE_CH * ch, ntc, 4, C.G, C.wg, 0};
                EpiStoreBf16 E{(pg8::bf16_t*)(ws + WS_Y), DM, 4, MOE_CH * ch, 1.0f / (F8_SU * F8_SW)};
                REPEAT(pu + 1) pg8::gemm_phase<EpiStoreBf16, MoeSched, GP_ALIGN, GP_SP2, true>(C.lds, g, S, E);
                if (ch == MOE_NCH - 2 || MK_SPLIT) SEAM(pu + 1);
            }
        }
        {
            constexpr int ch = MOE_NCH - 1, pu = 20 + 2 * ch;
            int ntiles = 0;
            if (IN(pu) || IN(pu + 1)) ntiles = __builtin_amdgcn_readfirstlane(__hip_atomic_load(tile_e + 272, __ATOMIC_RELAXED, __HIP_MEMORY_SCOPE_AGENT));
            int ntc = ntiles - MOE_CH * ch; ntc = ntc < 0 ? 0 : (ntc > 8 ? 8 : ntc);
            if (IN(pu)) {
                pg8::Gemm g{(const pg8::bf16_t*)(ws + WS_HFS), (const pg8::bf16_t*)(ws + WS_WMUP), MOE_MAXT * 256, NEXP * 2 * FFE, DM / 2};
                MoeSched S{tile_e, MOE_CH * ch, ntc, 2 * FFE / 256, C.G, C.wg, 1};
                EpiSwiglu<true> E{(void*)(ws + WS_UM), FFE, 2 * FFE / 256, -MOE_CH * ch, 1.0f / (F8_SA * F8_SW), F8_SU};
                pg8::gemm_phase<EpiSwiglu<true>, MoeSched, GP_ALIGN, GP_SP2, true>(C.lds, g, S, E);
                final_steal(Cr);
                SEAM(pu);
            }
            if (IN(pu + 1)) {
                pg8::Gemm gt{(const pg8::bf16_t*)(ws + WS_UM), (const pg8::bf16_t*)(ws + WS_WMDN), MOE_CH * 256, NEXP * DM, FFE / 2, FFE / 2 / MOE_TAILK};
                MoeTailSched S{tile_e, MOE_CH * ch, ntc, C.G, C.wg};
                EpiStoreBf16K E{(pg8::bf16_t*)(ws + WS_YT), DM, 1.0f / (F8_SU * F8_SW)};
                pg8::gemm_phase<EpiStoreBf16K, MoeTailSched, GP_ALIGN, GP_SP2, true, true>(C.lds, gt, S, E);
                final_steal(Cr);
                SEAM(pu + 1);
            }
        }
    }
    if (IN(30)) { phase_final(Cr); }
#undef IN
#undef SEAM
}

extern "C" void kernel_launch(void* const* d_in, const int* in_sizes, int n_in, void* d_out, int out_size, void* d_ws, size_t ws_size, hipStream_t stream) {
    static int grid = 0;
    if (grid == 0) {
        if (n_in != 25 || in_sizes[0] != NLAT * DM || out_size != NLAT * DM || ws_size < WS_END) { fprintf(stderr, "kernel_launch: unexpected shapes (n_in %d, in0 %d, out %d, ws %zu < %zu)\n", n_in, n_in > 0 ? in_sizes[0] : -1, out_size, ws_size, (size_t)WS_END); grid = -1; return; }
        int dev = 0, cus = 0, per_cu = 0;
        if (hipGetDevice(&dev) != hipSuccess || hipDeviceGetAttribute(&cus, hipDeviceAttributeMultiprocessorCount, dev) != hipSuccess) { grid = -1; return; }
        if (hipFuncSetAttribute((const void*)mk_fwd, hipFuncAttributeMaxDynamicSharedMemorySize, LDS_BYTES) != hipSuccess) { fprintf(stderr, "kernel_launch: hipFuncSetAttribute failed\n"); grid = -1; return; }
        if (hipOccupancyMaxActiveBlocksPerMultiprocessor(&per_cu, (const void*)mk_fwd, NWAVES * 64, LDS_BYTES) != hipSuccess || per_cu < 1) fprintf(stderr, "kernel_launch: occupancy query reports %d\n", per_cu);
        (void)hipGetLastError();
        grid = 256;
        if (cus < 256) { fprintf(stderr, "kernel_launch: %d CUs < 256\n", cus); grid = -1; return; }
    }
    if (grid < 0) return;
    if (hipMemsetAsync((char*)d_ws, 0, ZERO_BYTES, stream) != hipSuccess) return;
    Args a{};
    for (int i = 0; i < 25; ++i) a.in[i] = (const float*)d_in[i];
    a.out = (float*)d_out; a.ws = (unsigned char*)d_ws;
#if MK_SPLIT
    for (int p = 0; p < N_PHASES; ++p) { a.ph_lo = p; a.ph_hi = p + 1; hipLaunchKernelGGL(mk_fwd, dim3(grid), dim3(NWAVES * 64), LDS_BYTES, stream, a); }
#else
    a.ph_lo = 0; a.ph_hi = N_PHASES;
    hipLaunchKernelGGL(mk_fwd, dim3(grid), dim3(NWAVES * 64), LDS_BYTES, stream, a);
#endif
}
```

```cpp
#include <hip/hip_runtime.h>
#include <cstdio>
#include <cstdint>
namespace pg8 {
#define PG8_LAS __attribute__((address_space(3)))
typedef unsigned short bf16_t;
typedef short bf16x8 __attribute__((ext_vector_type(8)));
typedef float f32x4 __attribute__((ext_vector_type(4)));
typedef unsigned u32x4 __attribute__((ext_vector_type(4)));
constexpr int BM = 256, BK = 64, HALF = 128, HTB = HALF * BK * 2  , STAGE_BYTES = 8 * HTB, NXCD = 8, WGM = 8;

__host__ __device__ __forceinline__ int lds_byte(int r, int c) { const int st = (r >> 4) * 2 + (c >> 5), rr = r & 15, cc = c & 31, ob = rr * 64 + cc * 2; return st * 1024 + (ob ^ (((ob >> 9) & 1) << 5)); }
__host__ __device__ __forceinline__ void stage_rc(int b, int& R, int& C) { const int st = b / 1024, sb = b % 1024, swz = sb ^ (((sb >> 9) & 1) << 5); R = (st >> 1) * 16 + swz / 64; C = (st & 1) * 32 + (swz % 64) / 2; }
__host__ __device__ __forceinline__ int perm32(int rho) { const int n = rho >> 4, i = rho & 15; return 8 * (i >> 2) + 4 * n + (i & 3); }

struct Unit { int pm, pn, ks; };
struct Gemm { const bf16_t* A; const bf16_t* Bt; int M, N, K; int KL = 0, KLL = 0, NKS = 0, KO1 = -1; };

struct StaticOrder {
    int nM, nN, nwg, G, c;
    __host__ __device__ void init(int M, int N, int G_, int c_) { nM = M / BM; nN = N / BM; nwg = nM * nN; G = G_; c = c_; }
    __host__ __device__ bool next(int i, Unit& u) const {
        const long L = (long)i * G + c; if (L >= nwg) return false;
        int wgid = (int)L; { const int q = nwg / NXCD, r = nwg % NXCD, xcd = wgid % NXCD, off = wgid / NXCD; wgid = (xcd < r ? xcd * (q + 1) : r * (q + 1) + (xcd - r) * q) + off; }
        const int nig = WGM * nN, gid = wgid / nig, fm = gid * WGM, gsz = (nM - fm) < WGM ? (nM - fm) : WGM;
        u.pm = fm + ((wgid % nig) % gsz); u.pn = (wgid % nig) / gsz; return true;
    }
    __device__ __forceinline__ void a_ready(const Unit&) const {}
    __device__ __forceinline__ void done(const Unit&) const {}
};

__device__ __forceinline__ unsigned cvt_pk_bf16(float lo, float hi) { unsigned r; asm volatile("v_cvt_pk_bf16_f32 %0, %1, %2" : "=v"(r) : "v"(lo), "v"(hi)); return r; }
typedef float f32x2 __attribute__((ext_vector_type(2)));
typedef int i32x4_t __attribute__((ext_vector_type(4))); typedef int i32x8_t __attribute__((ext_vector_type(8)));
__device__ __forceinline__ i32x8_t cat8(bf16x8 a, bf16x8 b) { return __builtin_shufflevector(__builtin_bit_cast(i32x4_t, a), __builtin_bit_cast(i32x4_t, b), 0, 1, 2, 3, 4, 5, 6, 7); }
template <class Epi, class Sched, bool ALIGN_EPI = false, bool SP2 = false, bool F8 = false, bool KSPLIT = false>
__device__ __forceinline__ void gemm_phase(PG8_LAS unsigned char* lds, const Gemm g, const Sched& S, const Epi& E) {
    const int tid = threadIdx.x, wid = __builtin_amdgcn_readfirstlane(tid >> 6), lane = tid & 63, wr = wid >> 2, wc = wid & 3, fr = lane & 15, fq = lane >> 4;
    const int K = g.K; int nt = (KSPLIT ? g.KL : K) / BK;
    const size_t ksb = KSPLIT ? (size_t)g.KL * 2 : 0;
    unsigned voffA[2], voffB[2];
#pragma unroll
    for (int i = 0; i < 2; ++i) { int R, C; stage_rc(tid * 16 + i * 8192, R, C); const int Rb = Epi::PERM ? ((R & ~31) + perm32(R & 31)) : R;
        voffA[i] = (unsigned)(R * K + C) * 2u; voffB[i] = (unsigned)(Rb * K + C) * 2u; }
    const size_t kstep = (size_t)(BK * 2);
    const size_t hstep = (size_t)HALF * K * 2;
    const size_t tstep = 2 * hstep;
    const unsigned ldsw = (unsigned)wid * 1024u;
    const int aoff = lds_byte(wr * 64 + fr, fq * 8), boff = lds_byte(wc * 32 + fr, fq * 8);
#define PG8_SA(b, h) (((b) * 2 + (h)) * HTB)
#define PG8_SB(b, h) ((4 + (b) * 2 + (h)) * HTB)
#define PG8_STAGE(bufoff, gbase, voff) do { _Pragma("unroll") for (int _i = 0; _i < 2; ++_i) \
        __builtin_amdgcn_global_load_lds((const unsigned*)((const char*)(gbase) + (voff)[_i]), (PG8_LAS unsigned*)(lds + (bufoff) + ldsw + _i * 8192), 16, 0, 0); } while (0)
#define PG8_LDA(dst, b, h) do { if constexpr (F8) { _Pragma("unroll") for (int m = 0; m < 4; ++m) dst##8[m] = cat8(*(const PG8_LAS bf16x8*)(lds + PG8_SA(b, h) + aoff + m * 2048), *(const PG8_LAS bf16x8*)(lds + PG8_SA(b, h) + aoff + m * 2048 + 1024)); } else { \
        _Pragma("unroll") for (int m = 0; m < 4; ++m) _Pragma("unroll") for (int k = 0; k < 2; ++k) dst[m][k] = *(const PG8_LAS bf16x8*)(lds + PG8_SA(b, h) + aoff + m * 2048 + k * 1024); } } while (0)
#define PG8_LDB(dst, b, h) do { if constexpr (F8) { _Pragma("unroll") for (int n = 0; n < 2; ++n) dst##8[n] = cat8(*(const PG8_LAS bf16x8*)(lds + PG8_SB(b, h) + boff + n * 2048), *(const PG8_LAS bf16x8*)(lds + PG8_SB(b, h) + boff + n * 2048 + 1024)); } else { \
        _Pragma("unroll") for (int n = 0; n < 2; ++n) _Pragma("unroll") for (int k = 0; k < 2; ++k) dst[n][k] = *(const PG8_LAS bf16x8*)(lds + PG8_SB(b, h) + boff + n * 2048 + k * 1024); } } while (0)
#define PG8_MMA(ai, bj, At, Bt) do { __builtin_amdgcn_s_setprio(1); if constexpr (F8) { _Pragma("unroll") for (int m = 0; m < 4; ++m) _Pragma("unroll") for (int n = 0; n < 2; ++n) \
        asm volatile("v_mfma_f32_16x16x128_f8f6f4 %0, %1, %2, %0" : "+v"(acc[ai][bj][m][n]) : "v"(Bt##8[n]), "v"(At##8[m])); } else { \
        _Pragma("unroll") for (int m = 0; m < 4; ++m) _Pragma("unroll") for (int n = 0; n < 2; ++n) _Pragma("unroll") for (int k = 0; k < 2; ++k) \
        acc[ai][bj][m][n] = __builtin_amdgcn_mfma_f32_16x16x32_bf16(Bt[n][k], At[m][k], acc[ai][bj][m][n], 0, 0, 0); } __builtin_amdgcn_s_setprio(0); } while (0)
#define PG8_WAIT_V(n) asm volatile("s_waitcnt vmcnt(" #n ")" ::: "memory")
#define PG8_WAIT_L(n) asm volatile("s_waitcnt lgkmcnt(" #n ")" ::: "memory")
#define PG8_BAR __builtin_amdgcn_s_barrier()
#define PG8_SCHED __builtin_amdgcn_sched_barrier(0)
    Unit cur, nxt; int ui = 0;
    if (!S.next(0, cur)) return;
    f32x4 acc[2][2][4][2];
#pragma unroll
    for (int a = 0; a < 2; ++a)
#pragma unroll
        for (int b = 0; b < 2; ++b)
#pragma unroll
            for (int m = 0; m < 4; ++m)
#pragma unroll
                for (int n = 0; n < 2; ++n) acc[a][b][m][n] = (f32x4){0.f, 0.f, 0.f, 0.f};
    bf16x8 At[4][2], B0[2][2], B1[2][2]; i32x8_t At8[4], B08[2], B18[2];
    const char* cA = (const char*)g.A + (size_t)cur.pm * tstep; const char* cB = (const char*)g.Bt + (size_t)cur.pn * tstep;
    if constexpr (KSPLIT) { const size_t ko = (g.KO1 >= 0) ? (cur.ks ? (size_t)g.KO1 : 0) : (size_t)cur.ks * ksb; cA += ko; cB += ko; if (g.KLL && cur.ks == g.NKS - 1) nt = g.KLL / BK; }
    S.a_ready(cur);
    if constexpr (SP2) {
        PG8_STAGE(PG8_SB(0, 0), cB, voffB); PG8_STAGE(PG8_SB(0, 1), cB + hstep, voffB); PG8_STAGE(PG8_SA(0, 0), cA, voffA); PG8_STAGE(PG8_SA(0, 1), cA + hstep, voffA);
        if (wr == 1) PG8_BAR;
        PG8_WAIT_V(2); PG8_BAR;
        PG8_STAGE(PG8_SB(1, 0), cB + kstep, voffB); PG8_STAGE(PG8_SA(1, 0), cA + kstep, voffA); PG8_STAGE(PG8_SB(1, 1), cB + hstep + kstep, voffB);
        PG8_WAIT_V(6); PG8_BAR;
    } else {
        PG8_STAGE(PG8_SB(0, 0), cB, voffB); PG8_STAGE(PG8_SA(0, 0), cA, voffA); PG8_STAGE(PG8_SB(0, 1), cB + hstep, voffB); PG8_STAGE(PG8_SA(0, 1), cA + hstep, voffA);
        if (wr == 1) PG8_BAR;
        PG8_WAIT_V(4); PG8_BAR;
        PG8_STAGE(PG8_SB(1, 0), cB + kstep, voffB); PG8_STAGE(PG8_SA(1, 0), cA + kstep, voffA); PG8_STAGE(PG8_SB(1, 1), cB + hstep + kstep, voffB);
        PG8_WAIT_V(6); PG8_BAR;
    }
    for (;;) {
        const bool has_next = S.next(ui + 1, nxt);
        const size_t nko = KSPLIT ? ((g.KO1 >= 0) ? (nxt.ks ? (size_t)g.KO1 : 0) : (size_t)nxt.ks * ksb) : 0;
        const char* nA = has_next ? (const char*)g.A + (size_t)nxt.pm * tstep + nko : cA; const char* nB = has_next ? (const char*)g.Bt + (size_t)nxt.pn * tstep + nko : cB;
        for (int t = 0; t < nt; t += 2) {
            const bool last = (t == nt - 2);
            const char* a1 = cA + (size_t)(t + 1) * kstep;
            const char* a2 = last ? nA : cA + (size_t)(t + 2) * kstep; const char* b2 = last ? nB : cB + (size_t)(t + 2) * kstep;
            const char* a3 = a2 + kstep; const char* b3 = b2 + kstep;
            if (last && has_next) S.a_ready(nxt);
            if constexpr (SP2) {
            PG8_LDB(B0, 0, 0); PG8_LDB(B1, 0, 1); PG8_SCHED; PG8_LDA(At, 0, 0); PG8_STAGE(PG8_SA(1, 1), a1 + hstep, voffA);
            PG8_WAIT_V(8); PG8_WAIT_L(0); PG8_BAR; PG8_MMA(0, 0, At, B0); PG8_MMA(0, 1, At, B1); PG8_BAR; PG8_SCHED;
            PG8_LDA(At, 0, 1); PG8_STAGE(PG8_SB(0, 0), b2, voffB); PG8_STAGE(PG8_SB(0, 1), b2 + hstep, voffB); PG8_STAGE(PG8_SA(0, 0), a2, voffA);
            PG8_WAIT_V(8); PG8_WAIT_L(0); PG8_BAR; PG8_MMA(1, 0, At, B0); PG8_MMA(1, 1, At, B1); PG8_BAR; PG8_SCHED;
            PG8_LDB(B0, 1, 0); PG8_LDB(B1, 1, 1); PG8_SCHED; PG8_LDA(At, 1, 0); PG8_STAGE(PG8_SA(0, 1), a2 + hstep, voffA);
            PG8_WAIT_V(8); PG8_WAIT_L(0); PG8_BAR; PG8_MMA(0, 0, At, B0); PG8_MMA(0, 1, At, B1); PG8_BAR; PG8_SCHED;
            PG8_LDA(At, 1, 1); PG8_STAGE(PG8_SB(1, 0), b3, voffB); PG8_STAGE(PG8_SB(1, 1), b3 + hstep, voffB); PG8_STAGE(PG8_SA(1, 0), a3, voffA);
            PG8_WAIT_V(8); PG8_WAIT_L(0); PG8_BAR; PG8_MMA(1, 0, At, B0); PG8_MMA(1, 1, At, B1); PG8_BAR; PG8_SCHED;
            } else {
            PG8_LDB(B0, 0, 0); PG8_SCHED; PG8_LDA(At, 0, 0); PG8_STAGE(PG8_SA(1, 1), a1 + hstep, voffA);
            PG8_WAIT_L(8); PG8_BAR; PG8_WAIT_L(0); PG8_MMA(0, 0, At, B0); PG8_BAR; PG8_SCHED;
            PG8_LDB(B1, 0, 1); PG8_STAGE(PG8_SB(0, 0), b2, voffB);
            PG8_BAR; PG8_WAIT_L(0); PG8_MMA(0, 1, At, B1); PG8_BAR;
            PG8_LDA(At, 0, 1); PG8_STAGE(PG8_SA(0, 0), a2, voffA);
            PG8_BAR; PG8_WAIT_L(0); PG8_MMA(1, 0, At, B0); PG8_BAR; PG8_SCHED;
            PG8_STAGE(PG8_SB(0, 1), b2 + hstep, voffB);
            PG8_WAIT_V(6); PG8_BAR; PG8_MMA(1, 1, At, B1); PG8_BAR;
            PG8_LDB(B0, 1, 0); PG8_SCHED; PG8_LDA(At, 1, 0); PG8_STAGE(PG8_SA(0, 1), a2 + hstep, voffA);
            PG8_WAIT_L(8); PG8_BAR; PG8_WAIT_L(0); PG8_MMA(0, 0, At, B0); PG8_BAR; PG8_SCHED;
            PG8_LDB(B1, 1, 1); PG8_STAGE(PG8_SB(1, 0), b3, voffB);
            PG8_BAR; PG8_WAIT_L(0); PG8_MMA(0, 1, At, B1); PG8_BAR;
            PG8_LDA(At, 1, 1); PG8_STAGE(PG8_SA(1, 0), a3, voffA);
            PG8_BAR; PG8_WAIT_L(0); PG8_MMA(1, 0, At, B0); PG8_BAR; PG8_SCHED;
            PG8_STAGE(PG8_SB(1, 1), b3 + hstep, voffB);
            PG8_WAIT_V(6); PG8_BAR; PG8_MMA(1, 1, At, B1); PG8_BAR;
            }
        }
        if constexpr (F8) { asm volatile("s_nop 15\n\ts_nop 15" ::: "memory"); __builtin_amdgcn_sched_barrier(0); }
        if constexpr (ALIGN_EPI) { if (wr == 0) PG8_BAR; }
        if constexpr (!Epi::AFTER_DRAIN) { E(acc, cur, wr, wc, fr, fq); S.done(cur); }
        if (!has_next) break;
#pragma unroll
        for (int a = 0; a < 2; ++a)
#pragma unroll
            for (int b = 0; b < 2; ++b)
#pragma unroll
                for (int m = 0; m < 4; ++m)
#pragma unroll
                    for (int n = 0; n < 2; ++n) acc[a][b][m][n] = (f32x4){0.f, 0.f, 0.f, 0.f};
        cur = nxt; cA = nA; cB = nB; ++ui;
        if constexpr (KSPLIT) nt = ((g.KLL && cur.ks == g.NKS - 1) ? g.KLL : g.KL) / BK;
        if constexpr (ALIGN_EPI) { if (wr == 1) PG8_BAR; }
    }
    PG8_WAIT_V(0);
    if constexpr (!ALIGN_EPI) { if (wr == 0) PG8_BAR; }
    PG8_BAR;
    if constexpr (Epi::AFTER_DRAIN) { E.fused(acc, cur, wr, wc, fr, fq, lds, wid, lane); S.done(cur); }
#undef PG8_SA
#undef PG8_SB
#undef PG8_STAGE
#undef PG8_LDA
#undef PG8_LDB
#undef PG8_MMA
#undef PG8_WAIT_V
#undef PG8_WAIT_L
#undef PG8_BAR
#undef PG8_SCHED
}
}
#define GAS __attribute__((address_space(1)))
#define LAS __attribute__((address_space(3)))
typedef unsigned short bf16;
typedef unsigned v4u __attribute__((ext_vector_type(4)));
typedef float f32x4 __attribute__((ext_vector_type(4)));
typedef short bf16x8 __attribute__((ext_vector_type(8)));
typedef GAS unsigned gu32;
typedef GAS unsigned long long gu64;
#define RLX_AGENT __ATOMIC_RELAXED, __HIP_MEMORY_SCOPE_AGENT
#define LDS_WAIT() asm volatile("s_waitcnt lgkmcnt(0)" ::: "memory")
#define VM_WAIT() asm volatile("s_waitcnt vmcnt(0)" ::: "memory")
__device__ __forceinline__ unsigned long long rt() { return __builtin_amdgcn_s_memrealtime(); }
__device__ __forceinline__ unsigned f2bf(float f) { unsigned u = __builtin_bit_cast(unsigned, f); return (u + 0x7fffu + ((u >> 16) & 1u)) >> 16; }
typedef float pk_f32x2 __attribute__((ext_vector_type(2))); typedef __bf16 pk_bf16x2 __attribute__((ext_vector_type(2)));
__device__ __forceinline__ unsigned pk2(float lo, float hi) { pk_f32x2 v = {lo, hi}; pk_bf16x2 b = __builtin_convertvector(v, pk_bf16x2); return __builtin_bit_cast(unsigned, b); }

#define XB_TMO      128
#define XB_XCNT(j)  (256  + 64 * (j))
#define XB_XSUB(j)  (1280 + 64 * (j))
#define XB_XGEN(j)  (2304 + 64 * (j))
#define XB_TOP      3328
#define XB_TOPGEN   3392
#define XCD_BAR_WORDS 3456
#define XB_SPIN_CAP (1u << 18)

__device__ __forceinline__ unsigned xb_ld(unsigned* p)              { return __hip_atomic_load(p, __ATOMIC_RELAXED, __HIP_MEMORY_SCOPE_AGENT); }
__device__ __forceinline__ unsigned xb_add(unsigned* p, unsigned v) { return __hip_atomic_fetch_add(p, v, __ATOMIC_RELAXED, __HIP_MEMORY_SCOPE_AGENT); }
__device__ __forceinline__ unsigned xb_xcc_id() { return (unsigned)__builtin_amdgcn_s_getreg((3 << 11) | 20) & 0xFu; }
#define XB_SPIN(cond, bar) do { unsigned _sp = 0; while (cond) { __builtin_amdgcn_s_sleep(1); \
    if ((++_sp & 255u) == 0u) { if (xb_ld(&(bar)[XB_TMO])) break; if (_sp > XB_SPIN_CAP) { atomicAdd(&(bar)[XB_TMO], 1u); break; } } } } while (0)

struct XcdBarrier {
    unsigned* bar; unsigned x;
    volatile LAS unsigned* st;
};

__device__ __forceinline__ XcdBarrier xcd_barrier_post(unsigned* bar, volatile LAS unsigned* st) {
    XcdBarrier b; b.bar = bar; b.x = xb_xcc_id(); b.st = st;
    if (threadIdx.x == 0) (void)xb_add(&bar[XB_XCNT(b.x)], 1u);
    return b;
}
__device__ __forceinline__ void xcd_barrier_complete(unsigned* bar, unsigned x, unsigned& nloc, unsigned& nx) {
    const unsigned G = gridDim.x * gridDim.y * gridDim.z;
    unsigned sum, cnt, mine, sp = 0u;
    for (;;) {
        sum = 0u; cnt = 0u; mine = 0u;
#pragma unroll
        for (unsigned j = 0; j < 16; ++j) { const unsigned c = xb_ld(&bar[XB_XCNT(j)]); sum += c; cnt += (c > 0u) ? 1u : 0u; mine = (j == x) ? c : mine; }
        if (sum == G) break;
        __builtin_amdgcn_s_sleep(1);
        if ((++sp & 255u) == 0u) { if (xb_ld(&bar[XB_TMO])) break; if (sp > XB_SPIN_CAP) { atomicAdd(&bar[XB_TMO], 1u); break; } }
    }
    nloc = mine > 0u ? mine : 1u; nx = cnt > 0u ? cnt : 1u;
}

__device__ __forceinline__ void xcd_barrier(const XcdBarrier& b) {
    asm volatile("s_waitcnt vmcnt(0)" ::: "memory");
    __syncthreads();
    if (threadIdx.x == 0) {
        unsigned* bar = b.bar;
        __builtin_amdgcn_s_waitcnt(0);
        unsigned nloc = b.st[0], nx = b.st[1];
        if (nloc == 0u) { xcd_barrier_complete(bar, b.x, nloc, nx); b.st[0] = nloc; b.st[1] = nx; }
        const unsigned old = xb_add(&bar[XB_XSUB(b.x)], 1u);
        const unsigned gen = old / nloc;
        if (old + 1u == (gen + 1u) * nloc) {
            __builtin_amdgcn_fence(__ATOMIC_RELEASE, "agent");
            asm volatile("s_waitcnt vmcnt(0)" ::: "memory");
            const unsigned og = xb_add(&bar[XB_TOP], 1u);
            const unsigned tg = og / nx;
            if (og + 1u == (tg + 1u) * nx) xb_add(&bar[XB_TOPGEN], 1u);
            else XB_SPIN(xb_ld(&bar[XB_TOPGEN]) == tg, bar);
            __builtin_amdgcn_fence(__ATOMIC_ACQUIRE, "agent");
            xb_add(&bar[XB_XGEN(b.x)], 1u);
            asm volatile("s_waitcnt vmcnt(0)" ::: "memory");
        } else {
            XB_SPIN(xb_ld(&bar[XB_XGEN(b.x)]) == gen, bar);
            __builtin_amdgcn_fence(__ATOMIC_ACQUIRE, "agent");
            asm volatile("s_waitcnt vmcnt(0)" ::: "memory");
        }
    }
    __syncthreads();
}

__device__ __forceinline__ void split_arrive(const XcdBarrier& b, unsigned* w) {
    asm volatile("s_waitcnt vmcnt(0)" ::: "memory");
    __syncthreads();
    if (threadIdx.x == 0) {
        __builtin_amdgcn_s_waitcnt(0);
        unsigned nloc = b.st[0], nx = b.st[1];
        if (nloc == 0u) { xcd_barrier_complete(b.bar, b.x, nloc, nx); b.st[0] = nloc; b.st[1] = nx; }
        const unsigned old = xb_add(&w[64 * b.x], 1u);
        if (old + 1u == nloc) {
            __builtin_amdgcn_fence(__ATOMIC_RELEASE, "agent");
            asm volatile("s_waitcnt vmcnt(0)" ::: "memory");
            const unsigned og = xb_add(&w[64 * 16], 1u);
            if (og + 1u == nx) xb_add(&w[64 * 17], 1u);
        }
    }
}
__device__ __forceinline__ void split_wait(const XcdBarrier& b, unsigned* w) {
    if (threadIdx.x == 0) {
        XB_SPIN(xb_ld(&w[64 * 17]) == 0u, b.bar);
        __builtin_amdgcn_fence(__ATOMIC_ACQUIRE, "agent");
        asm volatile("s_waitcnt vmcnt(0)" ::: "memory");
    }
    __syncthreads();
}

constexpr int NWAVES = 8;
constexpr int NB = 8, SEQ = 4096, CTXL = 256, TT = SEQ + CTXL, DM = 1024, MROWS = NB * TT;
constexpr int NLAT = NB * SEQ;
constexpr int NPROJ = 1792, INCOLS = 1696, FFD = 2816, FFE = 3584, NEXP = 8;
constexpr int KTILES = TT / 64;
constexpr float EPS = 1e-6f, LOG2E = 1.4426950408889634f;
constexpr int MOE_CH = 64, MOE_NCH = 5, MOE_MAXT = 264, MOE_TAILK = 7;

constexpr size_t MiB = 1u << 20;
constexpr size_t WS_CTL = 0, WS_WUB = 1 * MiB, ZERO_BYTES = 3 * MiB;
constexpr size_t WS_MOD = 3 * MiB;
constexpr size_t WS_WIN = 4 * MiB, WS_WOUT = 11 * MiB, WS_WUP = 15 * MiB, WS_WDN = 26 * MiB;
constexpr size_t WS_XC = 32 * MiB;
constexpr size_t WS_RT = 40 * MiB;
constexpr size_t RT_TOPE = 0, RT_GATE = 256 * 1024, RT_POS = 512 * 1024, RT_HIST = 768 * 1024, RT_TILEE = 776 * 1024;
constexpr size_t WS_H = 42 * MiB;
constexpr size_t WS_P = 110 * MiB;
constexpr size_t WS_Q = 229 * MiB;
constexpr size_t SZ_Q64 = (size_t)NB * 6 * TT * 64 * 2, SZ_KV2 = (size_t)NB * 2 * KTILES * 8192;
constexpr size_t WS_QA = WS_Q, WS_KA = WS_QA + SZ_Q64, WS_VA = WS_KA + SZ_KV2, WS_QC = WS_VA + SZ_KV2, WS_KC = WS_QC + SZ_Q64, WS_VC = WS_KC + SZ_KV2;
constexpr size_t WS_CQKV = WS_VC + SZ_KV2;
constexpr size_t WS_KR = WS_CQKV + (size_t)MROWS * 384 * 2;
constexpr size_t WS_SSQ = WS_KR, WS_SSK = WS_KR + (size_t)MROWS * 16;
constexpr size_t WS_QB = WS_KR + (size_t)MROWS * 32 * 2;
constexpr size_t WS_KB = WS_QB + (size_t)NB * 4 * TT * 96 * 2;
constexpr size_t WS_VB = WS_KB + (size_t)NB * 4 * KTILES * 12288;
constexpr size_t WS_QEND = WS_VB + (size_t)NB * 4 * KTILES * 8192;
constexpr size_t WS_PART2 = 392 * MiB;
constexpr size_t WS_UM2 = WS_H;
constexpr size_t WS_PART = 400 * MiB;
constexpr size_t WS_D1 = WS_P;
constexpr size_t WS_D0 = WS_P;
constexpr size_t WS_D2 = 300 * MiB;
constexpr size_t WS_YT = 534 * MiB;
constexpr size_t WS_U = WS_P;
constexpr size_t WS_HFS = 194 * MiB, WS_Y = 260 * MiB, WS_UM = 392 * MiB, WS_WMUP = 450 * MiB, WS_WMDN = 506 * MiB, WS_END = 562 * MiB;
static_assert(WS_QEND <= 411 * MiB && WS_U + (size_t)MROWS * FFD * 2 <= WS_QEND, "ws map");
static_assert(WS_HFS + (size_t)MOE_MAXT * 256 * DM <= WS_Y && WS_Y + (size_t)MOE_MAXT * 256 * DM * 2 <= WS_UM && WS_UM + (size_t)MOE_CH * 256 * FFE <= WS_WMUP && WS_QEND <= WS_WMUP && WS_WMUP + (size_t)NEXP * 2 * FFE * DM <= WS_WMDN && WS_WMDN + (size_t)NEXP * DM * FFE <= WS_END, "moe ws map");
constexpr int CW_BAR = 4096;
constexpr int CW_STEAL = 16384, CW_DONE = 16448, CW_FINAL = 20480, CW_SPLIT = 24576;

constexpr int RING_BYTES = 131072, LDSCTL_OFF = RING_BYTES, MISC_OFF = LDSCTL_OFF + 320, LDS_BYTES = 147456;

__device__ __forceinline__ float bflo(unsigned u) { return __builtin_bit_cast(float, u << 16); }
__device__ __forceinline__ float bfhi(unsigned u) { return __builtin_bit_cast(float, u & 0xffff0000u); }
__device__ __forceinline__ void unpack8(const v4u r, float (&v)[8]) { v[0] = bflo(r.x); v[1] = bfhi(r.x); v[2] = bflo(r.y); v[3] = bfhi(r.y); v[4] = bflo(r.z); v[5] = bfhi(r.z); v[6] = bflo(r.w); v[7] = bfhi(r.w); }
__device__ __forceinline__ v4u pack8(const float (&v)[8]) { v4u o; o.x = pk2(v[0], v[1]); o.y = pk2(v[2], v[3]); o.z = pk2(v[4], v[5]); o.w = pk2(v[6], v[7]); return o; }
__device__ __forceinline__ float wave_sum(float v) {
#define WS_DPP(ctrl_, rmask_) v += __builtin_bit_cast(float, __builtin_amdgcn_update_dpp(0, __builtin_bit_cast(int, v), ctrl_, rmask_, 0xf, false))
    WS_DPP(0xB1, 0xf);
    WS_DPP(0x4E, 0xf);
    WS_DPP(0x141, 0xf);
    WS_DPP(0x140, 0xf);
    WS_DPP(0x142, 0xa);
    WS_DPP(0x143, 0xc);
#undef WS_DPP
    return __builtin_bit_cast(float, __builtin_amdgcn_readlane(__builtin_bit_cast(int, v), 63));
}
__device__ __forceinline__ float fast_rsqrt(float x) { return __builtin_amdgcn_rsqf(x); }
__device__ __forceinline__ float silu_f(float a) { return a * __builtin_amdgcn_rcpf(1.0f + __builtin_amdgcn_exp2f(-a * LOG2E)); }

__device__ __forceinline__ float clamp8(float v) { return __builtin_amdgcn_fmed3f(v, -448.f, 448.f); }
__device__ __forceinline__ unsigned pk4_fp8(float a, float b, float c, float d) { int w = __builtin_amdgcn_cvt_pk_fp8_f32(clamp8(a), clamp8(b), 0, false); w = __builtin_amdgcn_cvt_pk_fp8_f32(clamp8(c), clamp8(d), w, true); return (unsigned)w; }
#ifndef DENSE_F8
#define DENSE_F8 0
#endif
#ifndef DENSE_F8_UP
#define DENSE_F8_UP 1
#endif
#ifndef DENSE_F8_DN
#define DENSE_F8_DN 0
#endif
constexpr float F8_SA = 8.f, F8_SW = 64.f, F8_SU = 2.f;
struct Args { const float* in[25]; float* out; unsigned char* ws; int ph_lo, ph_hi; };
struct Ctx {
    LAS unsigned char* lds; int tid, lane, wave, vcu, G, wg;
    const float* const* in; float* out; unsigned char* ws;
};

struct TileSched {
    int nM, nN, nwg, G, c, skip, reps;
    __device__ __forceinline__ void init(int nM_, int nN_, int G_, int c_, int skip_, int reps_ = 1) { nM = nM_; nN = nN_; nwg = nM * nN; G = G_; c = c_; skip = skip_; reps = reps_; }
    __device__ __forceinline__ bool next(int i, pg8::Unit& u) const {
        const long L = (long)i * G + c; if (L >= (long)nwg * reps) return false;
        int wgid = (int)(L % nwg); { const int q = nwg / pg8::NXCD, r = nwg % pg8::NXCD, xcd = wgid % pg8::NXCD, off = wgid / pg8::NXCD; wgid = (xcd < r ? xcd * (q + 1) : r * (q + 1) + (xcd - r) * q) + off; }
        const int nig = pg8::WGM * nN, gid = wgid / nig, fm = gid * pg8::WGM, gsz = (nM - fm) < pg8::WGM ? (nM - fm) : pg8::WGM;
        int pm = fm + ((wgid % nig) % gsz); u.pn = (wgid % nig) / gsz;
        if (skip) pm = (pm >> 4) * 17 + 1 + (pm & 15);
        u.pm = pm; return true;
    }
    __device__ __forceinline__ void a_ready(const pg8::Unit&) const {}
    __device__ __forceinline__ void done(const pg8::Unit&) const {}
};
struct CtxSched {
    int c;
    __device__ __forceinline__ bool next(int i, pg8::Unit& u) const { if (i > 0 || c >= 32) return false; u.pm = 17 * (c >> 2); u.pn = c & 3; return true; }
    __device__ __forceinline__ void a_ready(const pg8::Unit&) const {}
    __device__ __forceinline__ void done(const pg8::Unit&) const {}
};
struct UpBSched {
    TileSched T;
    __device__ __forceinline__ bool next(int i, pg8::Unit& u) const { if (!T.next(i, u)) return false; u.ks = (u.pn >= 2) ? 1 : 0; return true; }
    __device__ __forceinline__ void a_ready(const pg8::Unit&) const {}
    __device__ __forceinline__ void done(const pg8::Unit&) const {}
};
struct CtxSplitSched {
    int c;
    __device__ __forceinline__ bool next(int i, pg8::Unit& u) const { if (i > 0 || c >= 64) return false; u.pm = 17 * (c >> 3); u.pn = (c >> 1) & 3; u.ks = c & 1; return true; }
    __device__ __forceinline__ void a_ready(const pg8::Unit&) const {}
    __device__ __forceinline__ void done(const pg8::Unit&) const {}
};
struct MoeTailSched {
    const int* tile_e; int tile0, ntc, G, c;
    __device__ __forceinline__ bool next(int i, pg8::Unit& u) const {
        const int L = i * G + c; if (L >= ntc * 4 * MOE_TAILK) return false;
        const int tl = L % ntc, r = L / ntc;
        const int e = __builtin_amdgcn_readfirstlane(__hip_atomic_load(tile_e + tile0 + tl, __ATOMIC_RELAXED, __HIP_MEMORY_SCOPE_AGENT)) & 7;
        u.pm = tl; u.pn = e * 4 + (r & 3); u.ks = r >> 2; return true;
    }
    __device__ __forceinline__ void a_ready(const pg8::Unit&) const {}
    __device__ __forceinline__ void done(const pg8::Unit&) const {}
};
struct MoeSched {
    const int* tile_e; int tile0, ntc, NT, G, c, up;
    __device__ __forceinline__ bool next(int i, pg8::Unit& u) const {
        const int L = i * G + c; if (L >= ntc * NT) return false;
        const int tl = L % ntc, pnl = L / ntc;
        const int e = __builtin_amdgcn_readfirstlane(__hip_atomic_load(tile_e + tile0 + tl, __ATOMIC_RELAXED, __HIP_MEMORY_SCOPE_AGENT)) & 7;
        u.pm = up ? tile0 + tl : tl; u.pn = e * NT + pnl; return true;
    }
    __device__ __forceinline__ void a_ready(const pg8::Unit&) const {}
    __device__ __forceinline__ void done(const pg8::Unit&) const {}
};

struct EpiStoreBf16 {
    static constexpr bool PERM = true, AFTER_DRAIN = false;
    pg8::bf16_t* O; int ldc, pn_mod, pm_off; float scale;
    __device__ __forceinline__ void operator()(const pg8::f32x4 (&acc)[2][2][4][2], const pg8::Unit& u, int wr, int wc, int fr, int fq) const {
        const int row0 = (u.pm + pm_off) * 256 + wr * 64 + fr, col0 = (u.pn % pn_mod) * 256 + wc * 32 + 8 * fq;
#pragma unroll
        for (int ai = 0; ai < 2; ++ai)
#pragma unroll
            for (int m = 0; m < 4; ++m) { pg8::bf16_t* rowp = O + (size_t)(row0 + ai * 128 + m * 16) * ldc + col0;
#pragma unroll
                for (int bj = 0; bj < 2; ++bj) { const pg8::f32x4 v0 = acc[ai][bj][m][0] * scale, v1 = acc[ai][bj][m][1] * scale;
                    pg8::u32x4 w; w.x = pg8::cvt_pk_bf16(v0[0], v0[1]); w.y = pg8::cvt_pk_bf16(v0[2], v0[3]); w.z = pg8::cvt_pk_bf16(v1[0], v1[1]); w.w = pg8::cvt_pk_bf16(v1[2], v1[3]);
                    *(pg8::u32x4*)(rowp + bj * 128) = w; } }
    }
};
struct EpiGateBf16 {
    static constexpr bool PERM = true, AFTER_DRAIN = false;
    pg8::bf16_t* D; const float* gate; float scale;
    __device__ __forceinline__ void operator()(const pg8::f32x4 (&acc)[2][2][4][2], const pg8::Unit& u, int wr, int wc, int fr, int fq) const {
        int upm = u.pm, upn = u.pn; asm volatile("" : "+v"(fr), "+v"(fq), "+s"(upm), "+s"(upn));
        const int b = upm / 17, lt = b * 16 + (upm - 17 * b) - 1;
        const float* g = gate + b * 6144;
        const int row0 = lt * 256 + wr * 64 + fr, col0 = upn * 256 + wc * 32 + 8 * fq;
#pragma unroll
        for (int bj = 0; bj < 2; ++bj) { const pg8::f32x4 g0 = *(const pg8::f32x4*)(g + col0 + bj * 128) * scale, g1 = *(const pg8::f32x4*)(g + col0 + bj * 128 + 4) * scale;
#pragma unroll
            for (int ai = 0; ai < 2; ++ai)
#pragma unroll
                for (int m = 0; m < 4; ++m) { const pg8::f32x4 v0 = acc[ai][bj][m][0] * g0, v1 = acc[ai][bj][m][1] * g1;
                    pg8::u32x4 w; w.x = pg8::cvt_pk_bf16(v0[0], v0[1]); w.y = pg8::cvt_pk_bf16(v0[2], v0[3]); w.z = pg8::cvt_pk_bf16(v1[0], v1[1]); w.w = pg8::cvt_pk_bf16(v1[2], v1[3]);
                    *(pg8::u32x4*)(D + (size_t)(row0 + ai * 128 + m * 16) * DM + col0 + bj * 128) = w; } }
    }
};
struct EpiStoreBf16K {
    static constexpr bool PERM = true, AFTER_DRAIN = false;
    pg8::bf16_t* O; int ldc; float scale;
    __device__ __forceinline__ void operator()(const pg8::f32x4 (&acc)[2][2][4][2], const pg8::Unit& u, int wr, int wc, int fr, int fq) const {
        const int row0 = (u.ks * 8 + u.pm) * 256 + wr * 64 + fr, col0 = (u.pn & 3) * 256 + wc * 32 + 8 * fq;
#pragma unroll
        for (int ai = 0; ai < 2; ++ai)
#pragma unroll
            for (int m = 0; m < 4; ++m) { pg8::bf16_t* rowp = O + (size_t)(row0 + ai * 128 + m * 16) * ldc + col0;
#pragma unroll
                for (int bj = 0; bj < 2; ++bj) { const pg8::f32x4 v0 = acc[ai][bj][m][0] * scale, v1 = acc[ai][bj][m][1] * scale;
                    pg8::u32x4 w; w.x = pg8::cvt_pk_bf16(v0[0], v0[1]); w.y = pg8::cvt_pk_bf16(v0[2], v0[3]); w.z = pg8::cvt_pk_bf16(v1[0], v1[1]); w.w = pg8::cvt_pk_bf16(v1[2], v1[3]);
                    *(pg8::u32x4*)(rowp + bj * 128) = w; } }
    }
};
template <bool OUT8> struct EpiSwiglu {
    static constexpr bool PERM = true, AFTER_DRAIN = false;
    void* O; int ldc, pn_mod, pm_off; float ascale, oscale;
    __device__ __forceinline__ void operator()(const pg8::f32x4 (&acc)[2][2][4][2], const pg8::Unit& u, int wr, int wc, int fr, int fq) const {
        typedef unsigned u32x2v __attribute__((ext_vector_type(2)));
        const int row0 = (u.pm + pm_off) * 256 + wr * 64 + fr, col0 = (u.pn % pn_mod) * 128 + wc * 32 + 8 * fq;
#pragma unroll
        for (int ai = 0; ai < 2; ++ai)
#pragma unroll
            for (int m = 0; m < 4; ++m) { const size_t eo = (size_t)(row0 + ai * 128 + m * 16) * ldc + col0;
                const float c1 = -ascale * LOG2E, c2 = ascale * ascale * (OUT8 ? oscale : 1.0f);
                const pg8::f32x4 a0 = acc[ai][0][m][0], a1 = acc[ai][0][m][1];
                const pg8::f32x4 t0 = a0 * c1, t1 = a1 * c1;
                pg8::f32x4 e0, e1;
#pragma unroll
                for (int i = 0; i < 4; ++i) { e0[i] = __builtin_amdgcn_exp2f(t0[i]); e1[i] = __builtin_amdgcn_exp2f(t1[i]); }
                const pg8::f32x4 d0 = e0 + 1.0f, d1 = e1 + 1.0f;
                pg8::f32x4 r0, r1;
#pragma unroll
                for (int i = 0; i < 4; ++i) { r0[i] = __builtin_amdgcn_rcpf(d0[i]); r1[i] = __builtin_amdgcn_rcpf(d1[i]); }
                const pg8::f32x4 u0 = (a0 * r0) * (acc[ai][1][m][0] * c2), u1 = (a1 * r1) * (acc[ai][1][m][1] * c2);
                const float uu[8] = {u0[0], u0[1], u0[2], u0[3], u1[0], u1[1], u1[2], u1[3]};
                if (OUT8) { u32x2v w; w.x = pk4_fp8(uu[0], uu[1], uu[2], uu[3]); w.y = pk4_fp8(uu[4], uu[5], uu[6], uu[7]);
                    *(u32x2v*)((unsigned char*)O + eo) = w; }
                else { pg8::u32x4 w; w.x = pg8::cvt_pk_bf16(uu[0], uu[1]); w.y = pg8::cvt_pk_bf16(uu[2], uu[3]); w.z = pg8::cvt_pk_bf16(uu[4], uu[5]); w.w = pg8::cvt_pk_bf16(uu[6], uu[7]);
                    *(pg8::u32x4*)((pg8::bf16_t*)O + eo) = w; } }
    }
};
struct EpiProj {
    static constexpr bool PERM = true, AFTER_DRAIN = false;
    pg8::bf16_t* QA; unsigned char* KA; unsigned char* VA; pg8::bf16_t* QC; unsigned char* KC; unsigned char* VC; pg8::bf16_t* CQ; unsigned char* KB; float* SSQ; float* SSK;
    const float* aq; const float* ak; const LAS float* tab64; const LAS float* tab32;
    __device__ __forceinline__ void operator()(const pg8::f32x4 (&acc)[2][2][4][2], const pg8::Unit& u, int wr, int wc, int fr_, int fq_) const {
        int fr = fr_, fq = fq_, upm = u.pm, upn = u.pn; asm volatile("" : "+v"(fr), "+v"(fq), "+s"(upm), "+s"(upn));
        const int b = upm / 17, tj = (upm % 17) * 256; const bool isl = tj != 0;
        const int t0 = tj + wr * 64 + fr;
        const int row0 = upm * 256 + wr * 64 + fr;
        if (upn < 4) {
            const bool isA = upn < 2; const int hq = (upn & 1) * 4 + wc; const bool isq = hq < 6;
            pg8::f32x4 g0[2], g1[2];
            if (isA) { const float* gp = (isq ? aq : ak) + fq * 8; g0[0] = *(const pg8::f32x4*)gp; g0[1] = *(const pg8::f32x4*)(gp + 4); g1[0] = *(const pg8::f32x4*)(gp + 32); g1[1] = *(const pg8::f32x4*)(gp + 36); }
            unsigned char* dp; int astep, mstep, bstep;
            if (isq) { dp = (unsigned char*)(isA ? QA : QC) + (((size_t)(b * 6 + hq) * TT + t0) * 64 + fq * 8) * 2; astep = 128 * 128; mstep = 16 * 128; bstep = 64; }
            else { dp = (isA ? KA : KC) + ((size_t)(b * 2 + hq - 6) * KTILES + (t0 >> 6)) * 8192 + fq * 1024 + fr * 16; astep = 2 * 8192; mstep = 256; bstep = 4096; }
            const float qs = isq ? 0.125f * LOG2E : 1.0f;
#pragma unroll
            for (int ai = 0; ai < 2; ++ai)
#pragma unroll
                for (int m = 0; m < 4; ++m) {
                    float a[8], c[8];
#pragma unroll
                    for (int i = 0; i < 4; ++i) { a[i] = acc[ai][0][m][0][i]; a[4 + i] = acc[ai][0][m][1][i]; c[i] = acc[ai][1][m][0][i]; c[4 + i] = acc[ai][1][m][1][i]; }
                    if (isA) { float ss = 0.f;
#pragma unroll
                        for (int e = 0; e < 8; ++e) ss += a[e] * a[e] + c[e] * c[e];
                        ss += __shfl_xor(ss, 16); ss += __shfl_xor(ss, 32);
                        const float rinv = fast_rsqrt(ss * (1.f / 64.f) + EPS);
#pragma unroll
                        for (int e = 0; e < 8; ++e) { a[e] *= rinv * g0[e >> 2][e & 3]; c[e] *= rinv * g1[e >> 2][e & 3]; } }
                    if (isl) { const int lp = t0 + ai * 128 + m * 16 - CTXL; const LAS float* ta = tab64 + (((lp >> 6) & 63) * 16 + (fq & 1) * 8) * 2; const LAS float* tc = tab64 + ((lp & 63) * 16 + (fq & 1) * 8) * 2;
#pragma unroll
                        for (int e = 0; e < 8; ++e) { const float ya = __shfl_xor(a[e], 32), yc = __shfl_xor(c[e], 32);
                            a[e] = (fq >> 1) ? a[e] * ta[2 * e] + ya * ta[2 * e + 1] : a[e] * ta[2 * e] - ya * ta[2 * e + 1];
                            c[e] = (fq >> 1) ? c[e] * tc[2 * e] + yc * tc[2 * e + 1] : c[e] * tc[2 * e] - yc * tc[2 * e + 1]; } }
                    pg8::u32x4 wa, wc2;
                    wa.x = pk2(a[0] * qs, a[1] * qs); wa.y = pk2(a[2] * qs, a[3] * qs); wa.z = pk2(a[4] * qs, a[5] * qs); wa.w = pk2(a[6] * qs, a[7] * qs);
                    wc2.x = pk2(c[0] * qs, c[1] * qs); wc2.y = pk2(c[2] * qs, c[3] * qs); wc2.z = pk2(c[4] * qs, c[5] * qs); wc2.w = pk2(c[6] * qs, c[7] * qs);
                    unsigned char* d = dp + (size_t)ai * astep + m * mstep;
                    *(pg8::u32x4*)d = wa; *(pg8::u32x4*)(d + bstep) = wc2;
                    asm volatile("" ::: "memory");
                }
        } else if (upn == 4) {
            unsigned char* dp = ((wc < 2) ? VA : VC) + ((size_t)(b * 2 + (wc & 1)) * KTILES + (t0 >> 6)) * 8192 + fr * 64 + fq * 16;
#pragma unroll
            for (int ai = 0; ai < 2; ++ai)
#pragma unroll
                for (int m = 0; m < 4; ++m)
#pragma unroll
                    for (int bj = 0; bj < 2; ++bj) { const pg8::f32x4 v0 = acc[ai][bj][m][0], v1 = acc[ai][bj][m][1];
                        pg8::u32x4 w; w.x = pk2(v0[0], v0[1]); w.y = pk2(v0[2], v0[3]); w.z = pk2(v1[0], v1[1]); w.w = pk2(v1[2], v1[3]);
                        *(pg8::u32x4*)(dp + (size_t)ai * 2 * 8192 + m * 1024 + bj * 4096) = w; asm volatile("" ::: "memory"); }
        } else {
            const bool iscq = upn == 5;
            pg8::bf16_t* cp = CQ + (size_t)row0 * 384 + (iscq ? 0 : 256) + wc * 32 + fq * 8; float* sp = (iscq ? SSQ : SSK) + (size_t)row0 * 4 + wc;
#pragma unroll
            for (int ai = 0; ai < 2; ++ai)
#pragma unroll
                for (int m = 0; m < 4; ++m) { const size_t ro = (size_t)(ai * 128 + m * 16);
                    float ss = 0.f;
#pragma unroll
                    for (int bj = 0; bj < 2; ++bj) { if (bj == 1 && !iscq) continue;
                        const pg8::f32x4 v0 = acc[ai][bj][m][0], v1 = acc[ai][bj][m][1];
                        ss += (v0[0] * v0[0] + v0[1] * v0[1]) + (v0[2] * v0[2] + v0[3] * v0[3]) + (v1[0] * v1[0] + v1[1] * v1[1]) + (v1[2] * v1[2] + v1[3] * v1[3]);
                        pg8::u32x4 w; w.x = pk2(v0[0], v0[1]); w.y = pk2(v0[2], v0[3]); w.z = pk2(v1[0], v1[1]); w.w = pk2(v1[2], v1[3]);
                        *(pg8::u32x4*)(cp + ro * 384 + bj * 128) = w; }
                    ss += __shfl_xor(ss, 16); ss += __shfl_xor(ss, 32);
                    if (fq == 0) sp[ro * 4] = ss;
                    asm volatile("" ::: "memory");
                }
            if (!iscq && wc == 0) {
                unsigned char* kp = KB + ((size_t)(b * 4) * KTILES + (t0 >> 6)) * 12288 + (8 + fq) * 1024 + fr * 16;
#pragma unroll
                for (int ai = 0; ai < 2; ++ai)
#pragma unroll
                    for (int m = 0; m < 4; ++m) { float v[8];
#pragma unroll
                        for (int i = 0; i < 4; ++i) { v[i] = acc[ai][1][m][0][i]; v[4 + i] = acc[ai][1][m][1][i]; }
                        if (isl) { const int lp = t0 + ai * 128 + m * 16 - CTXL; const LAS float* t4 = tab32 + (((fq >> 1) ? (lp & 63) : ((lp >> 6) & 63)) * 8) * 2;
#pragma unroll
                            for (int e = 0; e < 8; ++e) { const float yp = __shfl_xor(v[e], 16); v[e] = (fq & 1) ? v[e] * t4[2 * e] + yp * t4[2 * e + 1] : v[e] * t4[2 * e] - yp * t4[2 * e + 1]; } }
                        pg8::u32x4 w; w.x = pk2(v[0], v[1]); w.y = pk2(v[2], v[3]); w.z = pk2(v[4], v[5]); w.w = pk2(v[6], v[7]);
#pragma unroll
                        for (int h = 0; h < 4; ++h) *(pg8::u32x4*)(kp + (size_t)h * KTILES * 12288 + (size_t)ai * 2 * 12288 + m * 256) = w;
                        asm volatile("" ::: "memory"); }
            }
        }
        asm volatile("s_waitcnt vmcnt(0)" ::: "memory");
    }
};
struct EpiUpB {
    static constexpr bool PERM = true, AFTER_DRAIN = false;
    pg8::bf16_t* QB; unsigned char* KB; unsigned char* VB; const float* SSQ; const float* SSK;
    __device__ __forceinline__ void operator()(const pg8::f32x4 (&acc)[2][2][4][2], const pg8::Unit& u, int wr, int wc, int fr_, int fq_) const {
        int fr = fr_, fq = fq_, upm = u.pm, upn = u.pn; asm volatile("" : "+v"(fr), "+v"(fq), "+s"(upm), "+s"(upn));
        const int b = upm / 17, t0 = (upm % 17) * 256 + wr * 64 + fr;
        const float* ssp = ((upn < 2) ? SSQ : SSK) + (size_t)(upm * 256 + wr * 64 + fr) * 4; const float sdiv = (upn < 2) ? (1.f / 256.f) : (1.f / 128.f);
        float rinv[2][4];
#pragma unroll
        for (int ai = 0; ai < 2; ++ai)
#pragma unroll
            for (int m = 0; m < 4; ++m) { const pg8::f32x4 s4 = *(const pg8::f32x4*)(ssp + (size_t)(ai * 128 + m * 16) * 4); rinv[ai][m] = fast_rsqrt(((s4[0] + s4[1]) + (s4[2] + s4[3])) * sdiv + EPS); }
#pragma unroll
        for (int bj = 0; bj < 2; ++bj) {
            unsigned char* p; int astep, mstep; float sc = 1.0f;
            if (upn < 2) { const int cbase = upn * 256 + bj * 128 + wc * 32; if (cbase >= 384) continue; const int h = cbase / 96;
                p = (unsigned char*)QB + (((size_t)(b * 4 + h) * TT + t0) * 96 + (cbase + 8 * fq - h * 96)) * 2; astep = 128 * 192; mstep = 16 * 192; sc = 0.10206207261596575f * LOG2E; }
            else { const int h = bj * 2 + (wc >> 1), c = (wc & 1) * 4 + fq;
                if (upn == 2) { p = KB + ((size_t)(b * 4 + h) * KTILES + (t0 >> 6)) * 12288 + c * 1024 + fr * 16; astep = 2 * 12288; mstep = 256; }
                else { p = VB + ((size_t)(b * 4 + h) * KTILES + (t0 >> 6)) * 8192 + (c >> 2) * 4096 + fr * 64 + (c & 3) * 16; astep = 2 * 8192; mstep = 1024; } }
#pragma unroll
            for (int ai = 0; ai < 2; ++ai)
#pragma unroll
                for (int m = 0; m < 4; ++m) { const float rs = rinv[ai][m] * sc;
                    const pg8::f32x4 v0 = acc[ai][bj][m][0] * rs, v1 = acc[ai][bj][m][1] * rs;
                    pg8::u32x4 w; w.x = pk2(v0[0], v0[1]); w.y = pk2(v0[2], v0[3]); w.z = pk2(v1[0], v1[1]); w.w = pk2(v1[2], v1[3]);
                    *(pg8::u32x4*)(p + (size_t)ai * astep + m * mstep) = w;
                }
        }
        asm volatile("s_waitcnt vmcnt(0)" ::: "memory");
    }
};
struct EpiResid {
    static constexpr bool PERM = false, AFTER_DRAIN = false;
    const float* base_lat; const float* base_ctx; float* out_lat; float* out_ctx; const float* gate; float scale;
    __device__ __forceinline__ void operator()(const pg8::f32x4 (&acc)[2][2][4][2], const pg8::Unit& u, int wr, int wc, int fr, int fq) const {
        const int b = u.pm / 17, j = u.pm % 17;
        const float* bs; float* os; const float* g;
        if (j == 0) { bs = base_ctx + (size_t)b * CTXL * DM; os = out_ctx + (size_t)b * CTXL * DM; g = gate + 8 * 6144; }
        else { const size_t ro = ((size_t)b * SEQ + (size_t)(j - 1) * 256) * DM; bs = base_lat + ro; os = out_lat + ro; g = gate + b * 6144; }
        const int col0 = u.pn * 256 + wc * 32 + 4 * fq;
#pragma unroll
        for (int bj = 0; bj < 2; ++bj)
#pragma unroll
            for (int n = 0; n < 2; ++n) { const pg8::f32x4 gv = *(const pg8::f32x4*)(g + col0 + bj * 128 + n * 16) * scale;
                pg8::f32x4 xb[2][4];
#pragma unroll
                for (int ai = 0; ai < 2; ++ai)
#pragma unroll
                    for (int m = 0; m < 4; ++m) xb[ai][m] = *(const pg8::f32x4*)(bs + (size_t)(ai * 128 + wr * 64 + m * 16 + fr) * DM + col0 + bj * 128 + n * 16);
#pragma unroll
                for (int ai = 0; ai < 2; ++ai)
#pragma unroll
                    for (int m = 0; m < 4; ++m) *(pg8::f32x4*)(os + (size_t)(ai * 128 + wr * 64 + m * 16 + fr) * DM + col0 + bj * 128 + n * 16) = xb[ai][m] + gv * acc[ai][bj][m][n];
                asm volatile("" ::: "memory"); }
    }
};
struct EpiResidPart {
    static constexpr bool PERM = false, AFTER_DRAIN = false;
    const float* base_lo; const float* base_hi; float* out_lo; float* out_hi; const float* gate; float scale;
    __device__ __forceinline__ void operator()(const pg8::f32x4 (&acc)[2][2][4][2], const pg8::Unit& u, int wr, int wc, int fr, int fq) const {
        int upm = u.pm, upn = u.pn; asm volatile("" : "+v"(fr), "+v"(fq), "+s"(upm), "+s"(upn));
        const int b = upm / 17; const bool hi = u.ks != 0;
        const float* bs = ((hi && base_hi) ? base_hi : base_lo) + (size_t)b * CTXL * DM; float* os = (hi ? out_hi : out_lo) + (size_t)b * CTXL * DM; const float* g = gate + 8 * 6144;
        const float keep = (hi && !base_hi) ? 0.f : 1.f;
        const int col0 = upn * 256 + wc * 32 + 4 * fq;
#pragma unroll
        for (int bj = 0; bj < 2; ++bj)
#pragma unroll
            for (int n = 0; n < 2; ++n) { const pg8::f32x4 gv = *(const pg8::f32x4*)(g + col0 + bj * 128 + n * 16) * scale;
                pg8::f32x4 xb[2][4];
#pragma unroll
                for (int ai = 0; ai < 2; ++ai)
#pragma unroll
                    for (int m = 0; m < 4; ++m) xb[ai][m] = *(const pg8::f32x4*)(bs + (size_t)(ai * 128 + wr * 64 + m * 16 + fr) * DM + col0 + bj * 128 + n * 16);
#pragma unroll
                for (int ai = 0; ai < 2; ++ai)
#pragma unroll
                    for (int m = 0; m < 4; ++m) *(pg8::f32x4*)(os + (size_t)(ai * 128 + wr * 64 + m * 16 + fr) * DM + col0 + bj * 128 + n * 16) = xb[ai][m] * keep + gv * acc[ai][bj][m][n];
                asm volatile("" ::: "memory"); }
    }
};

namespace att {
using f32x16 = __attribute__((ext_vector_type(16))) float;
using s16x4 = __attribute__((ext_vector_type(4))) short;
typedef short v4i16_t __attribute__((ext_vector_type(4)));
constexpr int KSLOT = 12288, VSLOT = 8192;
constexpr int L_K = 0, L_V = 2 * KSLOT, L_O = L_V + 2 * VSLOT, OSTR = 144, L_END = L_O + NWAVES * 32 * OSTR;
static_assert(L_END <= RING_BYTES, "attention LDS");
constexpr float THR = 8.0f, NEGBIG = -1e30f;
__device__ __forceinline__ int crow(int r, int hi) { return (r & 3) + 8 * (r >> 2) + 4 * hi; }
__device__ __forceinline__ float swapmax(float m) { auto rr = __builtin_amdgcn_permlane32_swap(__float_as_uint(m), __float_as_uint(m), false, false); float r; asm("v_max_f32_e32 %0, %1, %2" : "=v"(r) : "v"(__uint_as_float(rr[0])), "v"(__uint_as_float(rr[1]))); return r; }
__device__ __forceinline__ float swapsum(float m) { auto rr = __builtin_amdgcn_permlane32_swap(__float_as_uint(m), __float_as_uint(m), false, false); return __uint_as_float(rr[0]) + __uint_as_float(rr[1]); }
__device__ __forceinline__ s16x4 vtr(const LAS unsigned char* p) { return __builtin_bit_cast(s16x4, __builtin_amdgcn_ds_read_tr16_b64_v4i16((LAS v4i16_t*)p)); }
typedef float f32x2_t __attribute__((ext_vector_type(2))); typedef __bf16 bf16x2_t __attribute__((ext_vector_type(2)));
__device__ __forceinline__ unsigned cvtpk(float lo, float hi) { f32x2_t v = {lo, hi}; bf16x2_t b = __builtin_convertvector(v, bf16x2_t); return __builtin_bit_cast(unsigned, b); }
__device__ __forceinline__ float max3f(float a, float b, float c) { float r; asm("v_max3_f32 %0, %1, %2, %3" : "=v"(r) : "v"(a), "v"(b), "v"(c)); return r; }
__device__ __forceinline__ float max2f(float a, float b) { float r; asm("v_max_f32_e32 %0, %1, %2" : "=v"(r) : "v"(a), "v"(b)); return r; }
__device__ __forceinline__ float fadd_s(float a, float b) { float r; asm("v_add_f32_e32 %0, %1, %2" : "=v"(r) : "v"(a), "v"(b)); return r; }
__device__ __forceinline__ void glds16(const void* gsrc, unsigned lds_dst) { unsigned keep;
    asm volatile("s_mov_b32 %0, m0\n\ts_mov_b32 m0, %2\n\ts_nop 0\n\tglobal_load_lds_dwordx4 %1, off\n\ts_mov_b32 m0, %0" : "=&s"(keep) : "v"(gsrc), "s"(lds_dst) : "memory"); }

struct UnitDesc {
    const bf16* Q;
    const unsigned char* Kimg; const unsigned char* Vimg;
    bf16* O;
    int n0, s1t0, n1;
    int qpos0;
    float minit, linit;
};

__device__ __forceinline__ void rope_q96(bf16* Q, int qpos0) {
    const int tid = threadIdx.x, lane = tid & 63, r32 = lane & 31, hi = lane >> 5, wid = tid >> 6;
    const int lp = qpos0 + wid * 32 + r32;
#pragma unroll
    for (int ds = 4; ds < 6; ++ds) { const int pos = (ds == 4) ? ((lp >> 6) & 63) : (lp & 63);
        v4u* qp = (v4u*)(Q + (size_t)(wid * 32 + r32) * 96 + ds * 16 + hi * 8);
        float v[8]; unpack8(*qp, v); float o[8];
#pragma unroll
        for (int e = 0; e < 8; ++e) { constexpr float invf[8] = {1.0f, 0.31622776601683794f, 0.1f, 0.031622776601683794f, 0.01f, 0.0031622776601683794f, 0.001f, 0.00031622776601683794f};
            const float rev = ((float)pos * invf[e]) * 0.15915494309189535f; const float cs = __builtin_amdgcn_cosf(rev), sn = __builtin_amdgcn_sinf(rev);
            const float yp = __shfl_xor(v[e], 32); o[e] = hi ? v[e] * cs + yp * sn : v[e] * cs - yp * sn; }
        *qp = pack8(o); }
    asm volatile("s_waitcnt vmcnt(0)" ::: "memory");
}

template <int DK, bool WIN>
__device__ __forceinline__ void unit(LAS unsigned char* lds, const UnitDesc& u) {
    int tid = threadIdx.x; asm volatile("" : "+v"(tid));
    const int lane = tid & 63, r32 = lane & 31, hi = lane >> 5; const int wid = __builtin_amdgcn_readfirstlane(tid >> 6);
    constexpr int KT_BYTES = DK * 128, NDS = DK / 16;
    const int NT = u.n0 + u.n1;
    const unsigned lds0 = (unsigned)(uintptr_t)lds;
#define ATT_TILE(i_) (((i_) < u.n0) ? (i_) : u.s1t0 + ((i_) - u.n0))
#define ATT_ISSUE_K(i_, slot_) do { const unsigned char* kg_ = u.Kimg + (size_t)ATT_TILE(i_) * KT_BYTES + wid * 1024 + lane * 16; \
        glds16(kg_, (unsigned)__builtin_amdgcn_readfirstlane(lds0 + L_K + (slot_) * KSLOT + wid * 1024)); \
        if (DK == 96) { if (wid < 4) glds16(kg_ + 8192, (unsigned)__builtin_amdgcn_readfirstlane(lds0 + L_K + (slot_) * KSLOT + 8192 + wid * 1024)); } } while (0)
#define ATT_ISSUE_V(i_, slot_) do { const unsigned char* vg_ = u.Vimg + (size_t)ATT_TILE(i_) * 8192 + wid * 1024 + lane * 16; \
        glds16(vg_, (unsigned)__builtin_amdgcn_readfirstlane(lds0 + L_V + (slot_) * VSLOT + wid * 1024)); } while (0)
#define ATT_QK(P0, P1, slot_) do { const LAS unsigned char* kb_ = lds + L_K + (slot_) * KSLOT + hi * 1024 + r32 * 16; \
        bf16x8 kf_[3][2];          \
        kf_[0][0] = *(const LAS bf16x8*)(kb_); kf_[0][1] = *(const LAS bf16x8*)(kb_ + 512); kf_[1][0] = *(const LAS bf16x8*)(kb_ + 2048); kf_[1][1] = *(const LAS bf16x8*)(kb_ + 2048 + 512); \
        _Pragma("unroll") for (int ds = 0; ds < NDS; ++ds) { \
            if (ds + 2 < NDS) { kf_[(ds + 2) % 3][0] = *(const LAS bf16x8*)(kb_ + (ds + 2) * 2048); kf_[(ds + 2) % 3][1] = *(const LAS bf16x8*)(kb_ + (ds + 2) * 2048 + 512); } \
            if (ds == 0) { P0 = __builtin_amdgcn_mfma_f32_32x32x16_bf16(kf_[0][0], qf[0], negm, 0, 0, 0); P1 = __builtin_amdgcn_mfma_f32_32x32x16_bf16(kf_[0][1], qf[0], negm, 0, 0, 0); } \
            else { P0 = __builtin_amdgcn_mfma_f32_32x32x16_bf16(kf_[ds % 3][0], qf[ds], P0, 0, 0, 0); P1 = __builtin_amdgcn_mfma_f32_32x32x16_bf16(kf_[ds % 3][1], qf[ds], P1, 0, 0, 0); } \
            __builtin_amdgcn_sched_barrier(0x407); } } while (0)
#define ATT_WAITBAR() do { asm volatile("s_waitcnt vmcnt(0) lgkmcnt(0)" ::: "memory"); __builtin_amdgcn_s_barrier(); asm volatile("" ::: "memory"); } while (0)
    ATT_ISSUE_K(0, 0); ATT_ISSUE_V(0, 0); ATT_ISSUE_K(1, 1);
    bf16x8 qf[NDS];
#pragma unroll
    for (int ds = 0; ds < NDS; ++ds) qf[ds] = *(const bf16x8*)(u.Q + (size_t)(wid * 32 + r32) * DK + ds * 16 + hi * 8);
    f32x16 o0 = {}, o1 = {};
    const bool has_sink = u.linit != 0.f;
    float lsum = (hi == 0) ? u.linit : 0.f;
    f32x16 negm;
    { const float m0 = has_sink ? -u.minit : 0.f;
#pragma unroll
      for (int r = 0; r < 16; ++r) negm[r] = m0; }
    asm volatile("" : "+v"(negm));
    const int qlo = u.qpos0 + wid * 32, qp = qlo + r32;
    f32x16 sa0, sa1, sb0, sb1;
    ATT_WAITBAR();
    ATT_QK(sa0, sa1, 0);
    asm volatile("s_nop 15\n\ts_nop 7" : "+v"(sa0), "+v"(sa1));
    bool actc = true; int kposc = 0;
    ATT_WAITBAR();
#define ATT_STEP(i_, C0, C1, N0, N1, QKM_) do {        \
        if ((i_) + 2 < NT) ATT_ISSUE_K((i_) + 2, (i_) & 1); \
        if ((i_) + 1 < NT) ATT_ISSUE_V((i_) + 1, ((i_) + 1) & 1); \
        bool actn = (QKM_ == 2) ? ((i_) + 1 < NT) : (QKM_ == 1); int kposn = 0; \
        if (WIN) { if (actn && (i_) + 1 >= u.n0) { kposn = (u.s1t0 + ((i_) + 1 - u.n0) - 4) * 64; actn = (kposn + 63 >= qlo - 128) && (kposn <= qlo + 31 + 128); } } \
        if (actn) ATT_QK(N0, N1, ((i_) + 1) & 1); \
        if (actc) { \
            if (WIN) { if ((i_) >= u.n0) { \
                _Pragma("unroll") for (int r = 0; r < 16; ++r) { const int dk = kposc + crow(r, hi) - qp; if (dk > 128 || dk < -128) C0[r] = NEGBIG; if (dk + 32 > 128 || dk + 32 < -128) C1[r] = NEGBIG; } } } \
            float rma = max3f(C0[0], C0[1], C1[0]), rmb = max3f(C0[2], C0[3], C1[1]); rma = max3f(rma, C1[2], C1[3]); \
            _Pragma("unroll") for (int r = 4; r < 16; r += 4) { rma = max3f(rma, C0[r], C0[r + 1]); rmb = max3f(rmb, C0[r + 2], C0[r + 3]); rma = max3f(rma, C1[r], C1[r + 1]); rmb = max3f(rmb, C1[r + 2], C1[r + 3]); } \
            float rm = swapmax(max2f(rma, rmb)); \
            const bool force = (!has_sink) && ((i_) == 0); \
            if (force || __any(rm > THR)) { \
                const float dl = force ? rm : max2f(rm, 0.f), al = __builtin_amdgcn_exp2f(-dl); \
                _Pragma("unroll") for (int r = 0; r < 16; ++r) { C0[r] -= dl; C1[r] -= dl; o0[r] *= al; o1[r] *= al; negm[r] -= dl; } \
                if (actn) { _Pragma("unroll") for (int r = 0; r < 16; ++r) { N0[r] -= dl; N1[r] -= dl; } } \
                lsum *= al; asm volatile("" : "+v"(negm)); \
            } \
            float sacc = 0.f; \
            _Pragma("unroll") for (int r = 0; r < 16; ++r) { C0[r] = __builtin_amdgcn_exp2f(C0[r]); C1[r] = __builtin_amdgcn_exp2f(C1[r]); sacc += C0[r]; sacc += C1[r]; } \
            lsum += sacc; \
            v4u pw[4]; \
            _Pragma("unroll") for (int k = 0; k < 2; ++k) { \
                pw[k].x = cvtpk(C0[8 * k + 0], C0[8 * k + 1]); pw[k].y = cvtpk(C0[8 * k + 2], C0[8 * k + 3]); pw[k].z = cvtpk(C0[8 * k + 4], C0[8 * k + 5]); pw[k].w = cvtpk(C0[8 * k + 6], C0[8 * k + 7]); \
                pw[2 + k].x = cvtpk(C1[8 * k + 0], C1[8 * k + 1]); pw[2 + k].y = cvtpk(C1[8 * k + 2], C1[8 * k + 3]); pw[2 + k].z = cvtpk(C1[8 * k + 4], C1[8 * k + 5]); pw[2 + k].w = cvtpk(C1[8 * k + 6], C1[8 * k + 7]); } \
            const LAS unsigned char* vb = lds + L_V + ((i_) & 1) * VSLOT + ((lane >> 4) & 1) * 32 + (lane & 3) * 8 + (4 * hi + ((lane & 15) >> 2)) * 64; \
            _Pragma("unroll") for (int ks = 0; ks < 4; ++ks) { \
                const s16x4 a0 = vtr(vb + ks * 1024), a1 = vtr(vb + ks * 1024 + 512), b0 = vtr(vb + 4096 + ks * 1024), b1 = vtr(vb + 4096 + ks * 1024 + 512); \
                const bf16x8 vf0 = (bf16x8){a0[0], a0[1], a0[2], a0[3], a1[0], a1[1], a1[2], a1[3]}, vf1 = (bf16x8){b0[0], b0[1], b0[2], b0[3], b1[0], b1[1], b1[2], b1[3]}; \
                const bf16x8 pf = __builtin_bit_cast(bf16x8, pw[ks]); \
                o0 = __builtin_amdgcn_mfma_f32_32x32x16_bf16(vf0, pf, o0, 0, 0, 0); \
                o1 = __builtin_amdgcn_mfma_f32_32x32x16_bf16(vf1, pf, o1, 0, 0, 0); } \
        } \
        actc = actn; kposc = kposn; \
        ATT_WAITBAR(); } while (0)
    if (WIN) { for (int i = 0; i < NT; i += 2) { ATT_STEP(i, sa0, sa1, sb0, sb1, 2); ATT_STEP(i + 1, sb0, sb1, sa0, sa1, 2); } }
    else {
        for (int i = 0; i + 2 < NT; i += 2) { ATT_STEP(i, sa0, sa1, sb0, sb1, 1); ATT_STEP(i + 1, sb0, sb1, sa0, sa1, 1); }
        ATT_STEP(NT - 2, sa0, sa1, sb0, sb1, 1); ATT_STEP(NT - 1, sb0, sb1, sa0, sa1, 0);
    }
#undef ATT_STEP
#undef ATT_QK
#undef ATT_ISSUE_K
#undef ATT_ISSUE_V
#undef ATT_TILE
#undef ATT_WAITBAR
    const float inv = __builtin_amdgcn_rcpf(swapsum(lsum));
    LAS unsigned char* stg = lds + L_O + wid * (32 * OSTR);
    typedef unsigned u32x2v __attribute__((ext_vector_type(2)));
#pragma unroll
    for (int rg = 0; rg < 4; ++rg) {
        u32x2v w0, w1;
        w0.x = cvtpk(o0[4 * rg + 0] * inv, o0[4 * rg + 1] * inv); w0.y = cvtpk(o0[4 * rg + 2] * inv, o0[4 * rg + 3] * inv);
        w1.x = cvtpk(o1[4 * rg + 0] * inv, o1[4 * rg + 1] * inv); w1.y = cvtpk(o1[4 * rg + 2] * inv, o1[4 * rg + 3] * inv);
        *(LAS u32x2v*)(stg + r32 * OSTR + (8 * rg + 4 * hi) * 2) = w0;
        *(LAS u32x2v*)(stg + r32 * OSTR + (32 + 8 * rg + 4 * hi) * 2) = w1;
    }
    asm volatile("s_waitcnt lgkmcnt(0)" ::: "memory");
#pragma unroll
    for (int i = 0; i < 4; ++i) { const int row = i * 8 + (lane >> 3), ch = lane & 7; const v4u v = *(const LAS v4u*)(stg + row * OSTR + ch * 16);
        *(v4u*)(u.O + (size_t)(wid * 32 + row) * DM + ch * 8) = v; }
    asm volatile("s_waitcnt lgkmcnt(0)" ::: "memory");
}
}

__device__ __forceinline__ int win_map(int n) {
    if (n < 512) { const int hh = n >> 6, d = n & 63; return (hh >> 2) * 256 + (d >> 5) * 128 + (hh & 3) * 32 + (d & 31); }
    if (n < 640) { const int vh = (n - 512) >> 6, d = n & 63; return 4 * 256 + (d >> 5) * 128 + vh * 32 + (d & 31); }
    if (n < 896) return 5 * 256 + (n - 640);
    if (n < 1024) return 6 * 256 + (n - 896);
    if (n < 1056) return 6 * 256 + 128 + (n - 1024);
    const int n2 = n - 1056;
    if (n2 < 512) { const int hh = n2 >> 6, d = n2 & 63; return (2 + (hh >> 2)) * 256 + (d >> 5) * 128 + (hh & 3) * 32 + (d & 31); }
    const int vh = (n2 - 512) >> 6, d = n2 & 63; return 4 * 256 + (d >> 5) * 128 + (2 + vh) * 32 + (d & 31);
}
__device__ __forceinline__ void transpose_item(const float* W, int ldw, int k0, int n0, void* WT, int dpitch, int dk0, int rmode, int roff, LAS float* scr, int lane, int out8, const float* kscale = nullptr) {
    float tv[32];
#pragma unroll
    for (int i = 0; i < 32; ++i) { const int kk = 2 * i + (lane >> 5); tv[i] = W[(size_t)(k0 + kk) * ldw + n0 + (lane & 31)]; }
    if (kscale) {
#pragma unroll
        for (int i = 0; i < 32; ++i) tv[i] *= kscale[k0 + 2 * i + (lane >> 5)]; }
#pragma unroll
    for (int i = 0; i < 32; ++i) { const int kk = 2 * i + (lane >> 5); scr[kk * 33 + (lane & 31)] = tv[i]; }
    LDS_WAIT(); asm volatile("" ::: "memory");
    const int c = lane & 7;
#pragma unroll
    for (int j = 0; j < 4; ++j) { const int n = (lane >> 3) + 8 * j; const LAS float* s = scr + (8 * c) * 33 + n;
        const int nn = n0 + n; const int drow = (rmode == 1) ? (256 * (nn >> 7) + 128 * roff + (nn & 127)) : (rmode == 2) ? (roff + ((nn >> 6) & 1) * 256 + (nn >> 7) * 64 + (nn & 63)) : (rmode == 3) ? (win_map(n0) + n) : (roff + nn);
        const size_t eo = (size_t)drow * dpitch + dk0 + k0 + 8 * c;
        if (out8) { typedef unsigned u32x2v __attribute__((ext_vector_type(2))); u32x2v o;
            o.x = pk4_fp8(s[0 * 33] * F8_SW, s[1 * 33] * F8_SW, s[2 * 33] * F8_SW, s[3 * 33] * F8_SW); o.y = pk4_fp8(s[4 * 33] * F8_SW, s[5 * 33] * F8_SW, s[6 * 33] * F8_SW, s[7 * 33] * F8_SW);
            *(u32x2v*)((unsigned char*)WT + eo) = o; }
        else { v4u o; o.x = pk2(s[0 * 33], s[1 * 33]); o.y = pk2(s[2 * 33], s[3 * 33]); o.z = pk2(s[4 * 33], s[5 * 33]); o.w = pk2(s[6 * 33], s[7 * 33]);
            *(v4u*)((bf16*)WT + eo) = o; } }
    LDS_WAIT(); asm volatile("" ::: "memory");
}
__device__ __forceinline__ void transpose_mat(const Ctx& C, int item, const float* W, int K, int N, void* WT, int dpitch, int dk0, int rmode, int roff, int out8 = 0, const float* kscale = nullptr) {
    const int nblk = N / 32, kb = item / nblk, nb = item % nblk;
    transpose_item(W, N, 64 * kb, 32 * nb, WT, dpitch, dk0, rmode, roff, (LAS float*)(C.lds + C.wave * 16384), C.lane, out8, kscale);
}

__device__ __forceinline__ void phase_prologue(const Ctx& C) {
    float* mod = (float*)(C.ws + WS_MOD);
    if (C.vcu < 192) {
        const int L = C.vcu / 96, j0 = (C.vcu % 96) * 64;
        LAS float* sil = (LAS float*)C.lds; LAS float* part = (LAS float*)(C.lds + 40960);
        const float* cc = C.in[1]; const float* cx = C.in[3];
        for (int i = C.tid; i < 9 * 1024; i += 512) { const int r = i >> 10, k = i & 1023; const float v = (r < 8) ? cc[r * 1024 + k] : cx[k]; sil[i] = v / (1.0f + __expf(-v)); }
        __syncthreads();
        float acc[9];
#pragma unroll
        for (int r = 0; r < 9; ++r) acc[r] = 0.f;
        const float* wm = C.in[4] + (size_t)L * 1024 * 6144 + j0 + C.lane;
#pragma unroll 16
        for (int kk = 0; kk < 128; ++kk) { const int k = C.wave * 128 + kk; const float wv = wm[(size_t)k * 6144];
#pragma unroll
            for (int r = 0; r < 9; ++r) acc[r] += sil[r * 1024 + k] * wv; }
#pragma unroll
        for (int r = 0; r < 9; ++r) part[(C.wave * 9 + r) * 64 + C.lane] = acc[r];
        __syncthreads();
        for (int i = C.tid; i < 576; i += 512) { const int r = i >> 6, l = i & 63; float s = 0.f;
#pragma unroll
            for (int w = 0; w < 8; ++w) s += part[(w * 9 + r) * 64 + l];
            mod[(size_t)(L * 9 + r) * 6144 + j0 + l] = s + C.in[5][L * 6144 + j0 + l]; }
        __syncthreads();
    }
    const int gw = C.vcu * NWAVES + C.wave, NGW = C.G * NWAVES;
    bf16* win = (bf16*)(C.ws + WS_WIN); bf16* wout = (bf16*)(C.ws + WS_WOUT); unsigned char* wup = C.ws + WS_WUP; unsigned char* wdn = C.ws + WS_WDN; bf16* wub = (bf16*)(C.ws + WS_WUB);
    constexpr int I_IN = 16 * 53, I_OUT = 16 * 32, I_UP = 16 * 88, I_DN = 44 * 32, I_UQ = 4 * 12, I_UKV = 2 * 16, I_Z = 192;
    constexpr int NITEMS = 2 * I_IN + 2 * I_OUT + 2 * I_UP + I_DN + 2 * I_UQ + 2 * I_UKV + 2 * I_Z;
    for (int it = gw; it < NITEMS; it += NGW) {
        int r = it;
        if (r < 2 * I_IN) { const int L = r / I_IN; transpose_mat(C, r % I_IN, C.in[8] + (size_t)L * DM * INCOLS, DM, INCOLS, win + (size_t)L * NPROJ * DM, DM, 0, 3, 0); continue; } r -= 2 * I_IN;
        if (r < 2 * I_OUT) { const int L = r / I_OUT; transpose_mat(C, r % I_OUT, C.in[16] + (size_t)L * DM * DM, DM, DM, wout + (size_t)L * DM * DM, DM, 0, 0, 0); continue; } r -= 2 * I_OUT;
        if (r < I_UP) { transpose_mat(C, r, C.in[17], DM, FFD, wup, DM, 0, 1, 0, DENSE_F8 | DENSE_F8_UP); continue; } r -= I_UP;
        if (r < I_UP) { transpose_mat(C, r, C.in[18], DM, FFD, wup, DM, 0, 1, 1, DENSE_F8 | DENSE_F8_UP); continue; } r -= I_UP;
        if (r < I_DN) { transpose_mat(C, r, C.in[19], FFD, DM, wdn, FFD, 0, 0, 0, DENSE_F8 | DENSE_F8_DN); continue; } r -= I_DN;
        if (r < 2 * I_UQ) { const int L = r / I_UQ; transpose_mat(C, r % I_UQ, C.in[13] + (size_t)L * 256 * 384, 256, 384, wub + (size_t)L * 1024 * 384, 384, 0, 0, 0, 0, C.in[11] + L * 256); continue; } r -= 2 * I_UQ;
        if (r < 2 * I_UKV) { const int L = r / I_UKV; transpose_mat(C, r % I_UKV, C.in[14] + (size_t)L * 128 * 512, 128, 512, wub + (size_t)L * 1024 * 384, 384, 256, 2, 512, 0, C.in[12] + L * 128); continue; } r -= 2 * I_UKV;
        { const int L = r / I_Z, z = r % I_Z; *(v4u*)(win + (size_t)L * NPROJ * DM + (size_t)INCOLS * DM + (size_t)z * 512 + C.lane * 8) = (v4u){0u, 0u, 0u, 0u}; }
    }
}

__device__ __forceinline__ void norm_load(f32x4 (&v)[4], const float* xrow, const float* xadd, int lane) {
    const f32x4* xr = (const f32x4*)xrow + lane;
    if (xadd) { const f32x4* xa = (const f32x4*)xadd + lane;
#pragma unroll
        for (int j = 0; j < 4; ++j) v[j] = xr[64 * j] + xa[64 * j]; }
    else {
#pragma unroll
        for (int j = 0; j < 4; ++j) v[j] = xr[64 * j]; }
}
__device__ __forceinline__ unsigned long long* xs_row(const float* out, int n) {
    return (unsigned long long*)((unsigned char*)out + (size_t)n * 4096 + (size_t)(__builtin_popcount(n & 0x2D6) & 1) * 2048);
}
#define XS_UNPACK(dst_, d_) do { (dst_).x = bflo((unsigned)(d_)); (dst_).y = bfhi((unsigned)(d_)); (dst_).z = bflo((unsigned)((d_) >> 32)); (dst_).w = bfhi((unsigned)((d_) >> 32)); } while (0)
__device__ __forceinline__ void norm_finish(const f32x4 (&v)[4], const float* g, const float* sc, const float* sh, void* orow, int lane, int out8) {
    f32x4 gg[4], s1[4], s0[4]; float s = 0.f;
#pragma unroll
    for (int j = 0; j < 4; ++j) { gg[j] = ((const f32x4*)g)[lane + 64 * j]; s1[j] = ((const f32x4*)sc)[lane + 64 * j]; s0[j] = ((const f32x4*)sh)[lane + 64 * j]; }
#pragma unroll
    for (int j = 0; j < 4; ++j) { s += (v[j].x * v[j].x + v[j].y * v[j].y) + (v[j].z * v[j].z + v[j].w * v[j].w); }
    const float rinv = fast_rsqrt(wave_sum(s) * (1.f / DM) + EPS);
    unsigned long long* o8 = (unsigned long long*)orow + lane; unsigned* o4 = (unsigned*)orow + lane;
#pragma unroll
    for (int j = 0; j < 4; ++j) {
        const f32x4 y = v[j] * rinv * gg[j] * (s1[j] + 1.0f) + s0[j];
        if (out8) o4[64 * j] = pk4_fp8(y.x * F8_SA, y.y * F8_SA, y.z * F8_SA, y.w * F8_SA);
        else o8[64 * j] = (unsigned long long)pk2(y.x, y.y) | ((unsigned long long)pk2(y.z, y.w) << 32); }
}
__device__ __forceinline__ void norm_row(const float* xrow, const float* g, const float* sc, const float* sh, void* orow, int lane, int out8, const float* xadd = nullptr) {
    f32x4 v[4]; norm_load(v, xrow, xadd, lane); norm_finish(v, g, sc, sh, orow, lane, out8);
}
__device__ __forceinline__ void norm_finish_c(const f32x4 (&v)[4], const f32x4 (&ca)[4], const f32x4 (&cb)[4], void* orow, int lane, int out8) {
    float s = 0.f;
#pragma unroll
    for (int j = 0; j < 4; ++j) { s += (v[j].x * v[j].x + v[j].y * v[j].y) + (v[j].z * v[j].z + v[j].w * v[j].w); }
    const float rinv = fast_rsqrt(wave_sum(s) * (1.f / DM) + EPS);
    unsigned long long* o8 = (unsigned long long*)orow + lane; unsigned* o4 = (unsigned*)orow + lane;
#pragma unroll
    for (int j = 0; j < 4; ++j) {
        const f32x4 y = v[j] * rinv * ca[j] + cb[j];
        if (out8) o4[64 * j] = pk4_fp8(y.x * F8_SA, y.y * F8_SA, y.z * F8_SA, y.w * F8_SA);
        else o8[64 * j] = (unsigned long long)pk2(y.x, y.y) | ((unsigned long long)pk2(y.z, y.w) << 32); }
}
__device__ __forceinline__ void phase_norm(const Ctx& C, int L, int which, const float* xlat, const float* xctx, void* H, int out8, const float* ctxadd = nullptr, const bf16* latadd = nullptr, float* xout = nullptr, bool xs_in = false) {
    const int gw = C.vcu * NWAVES + C.wave, NGW = C.G * NWAVES;
    const float* g = (which ? C.in[7] : C.in[6]) + L * DM;
    const float* mod = (const float*)(C.ws + WS_MOD) + (size_t)L * 9 * 6144 + (which ? 3072 : 0);
    {
        const int rpw = (NLAT + NGW - 1) / NGW;
        const int nbeg = gw * rpw, nend = (nbeg + rpw < NLAT) ? nbeg + rpw : NLAT;
        f32x4 pa[2][4]; unsigned long long px[2][4], pd[2][4];
#define PL_LOAD(S_, n_) do { \
        if (xs_in) { const unsigned long long* xr_ = xs_row(xlat, (n_)) + C.lane; _Pragma("unroll") for (int j = 0; j < 4; ++j) px[S_][j] = xr_[64 * j]; } \
        else { const f32x4* xr_ = (const f32x4*)(xlat + (size_t)(n_) * DM) + C.lane; _Pragma("unroll") for (int j = 0; j < 4; ++j) pa[S_][j] = xr_[64 * j]; } \
        if (latadd) { const unsigned long long* dr_ = (const unsigned long long*)(latadd + (size_t)(n_) * DM) + C.lane; _Pragma("unroll") for (int j = 0; j < 4; ++j) pd[S_][j] = dr_[64 * j]; } } while (0)
        f32x4 ca[4], cb[4]; int bprev = -1;
#define PN_ROW(S_, n_) do { \
            f32x4 v[4]; \
            _Pragma("unroll") for (int j = 0; j < 4; ++j) { \
                if (xs_in) XS_UNPACK(v[j], px[S_][j]); else v[j] = pa[S_][j]; \
                if (latadd) { f32x4 d; XS_UNPACK(d, pd[S_][j]); v[j] = v[j] + d; } } \
            if ((n_) + 2 < nend) PL_LOAD(S_, (n_) + 2); \
            const int b = (n_) / SEQ; \
            if (b != bprev) { bprev = b; const float* md = mod + (size_t)b * 6144; \
                _Pragma("unroll") for (int j = 0; j < 4; ++j) { ca[j] = ((const f32x4*)g)[C.lane + 64 * j] * (((const f32x4*)(md + 1024))[C.lane + 64 * j] + 1.0f); cb[j] = ((const f32x4*)md)[C.lane + 64 * j]; } } \
            const int m = b * TT + CTXL + ((n_) - b * SEQ); \
            norm_finish_c(v, ca, cb, (unsigned char*)H + (size_t)m * DM * (out8 ? 1 : 2), C.lane, out8); \
            if (xout) { unsigned long long* xo = xs_row(xout, (n_)) + C.lane; \
                _Pragma("unroll") for (int j = 0; j < 4; ++j) xo[64 * j] = (unsigned long long)pk2(v[j].x, v[j].y) | ((unsigned long long)pk2(v[j].z, v[j].w) << 32); } } while (0)
        if (nbeg < nend) PL_LOAD(0, nbeg);
        if (nbeg + 1 < nend) PL_LOAD(1, nbeg + 1);
        for (int n = nbeg; n < nend; n += 2) {
            PN_ROW(0, n);
            if (n + 1 < nend) PN_ROW(1, n + 1);
        }
#undef PN_ROW
#undef PL_LOAD
    }
    {
        const float* md = mod + (size_t)8 * 6144;
        for (int r = gw; r < NB * CTXL; r += NGW) {
            const int m = (r / CTXL) * TT + r % CTXL;
            norm_row(xctx + (size_t)r * DM, g, md + 1024, md, (unsigned char*)H + (size_t)m * DM * (out8 ? 1 : 2), C.lane, out8, ctxadd ? ctxadd + (size_t)r * DM : nullptr);
        }
    }
}

__device__ __forceinline__ void phase_norm_lat(const Ctx& C, int L, int which, const float* xlat, void* H, int c0) {
    const int gw = (C.wg - c0) * NWAVES + C.wave, NGW = (C.G - c0) * NWAVES;
    const float* g = (which ? C.in[7] : C.in[6]) + L * DM;
    const float* mod = (const float*)(C.ws + WS_MOD) + (size_t)L * 9 * 6144 + (which ? 3072 : 0);
    for (int n = gw; n < NLAT; n += NGW) {
        const int b = n / SEQ, m = b * TT + CTXL + n % SEQ;
        const float* md = mod + (size_t)b * 6144;
        norm_row(xlat + (size_t)n * DM, g, md + 1024, md, (unsigned char*)H + (size_t)m * DM * 2, C.lane, 0);
    }
}
__device__ __forceinline__ void phase_norm_ctx(const Ctx& C, int L, int which, const float* xctx, void* H) {
    const int gw = C.vcu * NWAVES + C.wave, NGW = C.G * NWAVES;
    const float* g = (which ? C.in[7] : C.in[6]) + L * DM;
    const float* md = (const float*)(C.ws + WS_MOD) + (size_t)L * 9 * 6144 + (which ? 3072 : 0) + (size_t)8 * 6144;
    for (int r = gw; r < NB * CTXL; r += NGW) {
        const int m = (r / CTXL) * TT + r % CTXL;
        norm_row(xctx + (size_t)r * DM, g, md + 1024, md, (unsigned char*)H + (size_t)m * DM * 2, C.lane, 0);
    }
}

__device__ __forceinline__ void build_rope_tables(const Ctx& C, LAS float* tab64, LAS float* tab32) {
    for (int i = C.tid; i < 1024; i += 512) { const int pos = i >> 4, f = i & 15; const float invf = exp2f(-(float)f * (13.287712379549449f / 16.0f)); const float rev = ((float)pos * invf) * 0.15915494309189535f;
        tab64[2 * i] = __builtin_amdgcn_cosf(rev); tab64[2 * i + 1] = __builtin_amdgcn_sinf(rev); }
    for (int i = C.tid; i < 512; i += 512) { const int pos = i >> 3, f = i & 7; const float invf = exp2f(-(float)f * (13.287712379549449f / 8.0f)); const float rev = ((float)pos * invf) * 0.15915494309189535f;
        tab32[2 * i] = __builtin_amdgcn_cosf(rev); tab32[2 * i + 1] = __builtin_amdgcn_sinf(rev); }
    __syncthreads();
}
__device__ __forceinline__ size_t kimg_off(int t, int c, int tile_bytes) { return (size_t)(t >> 6) * tile_bytes + c * 1024 + (t & 63) * 16; }
__device__ __forceinline__ size_t vimg_off(int t, int c) { return (size_t)(t >> 6) * 8192 + (c >> 2) * 4096 + ((t & 63) >> 4) * 1024 + (t & 15) * 64 + (c & 3) * 16; }

__device__ __forceinline__ void phase_attn(const Ctx& C, int L) {
    const bf16* QA = (const bf16*)(C.ws + WS_QA); const bf16* QB = (const bf16*)(C.ws + WS_QB); const bf16* QC = (const bf16*)(C.ws + WS_QC);
    const unsigned char* KA = C.ws + WS_KA; const unsigned char* VA = C.ws + WS_VA; const unsigned char* KB = C.ws + WS_KB; const unsigned char* VB = C.ws + WS_VB;
    const unsigned char* KC = C.ws + WS_KC; const unsigned char* VC = C.ws + WS_VC;
    bf16* mix = (bf16*)(C.ws + WS_H);
    const float* sinks = C.in[15] + L * 6;
    const int with_ctx = (L == 0);
    for (int idx = C.vcu; idx < 512 + (with_ctx ? 32 : 0); idx += C.G) {
        att::UnitDesc u; int b, h, row0;
        if (idx < 512) { b = idx >> 6; h = (idx >> 4) & 3; row0 = CTXL + (idx & 15) * 256; u.n0 = KTILES; u.qpos0 = (idx & 15) * 256; }
        else { const int j = idx - 512; b = j >> 2; h = j & 3; row0 = 0; u.n0 = 4; u.qpos0 = 0; }
        u.Q = QB + ((size_t)(b * 4 + h) * TT + row0) * 96; u.Kimg = KB + (size_t)(b * 4 + h) * KTILES * 12288; u.Vimg = VB + (size_t)(b * 4 + h) * KTILES * 8192;
        u.O = mix + ((size_t)b * TT + row0) * DM + 384 + h * 64; u.s1t0 = 0; u.n1 = 0; u.minit = att::NEGBIG; u.linit = 0.f;
        if (idx < 512) att::rope_q96((bf16*)u.Q, u.qpos0);
        att::unit<96, false>(C.lds, u);
    }
    for (int idx = C.vcu; idx < 768 + (with_ctx ? 96 : 0); idx += C.G) {
        att::UnitDesc u; int b, h, row0, isC = 0;
        if (idx < 768) { b = idx / 96; h = (idx >> 4) % 6; row0 = CTXL + (idx & 15) * 256; u.n0 = KTILES; }
        else { int j = idx - 768; if (j >= 48) { j -= 48; isC = 1; } b = j / 6; h = j % 6; row0 = 0; u.n0 = 4; }
        const int hk = h / 3;
        u.Q = (isC ? QC : QA) + ((size_t)(b * 6 + h) * TT + row0) * 64; u.Kimg = (isC ? KC : KA) + (size_t)(b * 2 + hk) * KTILES * 8192; u.Vimg = (isC ? VC : VA) + (size_t)(b * 2 + hk) * KTILES * 8192;
        u.O = mix + ((size_t)b * TT + row0) * DM + (isC ? 640 : 0) + h * 64; u.s1t0 = 0; u.n1 = 0; u.qpos0 = 0;
        u.minit = isC ? sinks[h] * LOG2E : att::NEGBIG; u.linit = isC ? 1.f : 0.f;
        att::unit<64, false>(C.lds, u);
    }
    for (int idx = C.vcu; idx < 768; idx += C.G) {
        att::UnitDesc u; const int b = idx / 96, h = (idx >> 4) % 6, qb = idx & 15, hk = h / 3, row0 = CTXL + qb * 256;
        const int lt0 = 4 * qb - 2, ls = lt0 < 0 ? 0 : lt0, le = (lt0 + 10 > 64) ? 64 : lt0 + 10;
        u.Q = QC + ((size_t)(b * 6 + h) * TT + row0) * 64; u.Kimg = KC + (size_t)(b * 2 + hk) * KTILES * 8192; u.Vimg = VC + (size_t)(b * 2 + hk) * KTILES * 8192;
        u.O = mix + ((size_t)b * TT + row0) * DM + 640 + h * 64; u.n0 = 4; u.s1t0 = 4 + ls; u.n1 = le - ls; u.qpos0 = qb * 256;
        u.minit = sinks[h] * LOG2E; u.linit = 1.f;
        att::unit<64, true>(C.lds, u);
    }
}

constexpr int MOE_I_UP = 16 * 112, MOE_I_DN = 56 * 32, MOE_ITEMS = NEXP * (2 * MOE_I_UP + MOE_I_DN);
struct MoeItem { const float* Wb; int ldw; unsigned char* WT; int dpitch, k0, n0, inter, roff; };
__device__ __forceinline__ MoeItem moe_item_desc(const Ctx& C, int it) {
    unsigned char* wmup = C.ws + WS_WMUP; unsigned char* wmdn = C.ws + WS_WMDN;
    const int e = it / (2 * MOE_I_UP + MOE_I_DN); int r = it % (2 * MOE_I_UP + MOE_I_DN);
    MoeItem d;
    if (r < 2 * MOE_I_UP) { const int w3 = r >= MOE_I_UP; if (w3) r -= MOE_I_UP; const int nblk = FFE / 32, kb = r / nblk, nb = r % nblk;
        d.ldw = FFE; d.k0 = 64 * kb; d.n0 = 32 * nb; d.Wb = (w3 ? C.in[22] : C.in[21]) + (size_t)e * DM * FFE + (size_t)d.k0 * FFE + d.n0; d.WT = wmup + (size_t)e * 2 * FFE * DM; d.dpitch = DM; d.inter = 1; d.roff = w3; }
    else { r -= 2 * MOE_I_UP; const int nblk = DM / 32, kb = r / nblk, nb = r % nblk;
        d.ldw = DM; d.k0 = 64 * kb; d.n0 = 32 * nb; d.Wb = C.in[23] + (size_t)e * FFE * DM + (size_t)d.k0 * DM + d.n0; d.WT = wmdn + (size_t)e * DM * FFE; d.dpitch = FFE; d.inter = 0; d.roff = 0; }
    return d;
}
__device__ __forceinline__ void moe_item_load(const MoeItem& d, float (&tv)[32], int lane) {
#pragma unroll
    for (int i = 0; i < 32; ++i) tv[i] = d.Wb[(unsigned)((2 * i + (lane >> 5)) * d.ldw + (lane & 31))];
}
__device__ __forceinline__ void moe_item_store(const MoeItem& d, const float (&tv)[32], LAS float* scr, int lane) {
#pragma unroll
    for (int i = 0; i < 32; ++i) { const int kk = 2 * i + (lane >> 5); scr[kk * 33 + (lane & 31)] = tv[i]; }
    LDS_WAIT(); asm volatile("" ::: "memory");
    const int c = lane & 7;
#pragma unroll
    for (int j = 0; j < 4; ++j) { const int n = (lane >> 3) + 8 * j; const LAS float* sp = scr + (8 * c) * 33 + n;
        const int nn = d.n0 + n; const int drow = d.inter ? (256 * (nn >> 7) + 128 * d.roff + (nn & 127)) : nn;
        typedef unsigned u32x2v __attribute__((ext_vector_type(2))); u32x2v o;
        o.x = pk4_fp8(sp[0 * 33] * F8_SW, sp[1 * 33] * F8_SW, sp[2 * 33] * F8_SW, sp[3 * 33] * F8_SW); o.y = pk4_fp8(sp[4 * 33] * F8_SW, sp[5 * 33] * F8_SW, sp[6 * 33] * F8_SW, sp[7 * 33] * F8_SW);
        *(u32x2v*)(d.WT + (size_t)drow * d.dpitch + d.k0 + 8 * c) = o; }
    LDS_WAIT(); asm volatile("" ::: "memory");
}
__device__ __forceinline__ void moe_convert_two(const Ctx& C, int it0, int it1) {
    LAS float* scr = (LAS float*)(C.lds + C.wave * 16384);
    const bool v0 = it0 < MOE_ITEMS, v1 = it1 < MOE_ITEMS;
    float ta[32], tb[32];
    MoeItem d0, d1;
    if (v0) { d0 = moe_item_desc(C, it0); moe_item_load(d0, ta, C.lane); }
    if (v1) { d1 = moe_item_desc(C, it1); moe_item_load(d1, tb, C.lane); }
    if (v0) moe_item_store(d0, ta, scr, C.lane);
    if (v1) moe_item_store(d1, tb, scr, C.lane);
}
__device__ __forceinline__ void moe_convert_steal(const Ctx& C, unsigned* ctr, unsigned* done, int need_done, bool count_done) {
    LAS int* sh = (LAS int*)(C.lds + 130048);
    if (count_done && C.tid == 0) __hip_atomic_fetch_add(done, 1u, __ATOMIC_RELAXED, __HIP_MEMORY_SCOPE_AGENT);
    for (;;) {
        __syncthreads();
        if (C.tid == 0) { int base = -1;
            if (!count_done || (int)__hip_atomic_load(done, __ATOMIC_RELAXED, __HIP_MEMORY_SCOPE_AGENT) < need_done) base = (int)__hip_atomic_fetch_add(ctr, 16u, __ATOMIC_RELAXED, __HIP_MEMORY_SCOPE_AGENT);
            sh[0] = base; }
        __syncthreads();
        const int base = sh[0];
        if (base < 0 || base >= MOE_ITEMS) break;
        moe_convert_two(C, base + C.wave, base + C.wave + NWAVES);
    }
    __syncthreads();
}

__device__ __forceinline__ void phase_route1(const Ctx& C) {
    LAS f32x4* wr0 = (LAS f32x4*)C.lds; LAS f32x4* wr1 = wr0 + 1024;
    LAS int* hist = (LAS int*)(C.lds + 32768);
    const f32x4* wrg = (const f32x4*)C.in[20];
    for (int k = C.tid; k < 1024; k += 512) { const int slot = ((k >> 8) * 4 + (k & 3)) * 64 + ((k & 255) >> 2); wr0[slot] = wrg[2 * k]; wr1[slot] = wrg[2 * k + 1]; }
    if (C.tid < 8) hist[C.tid] = 0;
    __syncthreads();
    const float* g = C.in[7] + DM; const float* mod = (const float*)(C.ws + WS_MOD) + (size_t)9 * 6144 + 3072;
    unsigned char* H8 = C.ws + WS_H;
    int* tope = (int*)(C.ws + WS_RT + RT_TOPE); float* gate = (float*)(C.ws + WS_RT + RT_GATE);
    const int TPW = NLAT / C.G;
    f32x4 ca[4], cb[4];
    { const float* md = mod + (size_t)((C.wg * TPW) / SEQ) * 6144;
#pragma unroll
      for (int j = 0; j < 4; ++j) { ca[j] = ((const f32x4*)g)[C.lane + 64 * j] * (((const f32x4*)(md + 1024))[C.lane + 64 * j] + 1.0f); cb[j] = ((const f32x4*)md)[C.lane + 64 * j]; } }
    unsigned long long rx[4], rd[4];
#define R1_LOAD(n_) do { const unsigned long long* xr_ = xs_row(C.out, (n_)) + C.lane; const unsigned long long* dr_ = (const unsigned long long*)((const bf16*)(C.ws + WS_D1) + (size_t)(n_) * DM) + C.lane; \
        _Pragma("unroll") for (int j = 0; j < 4; ++j) { rx[j] = xr_[64 * j]; rd[j] = dr_[64 * j]; } } while (0)
    R1_LOAD(C.wg * TPW + C.wave);
    for (int i = C.wave; i < TPW; i += NWAVES) {
        const int n = C.wg * TPW + i;
        f32x4 v[4]; float s = 0.f;
#pragma unroll
        for (int j = 0; j < 4; ++j) { f32x4 d; XS_UNPACK(v[j], rx[j]); XS_UNPACK(d, rd[j]); v[j] = v[j] + d; s += (v[j].x * v[j].x + v[j].y * v[j].y) + (v[j].z * v[j].z + v[j].w * v[j].w); }
        if (i + NWAVES < TPW) R1_LOAD(n + NWAVES);
        const float rinv = fast_rsqrt(wave_sum(s) * (1.f / DM) + EPS);
        unsigned* o8 = (unsigned*)(H8 + (size_t)n * DM) + C.lane;
        float lg[8];
#pragma unroll
        for (int e = 0; e < 8; ++e) lg[e] = 0.f;
#pragma unroll
        for (int j = 0; j < 4; ++j) {
            const f32x4 y = v[j] * rinv * ca[j] + cb[j];
            o8[64 * j] = pk4_fp8(y.x * F8_SA, y.y * F8_SA, y.z * F8_SA, y.w * F8_SA);
#pragma unroll
            for (int q = 0; q < 4; ++q) { const f32x4 w0 = wr0[(4 * j + q) * 64 + C.lane], w1 = wr1[(4 * j + q) * 64 + C.lane]; const float yy = y[q];
                lg[0] += yy * w0.x; lg[1] += yy * w0.y; lg[2] += yy * w0.z; lg[3] += yy * w0.w; lg[4] += yy * w1.x; lg[5] += yy * w1.y; lg[6] += yy * w1.z; lg[7] += yy * w1.w; } }
#pragma unroll
        for (int e = 0; e < 8; ++e) lg[e] = wave_sum(lg[e]);
        int e1 = 0; float l1 = lg[0];
#pragma unroll
        for (int e = 1; e < 8; ++e) if (lg[e] > l1) { l1 = lg[e]; e1 = e; }
        int e2 = -1; float l2 = -3.0e38f;
#pragma unroll
        for (int e = 0; e < 8; ++e) if (e != e1 && lg[e] > l2) { l2 = lg[e]; e2 = e; }
        const float g2 = 1.0f / (1.0f + __expf(l1 - l2)), g1 = 1.0f - g2;
        if (C.lane == 0) { tope[2 * n] = e1; tope[2 * n + 1] = e2; gate[2 * n] = g1; gate[2 * n + 1] = g2; __hip_atomic_fetch_add(hist + e1, 1, __ATOMIC_RELAXED, __HIP_MEMORY_SCOPE_WORKGROUP); __hip_atomic_fetch_add(hist + e2, 1, __ATOMIC_RELAXED, __HIP_MEMORY_SCOPE_WORKGROUP); }
    }
    __syncthreads();
    if (C.tid < 8) ((int*)(C.ws + WS_RT + RT_HIST))[C.wg * 8 + C.tid] = hist[C.tid];
    __syncthreads();
    moe_convert_steal(C, (unsigned*)(C.ws + WS_CTL) + CW_STEAL, (unsigned*)(C.ws + WS_CTL) + CW_DONE, 0x7fffffff, false);
}

__device__ __forceinline__ void phase_route2(const Ctx& C) {
    LAS int* hl = (LAS int*)C.lds;
    LAS int* cnt = (LAS int*)(C.lds + 16384); LAS int* pre = cnt + 8; LAS int* off = cnt + 16;
    LAS int* ep = (LAS int*)(C.lds + 20480); LAS int* posl = ep + 512;
    const int* hist = (const int*)(C.ws + WS_RT + RT_HIST);
    for (int i = C.tid; i < C.G * 8; i += 512) hl[i] = hist[i];
    __syncthreads();
    if (C.tid < 8) { int s = 0, p = 0; for (int w = 0; w < C.G; ++w) { const int hv = hl[w * 8 + C.tid]; if (w < C.wg) p += hv; s += hv; } cnt[C.tid] = s; pre[C.tid] = p; }
    __syncthreads();
    if (C.tid == 0) { int o = 0; for (int e = 0; e < 8; ++e) { off[e] = o; o += (cnt[e] + 255) & ~255; } off[8] = o; }
    __syncthreads();
    const int TPW = NLAT / C.G, NP = 2 * TPW;
    const int* tope = (const int*)(C.ws + WS_RT + RT_TOPE); int* posg = (int*)(C.ws + WS_RT + RT_POS);
    for (int p = C.tid; p < NP; p += 512) ep[p] = tope[2 * (C.wg * TPW) + p];
    __syncthreads();
    for (int p = C.tid; p < NP; p += 512) { const int e = ep[p]; int rank = 0; for (int q = 0; q < p; ++q) rank += (ep[q] == e) ? 1 : 0; const int pos = off[e] + pre[e] + rank; posl[p] = pos; posg[2 * (C.wg * TPW) + p] = pos; }
    __syncthreads();
    const unsigned char* H8 = C.ws + WS_H; unsigned char* HFS = C.ws + WS_HFS;
    for (int i0 = C.wave; i0 < TPW; i0 += 8 * NWAVES) {
        v4u a[8];
#pragma unroll
        for (int k = 0; k < 8; ++k) { const int i = i0 + k * NWAVES; if (i < TPW) a[k] = ((const v4u*)(H8 + (size_t)(C.wg * TPW + i) * DM))[C.lane]; }
#pragma unroll
        for (int k = 0; k < 8; ++k) { const int i = i0 + k * NWAVES; if (i < TPW) { ((v4u*)(HFS + (size_t)posl[2 * i] * DM))[C.lane] = a[k]; ((v4u*)(HFS + (size_t)posl[2 * i + 1] * DM))[C.lane] = a[k]; } }
    }
    int* tile_e = (int*)(C.ws + WS_RT + RT_TILEE);
    if (C.wg == 0) { for (int tl = C.tid; tl < 272; tl += 512) { int e = 7; for (int q = 7; q >= 0; --q) if (tl * 256 < off[q + 1]) e = q; tile_e[tl] = e; } if (C.tid == 0) tile_e[272] = off[8] >> 8; }
    if (C.wg < 8) { const int e = C.wg; for (int r = off[e] + cnt[e] + C.wave; r < off[e + 1]; r += NWAVES) ((v4u*)(HFS + (size_t)r * DM))[C.lane] = (v4u){0u, 0u, 0u, 0u}; }
}

constexpr int FIN_BLK = 64, FIN_TAILROW = MOE_CH * (MOE_NCH - 1) * 256;
struct FinTok { f32x4 x[4], gg[4]; unsigned long long a[4], c[4]; };
__device__ __forceinline__ void fin_load(const Ctx& C, FinTok& t, int n, int p0, int p1) {
    const unsigned long long* xr = xs_row(C.out, n) + C.lane; const bf16* Y = (const bf16*)(C.ws + WS_Y);
    const unsigned long long* y0 = (const unsigned long long*)(Y + (size_t)p0 * DM) + C.lane; const unsigned long long* y1 = (const unsigned long long*)(Y + (size_t)p1 * DM) + C.lane;
    const float* gt = (const float*)(C.ws + WS_MOD) + (size_t)9 * 6144 + 5120 + (size_t)(n / SEQ) * 6144;
    const unsigned long long* dr = (const unsigned long long*)((const bf16*)(C.ws + WS_D1) + (size_t)n * DM) + C.lane;
#pragma unroll
    for (int j = 0; j < 4; ++j) { const unsigned long long xb = xr[64 * j]; f32x4 x; XS_UNPACK(x, xb); const unsigned long long d = dr[64 * j]; t.a[j] = y0[64 * j]; t.c[j] = y1[64 * j]; t.gg[j] = ((const f32x4*)gt)[C.lane + 64 * j];
        t.x[j].x = x.x + bflo((unsigned)d); t.x[j].y = x.y + bfhi((unsigned)d); t.x[j].z = x.z + bflo((unsigned)(d >> 32)); t.x[j].w = x.w + bfhi((unsigned)(d >> 32)); }
}
__device__ __forceinline__ void fin_finish(const Ctx& C, const FinTok& t, int n, float g0, float g1, const f32x4 (&fnv)[4]) {
    f32x4* xr = (f32x4*)(C.out + (size_t)n * DM) + C.lane;
    f32x4 v[4]; float s = 0.f;
#pragma unroll
    for (int j = 0; j < 4; ++j) { const unsigned long long a = t.a[j], c = t.c[j]; const f32x4 gg = t.gg[j];
        f32x4 ya, yc; ya.x = bflo((unsigned)a); ya.y = bfhi((unsigned)a); ya.z = bflo((unsigned)(a >> 32)); ya.w = bfhi((unsigned)(a >> 32));
        yc.x = bflo((unsigned)c); yc.y = bfhi((unsigned)c); yc.z = bflo((unsigned)(c >> 32)); yc.w = bfhi((unsigned)(c >> 32));
        v[j] = t.x[j] + gg * (ya * g0 + yc * g1); s += (v[j].x * v[j].x + v[j].y * v[j].y) + (v[j].z * v[j].z + v[j].w * v[j].w); }
    const float rinv = fast_rsqrt(wave_sum(s) * (1.f / DM) + EPS);
#pragma unroll
    for (int j = 0; j < 4; ++j) xr[64 * j] = v[j] * rinv * fnv[j];
}
__device__ __forceinline__ void fin_row_acc(const Ctx& C, int p, float g, f32x4 (&y)[4]) {
    if (p < FIN_TAILROW) { const unsigned long long* yr = (const unsigned long long*)((const bf16*)(C.ws + WS_Y) + (size_t)p * DM) + C.lane;
#pragma unroll
        for (int j = 0; j < 4; ++j) { const unsigned long long a = yr[64 * j]; y[j].x += g * bflo((unsigned)a); y[j].y += g * bfhi((unsigned)a); y[j].z += g * bflo((unsigned)(a >> 32)); y[j].w += g * bfhi((unsigned)(a >> 32)); } }
    else for (int ks = 0; ks < MOE_TAILK; ++ks) { const unsigned long long* yr = (const unsigned long long*)((const bf16*)(C.ws + WS_YT) + ((size_t)ks * 2048 + (p - FIN_TAILROW)) * DM) + C.lane;
#pragma unroll
        for (int j = 0; j < 4; ++j) { const unsigned long long a = yr[64 * j]; y[j].x += g * bflo((unsigned)a); y[j].y += g * bfhi((unsigned)a); y[j].z += g * bflo((unsigned)(a >> 32)); y[j].w += g * bfhi((unsigned)(a >> 32)); } }
}
__device__ __forceinline__ void fin_tail_token(const Ctx& C, int n, int p0, int p1, float g0, float g1) {
    const float* gt = (const float*)(C.ws + WS_MOD) + (size_t)9 * 6144 + 5120 + (size_t)(n / SEQ) * 6144; const float* fn = C.in[24];
    f32x4* xr = (f32x4*)(C.out + (size_t)n * DM) + C.lane; const unsigned long long* xs = xs_row(C.out, n) + C.lane;
    f32x4 y[4];
#pragma unroll
    for (int j = 0; j < 4; ++j) y[j] = (f32x4){0.f, 0.f, 0.f, 0.f};
    fin_row_acc(C, p0, g0, y); fin_row_acc(C, p1, g1, y);
    f32x4 v[4]; float s = 0.f;
#pragma unroll
    for (int j = 0; j < 4; ++j) { const f32x4 gg = ((const f32x4*)gt)[C.lane + 64 * j]; const unsigned long long d = ((const unsigned long long*)((const bf16*)(C.ws + WS_D1) + (size_t)n * DM) + C.lane)[64 * j];
        const unsigned long long xb = xs[64 * j]; f32x4 xd; XS_UNPACK(xd, xb); xd.x += bflo((unsigned)d); xd.y += bfhi((unsigned)d); xd.z += bflo((unsigned)(d >> 32)); xd.w += bfhi((unsigned)(d >> 32));
        v[j] = xd + gg * y[j]; s += (v[j].x * v[j].x + v[j].y * v[j].y) + (v[j].z * v[j].z + v[j].w * v[j].w); }
    const float rinv = fast_rsqrt(wave_sum(s) * (1.f / DM) + EPS);
#pragma unroll
    for (int j = 0; j < 4; ++j) xr[64 * j] = v[j] * rinv * ((const f32x4*)fn)[C.lane + 64 * j];
}
__device__ __forceinline__ void final_tokens(const Ctx& C, int nbase, int nstride, int cnt, bool want_tail) {
    const int* posg = (const int*)(C.ws + WS_RT + RT_POS); const float* gate = (const float*)(C.ws + WS_RT + RT_GATE);
    int p0v = 0, p1v = 0; float g0v = 0.f, g1v = 0.f; bool sel = false;
    if (C.lane < cnt) { const int n = nbase + C.lane * nstride; p0v = posg[2 * n]; p1v = posg[2 * n + 1]; g0v = gate[2 * n]; g1v = gate[2 * n + 1]; sel = ((p0v >= FIN_TAILROW) || (p1v >= FIN_TAILROW)) == want_tail; }
    unsigned long long todo = __ballot(sel);
    f32x4 fnv[4];
#pragma unroll
    for (int j = 0; j < 4; ++j) fnv[j] = ((const f32x4*)C.in[24])[C.lane + 64 * j];
    if (want_tail) {
        while (todo) { const int k = __builtin_ctzll(todo); todo &= todo - 1;
            fin_tail_token(C, nbase + k * nstride, __builtin_amdgcn_readlane(p0v, k), __builtin_amdgcn_readlane(p1v, k),
                           __builtin_bit_cast(float, __builtin_amdgcn_readlane(__builtin_bit_cast(int, g0v), k)), __builtin_bit_cast(float, __builtin_amdgcn_readlane(__builtin_bit_cast(int, g1v), k))); }
        return;
    }
    while (todo) {
        const int k0 = __builtin_ctzll(todo); todo &= todo - 1;
        const int n0 = nbase + k0 * nstride; const int a0 = __builtin_amdgcn_readlane(p0v, k0), b0 = __builtin_amdgcn_readlane(p1v, k0);
        const float ga0 = __builtin_bit_cast(float, __builtin_amdgcn_readlane(__builtin_bit_cast(int, g0v), k0)), gb0 = __builtin_bit_cast(float, __builtin_amdgcn_readlane(__builtin_bit_cast(int, g1v), k0));
        FinTok t0; fin_load(C, t0, n0, a0, b0);
        if (todo) {
            const int k1 = __builtin_ctzll(todo); todo &= todo - 1;
            const int n1 = nbase + k1 * nstride; const int a1 = __builtin_amdgcn_readlane(p0v, k1), b1 = __builtin_amdgcn_readlane(p1v, k1);
            const float ga1 = __builtin_bit_cast(float, __builtin_amdgcn_readlane(__builtin_bit_cast(int, g0v), k1)), gb1 = __builtin_bit_cast(float, __builtin_amdgcn_readlane(__builtin_bit_cast(int, g1v), k1));
            FinTok t1; fin_load(C, t1, n1, a1, b1);
            fin_finish(C, t0, n0, ga0, gb0, fnv); fin_finish(C, t1, n1, ga1, gb1, fnv);
        } else fin_finish(C, t0, n0, ga0, gb0, fnv);
    }
}
__device__ __forceinline__ void final_steal(const Ctx& C) {
    LAS int* sh = (LAS int*)(C.lds + 130048);
    unsigned* ctr = (unsigned*)(C.ws + WS_CTL) + CW_FINAL;
    for (;;) {
        __syncthreads();
        if (C.tid == 0) sh[0] = (int)__hip_atomic_fetch_add(ctr, 1u, __ATOMIC_RELAXED, __HIP_MEMORY_SCOPE_AGENT);
        __syncthreads();
        const int blk = sh[0];
        if (blk >= NLAT / FIN_BLK) break;
        final_tokens(C, blk * FIN_BLK + C.wave * (FIN_BLK / NWAVES), 1, FIN_BLK / NWAVES, false);
    }
    __syncthreads();
}
__device__ __forceinline__ void phase_final(const Ctx& C) {
    final_steal(C);
    const int gw = C.vcu * NWAVES + C.wave, NGW = C.G * NWAVES;
    final_tokens(C, gw, NGW, NLAT / NGW, true);
}
#ifndef MK_SPLIT
#define MK_SPLIT 0
#endif
constexpr int N_PHASES = 31;
#define GP_ALIGN true
#define GP_SP2 true


#ifndef PH_MASK
#define PH_MASK 0x7fffffffu
#endif
#define IN(k) (((PH_MASK >> (k)) & 1u) && lo <= (k) && (k) < hi)
#define SEAM(k) do { if (IN(k) && IN((k) + 1)) xcd_barrier(bar); } while (0)
#ifndef PH_REP
#define PH_REP 0u
#endif
#ifndef PH_URE
#define PH_URE 0u
#endif
#define UREP(k) (1 + (int)((PH_URE >> (k)) & 1u))
#define REPEAT(k) for (int rep_ = 0; rep_ < 1 + (int)((PH_REP >> (k)) & 1u); ++rep_)
#ifndef MK_STEAL
#define MK_STEAL 1
#endif
#define STEAL(k) do { if (MK_STEAL) moe_convert_steal(C, (unsigned*)(C.ws + WS_CTL) + CW_STEAL, (unsigned*)(C.ws + WS_CTL) + CW_DONE + 64 * (k), (int)C.G, true); } while (0)
template <int L>
__device__ __forceinline__ void layer_phases(const Ctx& C0, const Args& args, const XcdBarrier& bar, const int lo, const int hi) {
    Ctx C = C0; asm volatile("" : "+v"(C.tid), "+v"(C.lane));
    unsigned char* ws = C.ws;
    float* xc = (float*)(ws + WS_XC);
    bf16* Hb = (bf16*)(ws + WS_H);
    const float* modall = (const float*)(ws + WS_MOD);
        const int pb = 1 + 10 * L;
        const float* xlat = (L == 0) ? args.in[0] : (const float*)args.out;
        const float* xctx = (L == 0) ? args.in[2] : (const float*)xc;
        const float* modL = modall + (size_t)L * 9 * 6144;
        if (IN(pb + 0)) { REPEAT(pb + 0) phase_norm(C, L, 0, xlat, xctx, Hb, 0, L == 1 ? (const float*)(ws + WS_PART) : nullptr, L == 1 ? (const bf16*)(ws + WS_D2) : nullptr, L == 1 ? args.out : nullptr, L == 1); SEAM(pb + 0); }
        if (IN(pb + 1)) {
            LAS float* tab64 = (LAS float*)(C.lds + LDSCTL_OFF + 1024); LAS float* tab32 = tab64 + 2048;
            build_rope_tables(C, tab64, tab32);
            pg8::Gemm g{(const pg8::bf16_t*)Hb, (const pg8::bf16_t*)(ws + WS_WIN) + (size_t)L * NPROJ * DM, MROWS, NPROJ, DM};
            TileSched S; S.init(MROWS / 256, NPROJ / 256, C.G, C.wg, 0, UREP(pb + 1));
            EpiProj E{(pg8::bf16_t*)(ws + WS_QA), ws + WS_KA, ws + WS_VA, (pg8::bf16_t*)(ws + WS_QC), ws + WS_KC, ws + WS_VC, (pg8::bf16_t*)(ws + WS_CQKV), ws + WS_KB, (float*)(ws + WS_SSQ), (float*)(ws + WS_SSK),
                      args.in[9] + L * 64, args.in[10] + L * 64, tab64, tab32};
            REPEAT(pb + 1) pg8::gemm_phase<EpiProj, TileSched, GP_ALIGN, GP_SP2>(C.lds, g, S, E);
            STEAL(pb + 1);
            if (IN(pb + 1) && IN(pb + 3)) xcd_barrier(bar);
        }
        if (IN(pb + 3)) {
            int kub = 384; asm volatile("" : "+s"(kub));
            int kwin = 256; asm volatile("" : "+s"(kwin));
            pg8::Gemm g{(const pg8::bf16_t*)(ws + WS_CQKV), (const pg8::bf16_t*)(ws + WS_WUB) + (size_t)L * 1024 * 384, MROWS, 1024, kub, kwin, 0, 0, 256};
            UpBSched S; S.T.init(MROWS / 256, 4, C.G, C.wg, 0, UREP(pb + 3));
            EpiUpB E{(pg8::bf16_t*)(ws + WS_QB), ws + WS_KB, ws + WS_VB, (const float*)(ws + WS_SSQ), (const float*)(ws + WS_SSK)};
            REPEAT(pb + 3) pg8::gemm_phase<EpiUpB, UpBSched, GP_ALIGN, GP_SP2, false, true>(C.lds, g, S, E);
            STEAL(pb + 3);
            if (IN(pb + 3) && IN(pb + 5)) xcd_barrier(bar);
        }
        if (IN(pb + 5)) { REPEAT(pb + 5) phase_attn(C, L); SEAM(pb + 5); }
        if (IN(pb + 6)) {
            pg8::Gemm g{(const pg8::bf16_t*)Hb, (const pg8::bf16_t*)(ws + WS_WOUT) + (size_t)L * DM * DM, MROWS, DM, DM};
            TileSched S; S.init(NLAT / 256, 4, C.G, C.wg, 1, L == 0 ? UREP(7) : 1);
            {
                EpiGateBf16 E{(pg8::bf16_t*)(ws + (L == 0 ? WS_D0 : WS_D1)), modL + 2048, 1.0f};
                REPEAT(pb + 6) pg8::gemm_phase<EpiGateBf16, TileSched, GP_ALIGN, GP_SP2>(C.lds, g, S, E); }
            if (L == 0) {
                pg8::Gemm g2{(const pg8::bf16_t*)Hb, (const pg8::bf16_t*)(ws + WS_WOUT), MROWS, DM, DM, DM / 2};
                CtxSplitSched S2{C.wg};
                EpiResidPart E2{xctx, nullptr, xc, (float*)(ws + WS_PART2), modL + 2048, 1.0f};
                pg8::gemm_phase<EpiResidPart, CtxSplitSched, GP_ALIGN, GP_SP2, false, true>(C.lds, g2, S2, E2);
                STEAL(pb + 6);
            }
            SEAM(pb + 6);
        }
        if (L == 0) {
            if (IN(8)) { REPEAT(8) phase_norm(C, 0, 1, args.in[0], xc, Hb, DENSE_F8 | DENSE_F8_UP, (const float*)(ws + WS_PART2), (const bf16*)(ws + WS_D0), args.out); SEAM(8); }
            if (IN(9)) {
                constexpr bool F8D = (DENSE_F8 | DENSE_F8_DN) != 0, F8IN = (DENSE_F8 | DENSE_F8_UP) != 0;
                pg8::Gemm g{(const pg8::bf16_t*)Hb, (const pg8::bf16_t*)(ws + WS_WUP), MROWS, 2 * FFD, F8IN ? DM / 2 : DM};
                TileSched S; S.init(MROWS / 256, 2 * FFD / 256, C.G, C.wg, 0, UREP(9));
                EpiSwiglu<F8D> E{(void*)(ws + WS_U), FFD, 2 * FFD / 256, 0, F8IN ? 1.0f / (F8_SA * F8_SW) : 1.0f, F8_SU};
                REPEAT(9) pg8::gemm_phase<EpiSwiglu<F8D>, TileSched, GP_ALIGN, GP_SP2, F8IN>(C.lds, g, S, E);
                STEAL(9);
                SEAM(9);
            }
            if (IN(10)) {
                constexpr bool F8D = (DENSE_F8 | DENSE_F8_DN) != 0;
                pg8::Gemm g{(const pg8::bf16_t*)(ws + WS_U), (const pg8::bf16_t*)(ws + WS_WDN), MROWS, DM, F8D ? FFD / 2 : FFD};
                EpiGateBf16 E{(pg8::bf16_t*)(ws + WS_D2), modL + 5120, F8D ? 1.0f / (F8_SU * F8_SW) : 1.0f};
                TileSched S; S.init(NLAT / 256, 4, C.G, C.wg, 1);
                REPEAT(10) pg8::gemm_phase<EpiGateBf16, TileSched, GP_ALIGN, GP_SP2, F8D>(C.lds, g, S, E);
                {
                    pg8::Gemm g2{(const pg8::bf16_t*)(ws + WS_U), (const pg8::bf16_t*)(ws + WS_WDN), MROWS, DM, F8D ? FFD / 2 : FFD, F8D ? 768 : FFD / 2, F8D ? FFD / 2 - 768 : 0, 2};
                    CtxSplitSched S2{C.wg};
                    EpiResidPart E2{xc, (const float*)(ws + WS_PART2), xc, (float*)(ws + WS_PART), modL + 5120, F8D ? 1.0f / (F8_SU * F8_SW) : 1.0f};
                    pg8::gemm_phase<EpiResidPart, CtxSplitSched, GP_ALIGN, GP_SP2, F8D, true>(C.lds, g2, S2, E2);
                }
                STEAL(10);
                SEAM(10);
            }
        }
    }

__global__ void __launch_bounds__(NWAVES * 64, 2) mk_fwd(Args args) {
    extern __shared__ __attribute__((aligned(16))) unsigned char lds_raw[];
    Ctx C;
    C.lds = (LAS unsigned char*)lds_raw;
    C.tid = threadIdx.x; C.lane = C.tid & 63; C.wave = __builtin_amdgcn_readfirstlane(C.tid >> 6);
    C.G = gridDim.x; C.wg = blockIdx.x; { const int bx = blockIdx.x; C.vcu = (C.G % 8 == 0) ? (bx % 8) * (C.G / 8) + bx / 8 : bx; }
    C.in = args.in; C.out = args.out; C.ws = args.ws;
    volatile LAS unsigned* MISC = (volatile LAS unsigned*)(C.lds + MISC_OFF);
    for (int u = C.tid; u < (LDS_BYTES - LDSCTL_OFF) / 4; u += NWAVES * 64) ((LAS unsigned*)(C.lds + LDSCTL_OFF))[u] = 0u;
    __syncthreads();
    unsigned* ctl = (unsigned*)(C.ws + WS_CTL);
    XcdBarrier bar = xcd_barrier_post(ctl + CW_BAR, MISC + 8);
    const int lo = args.ph_lo, hi = args.ph_hi;
    unsigned char* ws = C.ws;
    float* xc = (float*)(ws + WS_XC);
    bf16* Hb = (bf16*)(ws + WS_H);
    const float* modall = (const float*)(ws + WS_MOD);

    if (IN(0)) { REPEAT(0) { phase_prologue(C); __syncthreads(); } SEAM(0); }

    layer_phases<0>(C, args, bar, lo, hi);
    layer_phases<1>(C, args, bar, lo, hi);
    Ctx Cr = C; asm volatile("" : "+v"(Cr.tid), "+v"(Cr.lane));
    if (IN(18)) { REPEAT(18) { phase_route1(Cr); __syncthreads(); } SEAM(18); }
    if (IN(19)) { REPEAT(19) { phase_route2(Cr); __syncthreads(); } SEAM(19); }
    {
        const int* tile_e = (const int*)(ws + WS_RT + RT_TILEE);
        for (int ch = 0; ch < MOE_NCH - 1; ++ch) {
            const int pu = 20 + 2 * ch;
            int ntiles = 0;
            if (IN(pu) || IN(pu + 1)) ntiles = __builtin_amdgcn_readfirstlane(__hip_atomic_load(tile_e + 272, __ATOMIC_RELAXED, __HIP_MEMORY_SCOPE_AGENT));
            int ntc = ntiles - MOE_CH * ch; ntc = ntc < 0 ? 0 : (ntc > MOE_CH ? MOE_CH : ntc);
            if (IN(pu)) {
                pg8::Gemm g{(const pg8::bf16_t*)(ws + WS_HFS), (const pg8::bf16_t*)(ws + WS_WMUP), MOE_MAXT * 256, NEXP * 2 * FFE, DM / 2};
                MoeSched S{tile_e, MOE_CH * ch, ntc, 2 * FFE / 256, C.G, C.wg, 1};
                EpiSwiglu<true> E{(void*)(ws + ((ch & 1) ? WS_UM2 : WS_UM)), FFE, 2 * FFE / 256, -MOE_CH * ch, 1.0f / (F8_SA * F8_SW), F8_SU};
                REPEAT(pu) pg8::gemm_phase<EpiSwiglu<true>, MoeSched, GP_ALIGN, GP_SP2, true>(C.lds, g, S, E);
                SEAM(pu);
            }
            if (IN(pu + 1)) {
                pg8::Gemm g{(const pg8::bf16_t*)(ws + ((ch & 1) ? WS_UM2 : WS_UM)), (const pg8::bf16_t*)(ws + WS_WMDN), MOE_CH * 256, NEXP * DM, FFE / 2};
                MoeSched S{tile_e, MOE_CH * ch, ntc, 4, C.G, C.wg, 0};
                EpiStoreBf16 E{(pg8::bf16_t*)(ws + WS_Y), DM, 4, MOE_CH * ch, 1.0f / (F8_SU * F8_SW)};
                REPEAT(pu + 1) pg8::gemm_phase<EpiStoreBf16, MoeSched, GP_ALIGN, GP_SP2, true>(C.lds, g, S, E);
                if (ch == MOE_NCH - 2 || MK_SPLIT) SEAM(pu + 1);
            }
        }
        {
            constexpr int ch = MOE_NCH - 1, pu = 20 + 2 * ch;
            int ntiles = 0;
            if (IN(pu) || IN(pu + 1)) ntiles = __builtin_amdgcn_readfirstlane(__hip_atomic_load(tile_e + 272, __ATOMIC_RELAXED, __HIP_MEMORY_SCOPE_AGENT));
            int ntc = ntiles - MOE_CH * ch; ntc = ntc < 0 ? 0 : (ntc > 8 ? 8 : ntc);
            if (IN(pu)) {
                pg8::Gemm g{(const pg8::bf16_t*)(ws + WS_HFS), (const pg8::bf16_t*)(ws + WS_WMUP), MOE_MAXT * 256, NEXP * 2 * FFE, DM / 2};
                MoeSched S{tile_e, MOE_CH * ch, ntc, 2 * FFE / 256, C.G, C.wg, 1};
                EpiSwiglu<true> E{(void*)(ws + WS_UM), FFE, 2 * FFE / 256, -MOE_CH * ch, 1.0f / (F8_SA * F8_SW), F8_SU};
                pg8::gemm_phase<EpiSwiglu<true>, MoeSched, GP_ALIGN, GP_SP2, true>(C.lds, g, S, E);
                final_steal(Cr);
                SEAM(pu);
            }
            if (IN(pu + 1)) {
                pg8::Gemm gt{(const pg8::bf16_t*)(ws + WS_UM), (const pg8::bf16_t*)(ws + WS_WMDN), MOE_CH * 256, NEXP * DM, FFE / 2, FFE / 2 / MOE_TAILK};
                MoeTailSched S{tile_e, MOE_CH * ch, ntc, C.G, C.wg};
                EpiStoreBf16K E{(pg8::bf16_t*)(ws + WS_YT), DM, 1.0f / (F8_SU * F8_SW)};
                pg8::gemm_phase<EpiStoreBf16K, MoeTailSched, GP_ALIGN, GP_SP2, true, true>(C.lds, gt, S, E);
                final_steal(Cr);
                SEAM(pu + 1);
            }
        }
    }
    if (IN(30)) { phase_final(Cr); }
#undef IN
#undef SEAM
}

extern "C" void kernel_launch(void* const* d_in, const int* in_sizes, int n_in, void* d_out, int out_size, void* d_ws, size_t ws_size, hipStream_t stream) {
    static int grid = 0;
    if (grid == 0) {
        if (n_in != 25 || in_sizes[0] != NLAT * DM || out_size != NLAT * DM || ws_size < WS_END) { fprintf(stderr, "kernel_launch: unexpected shapes (n_in %d, in0 %d, out %d, ws %zu < %zu)\n", n_in, n_in > 0 ? in_sizes[0] : -1, out_size, ws_size, (size_t)WS_END); grid = -1; return; }
        int dev = 0, cus = 0, per_cu = 0;
        if (hipGetDevice(&dev) != hipSuccess || hipDeviceGetAttribute(&cus, hipDeviceAttributeMultiprocessorCount, dev) != hipSuccess) { grid = -1; return; }
        if (hipFuncSetAttribute((const void*)mk_fwd, hipFuncAttributeMaxDynamicSharedMemorySize, LDS_BYTES) != hipSuccess) { fprintf(stderr, "kernel_launch: hipFuncSetAttribute failed\n"); grid = -1; return; }
        if (hipOccupancyMaxActiveBlocksPerMultiprocessor(&per_cu, (const void*)mk_fwd, NWAVES * 64, LDS_BYTES) != hipSuccess || per_cu < 1) fprintf(stderr, "kernel_launch: occupancy query reports %d\n", per_cu);
        (void)hipGetLastError();
        grid = 256;
        if (cus < 256) { fprintf(stderr, "kernel_launch: %d CUs < 256\n", cus); grid = -1; return; }
    }
    if (grid < 0) return;
    if (hipMemsetAsync((char*)d_ws, 0, ZERO_BYTES, stream) != hipSuccess) return;
    Args a{};
    for (int i = 0; i < 25; ++i) a.in[i] = (const float*)d_in[i];
    a.out = (float*)d_out; a.ws = (unsigned char*)d_ws;
#if MK_SPLIT
    for (int p = 0; p < N_PHASES; ++p) { a.ph_lo = p; a.ph_hi = p + 1; hipLaunchKernelGGL(mk_fwd, dim3(grid), dim3(NWAVES * 64), LDS_BYTES, stream, a); }
#else
    a.ph_lo = 0; a.ph_hi = N_PHASES;
    hipLaunchKernelGGL(mk_fwd, dim3(grid), dim3(NWAVES * 64), LDS_BYTES, stream, a);
#endif
}
```
